# Optimizing an MI355X kernel written in HIP

```python
import jax, jax.numpy as jnp
from jax import lax
import numpy as np

D_MODEL = 1024
BATCH = 4
SEQ = 8192
DEPTH = 2

CHUNK = 64
EPS = 1e-6

A_HEADS = 8
A_HEAD_DIM = 64
A_WIDTH = A_HEADS * A_HEAD_DIM
A_LEFT_CHUNKS = 8
A_MAX_REL = 128

B_HEADS = 8
B_KEY_DIM = 64
B_VAL_DIM = 64
B_KWIDTH = B_HEADS * B_KEY_DIM
B_VWIDTH = B_HEADS * B_VAL_DIM

C_HEADS = 8
C_Q_RANK = 256
C_KV_RANK = 128
C_NOPE = 64
C_ROPE = 32
C_V = 64
C_WIDTH = C_HEADS * C_V
C_QBLOCK = 128
ROPE_BASE = 10000.0

N_BRANCH = 3
BRANCH_WIDTH = 512
D_FF = 4 * D_MODEL

IN_SPLIT_SIZES = (A_WIDTH, A_WIDTH, A_WIDTH,
                  B_KWIDTH, B_KWIDTH, B_VWIDTH, B_VWIDTH,
                  C_Q_RANK, C_KV_RANK, C_ROPE,
                  N_BRANCH * D_MODEL)
IN_COLS = sum(IN_SPLIT_SIZES)

kernel_name = 'hybrid_gated_streaming_block'


def rmsnorm(x, g):
    x32 = x.astype(jnp.float32)
    y = x32 * lax.rsqrt(jnp.mean(jnp.square(x32), axis=-1, keepdims=True) + EPS)
    return (y * g.astype(jnp.float32)).astype(x.dtype)


def rope(x, cos, sin):
    x1, x2 = jnp.split(x.astype(jnp.float32), 2, axis=-1)
    return jnp.concatenate([x1 * cos - x2 * sin, x2 * cos + x1 * sin], axis=-1).astype(x.dtype)


def chunked_relpos_attention(q, k, v, rel_table):
    bsz, seq, heads, dh = q.shape
    n_chunks = seq // CHUNK
    pad = A_LEFT_CHUNKS * CHUNK
    band = pad + CHUNK
    k_pad = jnp.pad(k, ((0, 0), (pad, 0), (0, 0), (0, 0)))
    v_pad = jnp.pad(v, ((0, 0), (pad, 0), (0, 0), (0, 0)))
    qi = jnp.arange(CHUNK)[:, None]
    kj = jnp.arange(band)[None, :]
    rel = jnp.clip(qi + pad - kj, -A_MAX_REL, A_MAX_REL) + A_MAX_REL
    bias = rel_table.astype(jnp.float32)[:, rel]
    q_chunks = q.reshape(bsz, n_chunks, CHUNK, heads, dh).transpose(1, 0, 2, 3, 4)
    scale = dh ** -0.5

    def one_chunk(args):
        c, q_blk = args
        k_band = lax.dynamic_slice_in_dim(k_pad, c * CHUNK, band, axis=1)
        v_band = lax.dynamic_slice_in_dim(v_pad, c * CHUNK, band, axis=1)
        s = jnp.einsum('bqhd,bkhd->bhqk', q_blk, k_band).astype(jnp.float32) * scale + bias
        valid = kj >= pad - c * CHUNK
        s = jnp.where(valid[None, None], s, -jnp.inf)
        p = jax.nn.softmax(s, axis=-1).astype(v.dtype)
        return jnp.einsum('bhqk,bkhd->bqhd', p, v_band)

    out = lax.map(one_chunk, (jnp.arange(n_chunks), q_chunks))
    return out.transpose(1, 0, 2, 3, 4).reshape(bsz, seq, heads * dh)


def hgrn2_recurrence(q, f_logit, i_val, g, lower_bound, norm_g):
    bsz, seq, _ = q.shape
    n_chunks = seq // CHUNK
    f32 = jnp.float32

    def to_chunks(t, d):
        return t.astype(f32).reshape(bsz, n_chunks, CHUNK, B_HEADS, d).transpose(1, 0, 3, 2, 4)

    z = to_chunks(f_logit, B_KEY_DIM)
    lb = lower_bound.reshape(1, B_HEADS, 1, B_KEY_DIM)
    log_f = jnp.logaddexp(jnp.log(lb), jnp.log1p(-lb) + jax.nn.log_sigmoid(z))
    k = (1.0 - lb) * jax.nn.sigmoid(-z)
    qc = jax.nn.silu(to_chunks(q, B_KEY_DIM))
    vc = to_chunks(i_val, B_VAL_DIM)
    causal = jnp.tril(jnp.ones((CHUNK, CHUNK), dtype=bool))[None, None, :, :, None]

    def step(state, blk):
        q_b, k_b, lf_b, v_b = blk
        cum = jnp.cumsum(lf_b, axis=2)
        diff = cum[:, :, :, None, :] - cum[:, :, None, :, :]
        decay = jnp.exp(jnp.where(causal, diff, -jnp.inf))
        scores = jnp.einsum('bhid,bhjd,bhijd->bhij', q_b, k_b, decay)
        o = (jnp.einsum('bhij,bhjv->bhiv', scores, v_b)
             + jnp.einsum('bhid,bhdv->bhiv', q_b * jnp.exp(cum), state))
        last = cum[:, :, -1:, :]
        state = (jnp.exp(last[:, :, 0, :])[..., None] * state
                 + jnp.einsum('bhjd,bhjv->bhdv', k_b * jnp.exp(last - cum), v_b))
        return state, o

    s0 = jnp.zeros((bsz, B_HEADS, B_KEY_DIM, B_VAL_DIM), f32)
    _, o = lax.scan(step, s0, (qc, k, log_f, vc))
    o = o.transpose(1, 0, 3, 2, 4).reshape(bsz, seq, B_HEADS, B_VAL_DIM)
    o = rmsnorm(o, norm_g) * jax.nn.silu(g.astype(f32).reshape(bsz, seq, B_HEADS, B_VAL_DIM))
    return o.reshape(bsz, seq, B_VWIDTH).astype(q.dtype)


def mla_attention(c_q, c_kv, k_rope_raw, positions, q_norm_g, kv_norm_g, w_uq, w_ukv):
    bsz, seq, _ = c_q.shape
    q = (rmsnorm(c_q, q_norm_g) @ w_uq).reshape(bsz, seq, C_HEADS, C_NOPE + C_ROPE)
    kv = (rmsnorm(c_kv, kv_norm_g) @ w_ukv).reshape(bsz, seq, C_HEADS, C_NOPE + C_V)
    q_nope, q_rope = q[..., :C_NOPE], q[..., C_NOPE:]
    k_nope, v = kv[..., :C_NOPE], kv[..., C_NOPE:]
    inv_freq = ROPE_BASE ** (-jnp.arange(0, C_ROPE, 2, dtype=jnp.float32) / C_ROPE)
    ang = positions.astype(jnp.float32)[..., None] * inv_freq
    cos, sin = jnp.cos(ang)[:, :, None, :], jnp.sin(ang)[:, :, None, :]
    q_rope = rope(q_rope, cos, sin)
    k_rope = rope(k_rope_raw[:, :, None, :], cos, sin)[:, :, 0, :]
    n_blocks = seq // C_QBLOCK

    def blocks(t):
        return t.reshape(bsz, n_blocks, C_QBLOCK, C_HEADS, t.shape[-1]).transpose(1, 0, 2, 3, 4)

    key_chunk = jnp.arange(seq) // CHUNK
    scale = (C_NOPE + C_ROPE) ** -0.5

    def one_block(args):
        blk, qn, qr = args
        s = (jnp.einsum('bqhd,bkhd->bhqk', qn, k_nope)
             + jnp.einsum('bqhr,bkr->bhqk', qr, k_rope)).astype(jnp.float32) * scale
        q_chunk = (blk * C_QBLOCK + jnp.arange(C_QBLOCK)) // CHUNK
        mask = key_chunk[None, :] <= q_chunk[:, None]
        s = jnp.where(mask[None, None], s, -jnp.inf)
        p = jax.nn.softmax(s, axis=-1).astype(v.dtype)
        return jnp.einsum('bhqk,bkhd->bqhd', p, v)

    out = lax.map(one_block, (jnp.arange(n_blocks), blocks(q_nope), blocks(q_rope)))
    return out.transpose(1, 0, 2, 3, 4).reshape(bsz, seq, C_WIDTH)


def setup_inputs(seed: int = 0) -> dict:
    key = jax.random.key(seed)
    ks = jax.random.split(key, 20)
    f32 = jnp.float32

    def nrm(k, shape, fan_in):
        return jax.random.normal(k, shape, f32) * (fan_in ** -0.5)

    def gain(k, shape):
        return 1.0 + 0.05 * jax.random.normal(k, shape, f32)

    x = jax.random.normal(ks[0], (BATCH, SEQ, D_MODEL), f32)
    offset = jax.random.randint(ks[1], (BATCH, 1), 0, 4096, dtype=jnp.int32)
    positions = offset + jnp.arange(SEQ, dtype=jnp.int32)[None, :]
    return {
        'x': x,
        'positions': positions,
        'norm_mix_g': gain(ks[2], (DEPTH, D_MODEL)),
        'w_in': nrm(ks[3], (DEPTH, D_MODEL, IN_COLS), D_MODEL),
        'rel_bias': 0.2 * jax.random.normal(ks[4], (DEPTH, A_HEADS, 2 * A_MAX_REL + 1), f32),
        'hgrn_lb_logits': jax.random.normal(ks[5], (DEPTH, B_KWIDTH), f32),
        'hgrn_norm_g': gain(ks[6], (DEPTH, B_VAL_DIM)),
        'mla_q_norm_g': gain(ks[7], (DEPTH, C_Q_RANK)),
        'mla_kv_norm_g': gain(ks[8], (DEPTH, C_KV_RANK)),
        'mla_w_uq': nrm(ks[9], (DEPTH, C_Q_RANK, C_HEADS * (C_NOPE + C_ROPE)), C_Q_RANK),
        'mla_w_ukv': nrm(ks[10], (DEPTH, C_KV_RANK, C_HEADS * (C_NOPE + C_V)), C_KV_RANK),
        'w_branch': nrm(ks[11], (DEPTH, N_BRANCH, BRANCH_WIDTH, D_MODEL), BRANCH_WIDTH),
        'w_out': nrm(ks[12], (DEPTH, D_MODEL, D_MODEL), D_MODEL),
        'norm_ffn_g': gain(ks[13], (DEPTH, D_MODEL)),
        'w_ff1': nrm(ks[14], (DEPTH, D_MODEL, D_FF), D_MODEL),
        'w_ff2': nrm(ks[15], (DEPTH, D_FF, D_MODEL), D_FF),
        'final_norm_g': gain(ks[16], (D_MODEL,)),
    }


def reference(x, positions, norm_mix_g, w_in, rel_bias, hgrn_lb_logits, hgrn_norm_g,
              mla_q_norm_g, mla_kv_norm_g, mla_w_uq, mla_w_ukv, w_branch, w_out,
              norm_ffn_g, w_ff1, w_ff2, final_norm_g):
    bsz, seq, _ = x.shape
    p_lb = jax.nn.softmax(hgrn_lb_logits.astype(jnp.float32), axis=0)
    lb_all = jnp.cumsum(p_lb, axis=0)
    lb_all = lb_all - lb_all[0:1]

    for l in range(DEPTH):
        h = rmsnorm(x, norm_mix_g[l])
        proj = h @ w_in[l]
        parts = []
        start = 0
        for size in IN_SPLIT_SIZES:
            parts.append(proj[..., start:start + size])
            start += size
        a_q, a_k, a_v, b_q, b_f, b_i, b_g, c_q, c_kv, c_kr, gate_logits = parts

        y_a = chunked_relpos_attention(
            a_q.reshape(bsz, seq, A_HEADS, A_HEAD_DIM),
            a_k.reshape(bsz, seq, A_HEADS, A_HEAD_DIM),
            a_v.reshape(bsz, seq, A_HEADS, A_HEAD_DIM),
            rel_bias[l])
        y_b = hgrn2_recurrence(b_q, b_f, b_i, b_g, lb_all[l], hgrn_norm_g[l])
        y_c = mla_attention(c_q, c_kv, c_kr, positions, mla_q_norm_g[l], mla_kv_norm_g[l],
                            mla_w_uq[l], mla_w_ukv[l])

        branches = jnp.stack([y_a.astype(h.dtype), y_b.astype(h.dtype), y_c.astype(h.dtype)], axis=2)
        up = jnp.einsum('bsnw,nwd->bsnd', branches, w_branch[l])
        gates = jax.nn.sigmoid(gate_logits.reshape(bsz, seq, N_BRANCH, D_MODEL))
        merged = jnp.sum(gates * up, axis=2)
        x = x + merged @ w_out[l]

        h2 = rmsnorm(x, norm_ffn_g[l])
        x = x + jnp.square(jax.nn.relu(h2 @ w_ff1[l])) @ w_ff2[l]

    return rmsnorm(x, final_norm_g)
```

```cpp
#include <hip/hip_runtime.h>
#include <hip/hip_cooperative_groups.h>
#include <cstdio>
#include <cstdint>
namespace cg = cooperative_groups;

#define LAS __attribute__((address_space(3)))
typedef unsigned short bf16_t;
typedef short bf16x8 __attribute__((ext_vector_type(8)));
typedef float f32x4 __attribute__((ext_vector_type(4)));
typedef float f32x16 __attribute__((ext_vector_type(16)));
typedef unsigned u32x4 __attribute__((ext_vector_type(4)));
typedef unsigned u32x2 __attribute__((ext_vector_type(2)));
typedef float f32x2_t __attribute__((ext_vector_type(2)));
typedef __bf16 bf16x2_t __attribute__((ext_vector_type(2)));

__device__ __forceinline__ unsigned pk2(float lo, float hi) { f32x2_t v = {lo, hi}; bf16x2_t b = __builtin_convertvector(v, bf16x2_t); return __builtin_bit_cast(unsigned, b); }
__device__ __forceinline__ bf16_t f2bf(float f) { return (bf16_t)(pk2(f, 0.f) & 0xffffu); }
__device__ __forceinline__ float bflo(unsigned w) { return __uint_as_float(w << 16); }
__device__ __forceinline__ float bfhi(unsigned w) { return __uint_as_float(w & 0xffff0000u); }
__device__ __forceinline__ float ex2(float x) { return __builtin_amdgcn_exp2f(x); }
__device__ __forceinline__ float sigm(float x) { return __builtin_amdgcn_rcpf(1.0f + ex2(-1.4426950408889634f * x)); }
__device__ __forceinline__ int crow(int r, int hi) { return (r & 3) + 8 * (r >> 2) + 4 * hi; }
__device__ __forceinline__ float shx(float v, int mask, int lane) { return __int_as_float(__builtin_amdgcn_ds_bpermute((lane ^ mask) << 2, __float_as_int(v))); }
__device__ __forceinline__ float wave_sum(float v, int lane) {
#pragma unroll
    for (int o = 1; o < 64; o <<= 1) v += shx(v, o, lane);
    return v;
}
#define LDS_WAIT() asm volatile("s_waitcnt lgkmcnt(0)" ::: "memory")
#define MFMA32(a, b, c) __builtin_amdgcn_mfma_f32_32x32x16_bf16((a), (b), (c), 0, 0, 0)

namespace pg8 {
constexpr int BM = 256, BK = 64, HALF = 128, HTB = HALF * BK * 2, STAGE_BYTES = 8 * HTB, NXCD = 8, WGM = 8;
__host__ __device__ __forceinline__ int lds_byte(int r, int c) { const int st = (r >> 4) * 2 + (c >> 5), rr = r & 15, cc = c & 31, ob = rr * 64 + cc * 2; return st * 1024 + (ob ^ (((ob >> 9) & 1) << 5)); }
__host__ __device__ __forceinline__ void stage_rc(int b, int& R, int& C) { const int st = b / 1024, sb = b % 1024, swz = sb ^ (((sb >> 9) & 1) << 5); R = (st >> 1) * 16 + swz / 64; C = (st & 1) * 32 + (swz % 64) / 2; }
__host__ __device__ __forceinline__ int perm32(int rho) { const int n = rho >> 4, i = rho & 15; return 8 * (i >> 2) + 4 * n + (i & 3); }

struct Unit { int pm, pn, z; };
struct Gemm { const bf16_t* A; const bf16_t* Bt; int M, N, K, lda, ldb; size_t za, zb; };

struct StaticOrder {
    int nM, nN, nwg, G, c;
    __device__ void init(int M, int N, int G_, int c_) { nM = M / BM; nN = N / BM; nwg = nM * nN; G = G_; c = c_; }
    __device__ bool next(int i, Unit& u) const {
        const long L = (long)i * G + c; if (L >= nwg) return false;
        int wgid = (int)L; { const int q = nwg / NXCD, r = nwg % NXCD, xcd = wgid % NXCD, off = wgid / NXCD; wgid = (xcd < r ? xcd * (q + 1) : r * (q + 1) + (xcd - r) * q) + off; }
        const int nig = WGM * nN, gid = wgid / nig, fm = gid * WGM, gsz = (nM - fm) < WGM ? (nM - fm) : WGM;
        u.pm = fm + ((wgid % nig) % gsz); u.pn = (wgid % nig) / gsz; u.z = 0; return true;
    }
};
struct BranchOrder {
    int G, c;
    __device__ bool next(int i, Unit& u) const {
        const int p = (i / 3) * G + c; if (p >= 256) return false;
        const int xcd = p & 7, off = p >> 3; u.pm = xcd * 8 + (off >> 2); u.pn = off & 3; u.z = i % 3; return true;
    }
};

template <int ACT0, int ACT1> struct EpiSplit {
    static constexpr bool PERM = true;
    bf16_t* O0; int ld0; int nsplit; bf16_t* O1; int ld1;
    __device__ __forceinline__ void operator()(const f32x4 (&acc)[2][2][4][2], const Unit& u, int wr, int wc, int fr, int fq) const {
        const bool first = u.pn < nsplit;
        bf16_t* base = first ? O0 : O1; const int ldc = first ? ld0 : ld1; const int colt = (first ? u.pn : u.pn - nsplit) * BM;
        const int act = first ? ACT0 : ACT1;
        const int row0 = u.pm * BM + wr * 64 + fr, col0 = colt + wc * 32 + 8 * fq;
#pragma unroll
        for (int ai = 0; ai < 2; ++ai)
#pragma unroll
            for (int m = 0; m < 4; ++m) { bf16_t* rowp = base + (size_t)(row0 + ai * HALF + m * 16) * ldc + col0;
#pragma unroll
                for (int bj = 0; bj < 2; ++bj) { f32x4 v0 = acc[ai][bj][m][0], v1 = acc[ai][bj][m][1];
                    if (act == 1) {
#pragma unroll
                        for (int e = 0; e < 4; ++e) { v0[e] = sigm(v0[e]); v1[e] = sigm(v1[e]); }
                    } else if (act == 2) {
#pragma unroll
                        for (int e = 0; e < 4; ++e) { const float a = fmaxf(v0[e], 0.f), b = fmaxf(v1[e], 0.f); v0[e] = a * a; v1[e] = b * b; }
                    }
                    u32x4 w; w.x = pk2(v0[0], v0[1]); w.y = pk2(v0[2], v0[3]); w.z = pk2(v1[0], v1[1]); w.w = pk2(v1[2], v1[3]);
                    *(u32x4*)(rowp + bj * HALF) = w; } }
    }
};
struct EpiBranch {
    static constexpr bool PERM = true;
    const bf16_t* Gt; bf16_t* Mg;
    __device__ __forceinline__ void operator()(const f32x4 (&acc)[2][2][4][2], const Unit& u, int wr, int wc, int fr, int fq) const {
        const int row0 = u.pm * BM + wr * 64 + fr, col0 = u.pn * BM + wc * 32 + 8 * fq;
#pragma unroll
        for (int ai = 0; ai < 2; ++ai)
#pragma unroll
            for (int m = 0; m < 4; ++m) { const size_t row = (size_t)(row0 + ai * HALF + m * 16);
#pragma unroll
                for (int bj = 0; bj < 2; ++bj) { const f32x4 v0 = acc[ai][bj][m][0], v1 = acc[ai][bj][m][1];
                    const u32x4 g = *(const u32x4*)(Gt + row * 3072 + u.z * 1024 + col0 + bj * HALF);
                    bf16_t* mp = Mg + row * 1024 + col0 + bj * HALF;
                    u32x4 pv = (u32x4){0u, 0u, 0u, 0u}; if (u.z > 0) pv = *(const u32x4*)mp;
                    float o[8];
                    o[0] = bflo(pv.x) + bflo(g.x) * v0[0]; o[1] = bfhi(pv.x) + bfhi(g.x) * v0[1]; o[2] = bflo(pv.y) + bflo(g.y) * v0[2]; o[3] = bfhi(pv.y) + bfhi(g.y) * v0[3];
                    o[4] = bflo(pv.z) + bflo(g.z) * v1[0]; o[5] = bfhi(pv.z) + bfhi(g.z) * v1[1]; o[6] = bflo(pv.w) + bflo(g.w) * v1[2]; o[7] = bfhi(pv.w) + bfhi(g.w) * v1[3];
                    u32x4 w; w.x = pk2(o[0], o[1]); w.y = pk2(o[2], o[3]); w.z = pk2(o[4], o[5]); w.w = pk2(o[6], o[7]);
                    *(u32x4*)mp = w; } }
    }
};
struct EpiResid {
    static constexpr bool PERM = true;
    const float* base; float* out;
    __device__ __forceinline__ void operator()(const f32x4 (&acc)[2][2][4][2], const Unit& u, int wr, int wc, int fr, int fq) const {
        const int row0 = u.pm * BM + wr * 64 + fr, col0 = u.pn * BM + wc * 32 + 8 * fq;
#pragma unroll
        for (int ai = 0; ai < 2; ++ai)
#pragma unroll
            for (int m = 0; m < 4; ++m) { const size_t off = (size_t)(row0 + ai * HALF + m * 16) * 1024 + col0;
#pragma unroll
                for (int bj = 0; bj < 2; ++bj) { const f32x4 b0 = *(const f32x4*)(base + off + bj * HALF), b1 = *(const f32x4*)(base + off + bj * HALF + 4);
                    *(f32x4*)(out + off + bj * HALF) = b0 + acc[ai][bj][m][0]; *(f32x4*)(out + off + bj * HALF + 4) = b1 + acc[ai][bj][m][1]; } }
    }
};

template <class Epi, class Sched>
__device__ __forceinline__ void gemm_phase(LAS unsigned char* lds, const Gemm g, const Sched& S, const Epi& E) {
    int tid = threadIdx.x; asm volatile("" : "+v"(tid));
    const int wid = __builtin_amdgcn_readfirstlane(tid >> 6), lane = tid & 63, wr = wid >> 2, wc = wid & 3, fr = lane & 15, fq = lane >> 4;
    const int K = g.K, nt = K / BK;
    unsigned voffA[2], voffB[2];
#pragma unroll
    for (int i = 0; i < 2; ++i) { int R, C; stage_rc(tid * 16 + i * 8192, R, C); const int Rb = Epi::PERM ? ((R & ~31) + perm32(R & 31)) : R;
        voffA[i] = (unsigned)(R * g.lda + C) * 2u; voffB[i] = (unsigned)(Rb * g.ldb + C) * 2u; }
    const size_t kstep = (size_t)(BK * 2);
    const size_t hstepA = (size_t)HALF * g.lda * 2, hstepB = (size_t)HALF * g.ldb * 2;
    const size_t tstepA = 2 * hstepA, tstepB = 2 * hstepB;
    const unsigned ldsw = (unsigned)wid * 1024u;
    const int aoff = lds_byte(wr * 64 + fr, fq * 8), boff = lds_byte(wc * 32 + fr, fq * 8);
#define PG8_SA(b, h) (((b) * 2 + (h)) * HTB)
#define PG8_SB(b, h) ((4 + (b) * 2 + (h)) * HTB)
#define PG8_STAGE(bufoff, gbase, voff) do { _Pragma("unroll") for (int _i = 0; _i < 2; ++_i) \
        __builtin_amdgcn_global_load_lds((const unsigned*)((const char*)(gbase) + (voff)[_i]), (LAS unsigned*)(lds + (bufoff) + ldsw + _i * 8192), 16, 0, 0); } while (0)
#define PG8_LDA(dst, b, h) do { _Pragma("unroll") for (int m = 0; m < 4; ++m) _Pragma("unroll") for (int k = 0; k < 2; ++k) dst[m][k] = *(const LAS bf16x8*)(lds + PG8_SA(b, h) + aoff + m * 2048 + k * 1024); } while (0)
#define PG8_LDB(dst, b, h) do { _Pragma("unroll") for (int n = 0; n < 2; ++n) _Pragma("unroll") for (int k = 0; k < 2; ++k) dst[n][k] = *(const LAS bf16x8*)(lds + PG8_SB(b, h) + boff + n * 2048 + k * 1024); } while (0)
#define PG8_MMA(ai, bj, At, Bt) do { __builtin_amdgcn_s_setprio(1); _Pragma("unroll") for (int m = 0; m < 4; ++m) _Pragma("unroll") for (int n = 0; n < 2; ++n) _Pragma("unroll") for (int k = 0; k < 2; ++k) \
        acc[ai][bj][m][n] = __builtin_amdgcn_mfma_f32_16x16x32_bf16(Bt[n][k], At[m][k], acc[ai][bj][m][n], 0, 0, 0); __builtin_amdgcn_s_setprio(0); } while (0)
#define PG8_WAIT_V(n) asm volatile("s_waitcnt vmcnt(" #n ")" ::: "memory")
#define PG8_WAIT_L(n) asm volatile("s_waitcnt lgkmcnt(" #n ")" ::: "memory")
#define PG8_BAR __builtin_amdgcn_s_barrier()
#define PG8_SCHED __builtin_amdgcn_sched_barrier(0)
    Unit cur, nxt; int ui = 0;
    if (!S.next(0, cur)) return;
    f32x4 acc[2][2][4][2];
#pragma unroll
    for (int a = 0; a < 2; ++a)
#pragma unroll
        for (int b = 0; b < 2; ++b)
#pragma unroll
            for (int m = 0; m < 4; ++m)
#pragma unroll
                for (int n = 0; n < 2; ++n) acc[a][b][m][n] = (f32x4){0.f, 0.f, 0.f, 0.f};
    bf16x8 At[4][2], B0[2][2], B1[2][2];
    const char* cA = (const char*)g.A + (size_t)cur.pm * tstepA + (size_t)cur.z * g.za; const char* cB = (const char*)g.Bt + (size_t)cur.pn * tstepB + (size_t)cur.z * g.zb;
    PG8_STAGE(PG8_SB(0, 0), cB, voffB); PG8_STAGE(PG8_SB(0, 1), cB + hstepB, voffB); PG8_STAGE(PG8_SA(0, 0), cA, voffA); PG8_STAGE(PG8_SA(0, 1), cA + hstepA, voffA);
    if (wr == 1) PG8_BAR;
    PG8_WAIT_V(2); PG8_BAR;
    PG8_STAGE(PG8_SB(1, 0), cB + kstep, voffB); PG8_STAGE(PG8_SA(1, 0), cA + kstep, voffA); PG8_STAGE(PG8_SB(1, 1), cB + hstepB + kstep, voffB);
    PG8_WAIT_V(6); PG8_BAR;
    for (;;) {
        const bool has_next = S.next(ui + 1, nxt);
        const char* nA = has_next ? (const char*)g.A + (size_t)nxt.pm * tstepA + (size_t)nxt.z * g.za : cA; const char* nB = has_next ? (const char*)g.Bt + (size_t)nxt.pn * tstepB + (size_t)nxt.z * g.zb : cB;
        for (int t = 0; t < nt; t += 2) {
            const bool last = (t == nt - 2);
            const char* a1 = cA + (size_t)(t + 1) * kstep;
            const char* a2 = last ? nA : cA + (size_t)(t + 2) * kstep; const char* b2 = last ? nB : cB + (size_t)(t + 2) * kstep;
            const char* a3 = a2 + kstep; const char* b3 = b2 + kstep;
            PG8_LDB(B0, 0, 0); PG8_LDB(B1, 0, 1); PG8_SCHED; PG8_LDA(At, 0, 0); PG8_STAGE(PG8_SA(1, 1), a1 + hstepA, voffA);
            PG8_WAIT_V(8); PG8_WAIT_L(0); PG8_BAR; PG8_MMA(0, 0, At, B0); PG8_MMA(0, 1, At, B1); PG8_BAR; PG8_SCHED;
            PG8_LDA(At, 0, 1); PG8_STAGE(PG8_SB(0, 0), b2, voffB); PG8_STAGE(PG8_SB(0, 1), b2 + hstepB, voffB); PG8_STAGE(PG8_SA(0, 0), a2, voffA);
            PG8_WAIT_V(8); PG8_WAIT_L(0); PG8_BAR; PG8_MMA(1, 0, At, B0); PG8_MMA(1, 1, At, B1); PG8_BAR; PG8_SCHED;
            PG8_LDB(B0, 1, 0); PG8_LDB(B1, 1, 1); PG8_SCHED; PG8_LDA(At, 1, 0); PG8_STAGE(PG8_SA(0, 1), a2 + hstepA, voffA);
            PG8_WAIT_V(8); PG8_WAIT_L(0); PG8_BAR; PG8_MMA(0, 0, At, B0); PG8_MMA(0, 1, At, B1); PG8_BAR; PG8_SCHED;
            PG8_LDA(At, 1, 1); PG8_STAGE(PG8_SB(1, 0), b3, voffB); PG8_STAGE(PG8_SB(1, 1), b3 + hstepB, voffB); PG8_STAGE(PG8_SA(1, 0), a3, voffA);
            PG8_WAIT_V(8); PG8_WAIT_L(0); PG8_BAR; PG8_MMA(1, 0, At, B0); PG8_MMA(1, 1, At, B1); PG8_BAR; PG8_SCHED;
        }
        if (wr == 0) PG8_BAR;
        { int t2_ = threadIdx.x; asm volatile("" : "+v"(t2_)); E(acc, cur, wr, wc, t2_ & 15, (t2_ >> 4) & 3); }
        if (!has_next) break;
#pragma unroll
        for (int a = 0; a < 2; ++a)
#pragma unroll
            for (int b = 0; b < 2; ++b)
#pragma unroll
                for (int m = 0; m < 4; ++m)
#pragma unroll
                    for (int n = 0; n < 2; ++n) acc[a][b][m][n] = (f32x4){0.f, 0.f, 0.f, 0.f};
        cur = nxt; cA = nA; cB = nB; ++ui;
        if (wr == 1) PG8_BAR;
    }
    PG8_WAIT_V(0);
    PG8_BAR;
#undef PG8_SA
#undef PG8_SB
#undef PG8_STAGE
#undef PG8_LDA
#undef PG8_LDB
#undef PG8_MMA
#undef PG8_WAIT_V
#undef PG8_WAIT_L
#undef PG8_BAR
#undef PG8_SCHED
}
}

constexpr int DM = 1024, SEQ = 8192, MTOT = 32768, MH = 16384, NIN = 7168, FF = 4096;
constexpr float EPS = 1e-6f, LOG2E = 1.4426950408889634f;
constexpr int LDS_BYTES = 147456;
constexpr size_t MiB = 1u << 20;
constexpr size_t WS_CTL = 0;
constexpr size_t WS_W = 1 * MiB, W_LAYER = 36 * MiB;
constexpr size_t WO_IN = 0, WO_QK = 14 * MiB, WO_V = 15 * MiB, WO_BR = 16 * MiB, WO_OUT = 19 * MiB, WO_F1 = 21 * MiB, WO_F2 = 29 * MiB;
constexpr size_t W_LAYER_REAL = 37 * MiB;
constexpr size_t WS_XN = 80 * MiB;
constexpr size_t WS_CAT = 112 * MiB;
constexpr size_t WS_KR = 124 * MiB;
constexpr size_t WS_CS = 125 * MiB;
constexpr size_t WS_P = 144 * MiB;
constexpr size_t WS_G = 272 * MiB;
constexpr size_t WS_Q = 368 * MiB;
constexpr size_t WS_KN = 392 * MiB;
constexpr size_t WS_VT = 408 * MiB;
constexpr size_t WS_Y = 424 * MiB;
constexpr size_t WS_MG = 472 * MiB;
constexpr size_t WS_H = 144 * MiB;
static_assert(WS_W + 2 * W_LAYER_REAL <= WS_XN, "weights fit");

#define OPAQUE_TID(t) int t = threadIdx.x; asm volatile("" : "+v"(t))
__device__ __forceinline__ void norm_rows_bf16(const float* x, const float* g, bf16_t* dst, int rows, int NGW) {
    OPAQUE_TID(tid_); const int lane = tid_ & 63, gw = blockIdx.x * 8 + __builtin_amdgcn_readfirstlane(tid_ >> 6);
    for (int m = gw; m < rows; m += NGW) {
        const f32x4* xr = (const f32x4*)(x + (size_t)m * DM) + lane;
        f32x4 v[4]; float s = 0.f;
#pragma unroll
        for (int j = 0; j < 4; ++j) { v[j] = xr[64 * j]; s += (v[j].x * v[j].x + v[j].y * v[j].y) + (v[j].z * v[j].z + v[j].w * v[j].w); }
        const float r = 1.0f / sqrtf(wave_sum(s, lane) * (1.0f / DM) + EPS);
        unsigned long long* o8 = (unsigned long long*)(dst + (size_t)m * DM) + lane;
#pragma unroll
        for (int j = 0; j < 4; ++j) { const f32x4 gg = ((const f32x4*)g)[lane + 64 * j];
            o8[64 * j] = (unsigned long long)pk2(v[j].x * r * gg.x, v[j].y * r * gg.y) | ((unsigned long long)pk2(v[j].z * r * gg.z, v[j].w * r * gg.w) << 32); }
    }
}
__device__ __forceinline__ void norm_rows_f32_inplace(float* x, const float* g, int rows, int NGW) {
    OPAQUE_TID(tid_); const int lane = tid_ & 63, gw = blockIdx.x * 8 + __builtin_amdgcn_readfirstlane(tid_ >> 6);
    for (int m = gw; m < rows; m += NGW) {
        f32x4* xr = (f32x4*)(x + (size_t)m * DM) + lane;
        f32x4 v[4]; float s = 0.f;
#pragma unroll
        for (int j = 0; j < 4; ++j) { v[j] = xr[64 * j]; s += (v[j].x * v[j].x + v[j].y * v[j].y) + (v[j].z * v[j].z + v[j].w * v[j].w); }
        const float r = 1.0f / sqrtf(wave_sum(s, lane) * (1.0f / DM) + EPS);
#pragma unroll
        for (int j = 0; j < 4; ++j) { const f32x4 gg = ((const f32x4*)g)[lane + 64 * j]; xr[64 * j] = v[j] * r * gg; }
    }
}
__device__ __forceinline__ void mla_prep(const bf16_t* P, const int* pos, const float* gq, const float* gkv, bf16_t* cat, bf16_t* kr, float* cs, int NGW) {
    OPAQUE_TID(tid_); const int lane = tid_ & 63, gw = blockIdx.x * 8 + __builtin_amdgcn_readfirstlane(tid_ >> 6);
    for (int m = gw; m < MH; m += NGW) {
        const bf16_t* prow = P + (size_t)m * 4096 + 3584;
        { const u32x2 w = *(const u32x2*)(prow + 4 * lane);
          const float a = bflo(w.x), b = bfhi(w.x), c = bflo(w.y), d = bfhi(w.y);
          const float r = 1.0f / sqrtf(wave_sum((a * a + b * b) + (c * c + d * d), lane) * (1.0f / 256.0f) + EPS);
          const f32x4 gg = ((const f32x4*)gq)[lane];
          u32x2 o; o.x = pk2(a * r * gg.x, b * r * gg.y); o.y = pk2(c * r * gg.z, d * r * gg.w);
          *(u32x2*)(cat + (size_t)m * 384 + 4 * lane) = o; }
        { const unsigned w = *(const unsigned*)(prow + 256 + 2 * lane);
          const float a = bflo(w), b = bfhi(w);
          const float r = 1.0f / sqrtf(wave_sum(a * a + b * b, lane) * (1.0f / 128.0f) + EPS);
          *(unsigned*)(cat + (size_t)m * 384 + 256 + 2 * lane) = pk2(a * r * gkv[2 * lane], b * r * gkv[2 * lane + 1]); }
        if (lane < 16) {
            const float x1 = __uint_as_float((unsigned)prow[384 + lane] << 16), x2 = __uint_as_float((unsigned)prow[400 + lane] << 16);
            const float invf = exp2f(-(float)lane * 0.83048202372184059f);
            double fr = (double)pos[m] * (double)invf * 0.15915494309189535;
            fr -= rint(fr);
            const float c = __builtin_amdgcn_cosf((float)fr), s = __builtin_amdgcn_sinf((float)fr);
            cs[(size_t)m * 32 + lane] = c; cs[(size_t)m * 32 + 16 + lane] = s;
            kr[(size_t)m * 32 + lane] = f2bf(x1 * c - x2 * s); kr[(size_t)m * 32 + 16 + lane] = f2bf(x2 * c + x1 * s);
        }
    }
}

constexpr int VP = 72;
template <int ND0, int KP>
__device__ __forceinline__ void qk_tile(const LAS unsigned char* Ks, const bf16x8 (&qf)[ND0], f32x16& p0, f32x16& p1, int r32, int hi) {
#pragma unroll
    for (int r = 0; r < 16; ++r) { p0[r] = 0.f; p1[r] = 0.f; }
#pragma unroll
    for (int d0 = 0; d0 < ND0; ++d0) {
        const bf16x8 a0 = *(const LAS bf16x8*)(Ks + r32 * (KP * 2) + (16 * d0 + 8 * hi) * 2);
        const bf16x8 a1 = *(const LAS bf16x8*)(Ks + (r32 + 32) * (KP * 2) + (16 * d0 + 8 * hi) * 2);
        p0 = MFMA32(a0, qf[d0], p0); p1 = MFMA32(a1, qf[d0], p1);
    }
}
__device__ __forceinline__ void softmax_pv(f32x16& p0, f32x16& p1, f32x16 (&o)[2], float& m_run, float& l_run, const LAS unsigned char* Vts, LAS float* sc, int r32, int hi) {
    float mx = fmaxf(p0[0], p1[0]);
#pragma unroll
    for (int r = 1; r < 16; ++r) mx = fmaxf(mx, fmaxf(p0[r], p1[r]));
    mx = fmaxf(mx, shx(mx, 32, r32 + 32 * hi));
    const float mn = fmaxf(m_run, mx);
    const float alpha = ex2(m_run - mn);
    m_run = mn;
    float s = 0.f;
#pragma unroll
    for (int r = 0; r < 16; ++r) { p0[r] = ex2(p0[r] - mn); p1[r] = ex2(p1[r] - mn); s += p0[r] + p1[r]; }
    l_run = l_run * alpha + s;
    if (hi == 0) sc[r32] = alpha;
    LDS_WAIT();
#pragma unroll
    for (int g4 = 0; g4 < 4; ++g4) { const f32x4 a = *(const LAS f32x4*)(sc + 8 * g4 + 4 * hi);
#pragma unroll
        for (int e = 0; e < 4; ++e) { o[0][4 * g4 + e] *= a[e]; o[1][4 * g4 + e] *= a[e]; } }
    LDS_WAIT();
#pragma unroll
    for (int ks = 0; ks < 4; ++ks) {
        u32x4 pw;
        if (ks == 0) pw = (u32x4){pk2(p0[0], p0[1]), pk2(p0[2], p0[3]), pk2(p0[4], p0[5]), pk2(p0[6], p0[7])};
        else if (ks == 1) pw = (u32x4){pk2(p0[8], p0[9]), pk2(p0[10], p0[11]), pk2(p0[12], p0[13]), pk2(p0[14], p0[15])};
        else if (ks == 2) pw = (u32x4){pk2(p1[0], p1[1]), pk2(p1[2], p1[3]), pk2(p1[4], p1[5]), pk2(p1[6], p1[7])};
        else pw = (u32x4){pk2(p1[8], p1[9]), pk2(p1[10], p1[11]), pk2(p1[12], p1[13]), pk2(p1[14], p1[15])};
        const bf16x8 pa = __builtin_bit_cast(bf16x8, pw);
        const int kvb = 16 * (ks & 1) + 32 * (ks >> 1);
#pragma unroll
        for (int db = 0; db < 2; ++db) {
            const LAS unsigned char* vp = Vts + (32 * db + r32) * (VP * 2) + (kvb + 4 * hi) * 2;
            const u32x2 lo = *(const LAS u32x2*)vp, h2 = *(const LAS u32x2*)(vp + 16);
            const u32x4 vw = (u32x4){lo.x, lo.y, h2.x, h2.y};
            o[db] = MFMA32(pa, __builtin_bit_cast(bf16x8, vw), o[db]);
        }
    }
}
__device__ __forceinline__ void attn_finish(f32x16 (&o)[2], float l_run, bf16_t* y, size_t row0, int ldy, int col0, LAS float* sc, int r32, int hi) {
    const float lt = l_run + shx(l_run, 32, r32 + 32 * hi);
    if (hi == 0) sc[r32] = 1.0f / lt;
    LDS_WAIT();
#pragma unroll
    for (int g4 = 0; g4 < 4; ++g4) { const f32x4 a = *(const LAS f32x4*)(sc + 8 * g4 + 4 * hi);
#pragma unroll
        for (int e = 0; e < 4; ++e) { const int r = 4 * g4 + e; bf16_t* yp = y + (row0 + crow(r, hi)) * ldy + col0 + r32;
            yp[0] = f2bf(o[0][r] * a[e]); yp[32] = f2bf(o[1][r] * a[e]); } }
    LDS_WAIT();
}

__device__ __forceinline__ void mla_unit(const bf16_t* Q, const bf16_t* KN, const bf16_t* KR, const bf16_t* VT, const float* CS, bf16_t* Y, int bl, int h, int qb, LAS unsigned char* lds) {
    OPAQUE_TID(tid);
    constexpr int KP = 104, KBUF = 64 * KP * 2, VBUF = 64 * VP * 2, OFF_V = 2 * KBUF, OFF_SC = OFF_V + 2 * VBUF;
    const int lane = tid & 63, w = __builtin_amdgcn_readfirstlane(tid >> 6), r32 = lane & 31, hi = lane >> 5;
    const size_t rb = (size_t)bl * SEQ;
    LAS float* sc = (LAS float*)(lds + OFF_SC) + w * 32;
    const float QS = 0.10206207261596577f * LOG2E;
    bf16x8 qf[6];
    { const size_t qrow = rb + (size_t)qb * 256 + 32 * w + r32;
      const bf16_t* qp = Q + qrow * 768 + h * 96;
#pragma unroll
      for (int d0 = 0; d0 < 4; ++d0) { const u32x4 raw = *(const u32x4*)(qp + 16 * d0 + 8 * hi);
          u32x4 t; t.x = pk2(bflo(raw.x) * QS, bfhi(raw.x) * QS); t.y = pk2(bflo(raw.y) * QS, bfhi(raw.y) * QS); t.z = pk2(bflo(raw.z) * QS, bfhi(raw.z) * QS); t.w = pk2(bflo(raw.w) * QS, bfhi(raw.w) * QS);
          qf[d0] = __builtin_bit_cast(bf16x8, t); }
      const u32x4 r1 = *(const u32x4*)(qp + 64 + 8 * hi), r2 = *(const u32x4*)(qp + 80 + 8 * hi);
      const f32x4 c0 = *(const f32x4*)(CS + qrow * 32 + 8 * hi), c1 = *(const f32x4*)(CS + qrow * 32 + 8 * hi + 4);
      const f32x4 s0 = *(const f32x4*)(CS + qrow * 32 + 16 + 8 * hi), s1 = *(const f32x4*)(CS + qrow * 32 + 16 + 8 * hi + 4);
      const float x1[8] = {bflo(r1.x), bfhi(r1.x), bflo(r1.y), bfhi(r1.y), bflo(r1.z), bfhi(r1.z), bflo(r1.w), bfhi(r1.w)};
      const float x2[8] = {bflo(r2.x), bfhi(r2.x), bflo(r2.y), bfhi(r2.y), bflo(r2.z), bfhi(r2.z), bflo(r2.w), bfhi(r2.w)};
      const float cc[8] = {c0.x, c0.y, c0.z, c0.w, c1.x, c1.y, c1.z, c1.w}, ss[8] = {s0.x, s0.y, s0.z, s0.w, s1.x, s1.y, s1.z, s1.w};
      float o1[8], o2[8];
#pragma unroll
      for (int i = 0; i < 8; ++i) { o1[i] = (x1[i] * cc[i] - x2[i] * ss[i]) * QS; o2[i] = (x2[i] * cc[i] + x1[i] * ss[i]) * QS; }
      u32x4 t1 = (u32x4){pk2(o1[0], o1[1]), pk2(o1[2], o1[3]), pk2(o1[4], o1[5]), pk2(o1[6], o1[7])}, t2 = (u32x4){pk2(o2[0], o2[1]), pk2(o2[2], o2[3]), pk2(o2[4], o2[5]), pk2(o2[6], o2[7])};
      qf[4] = __builtin_bit_cast(bf16x8, t1); qf[5] = __builtin_bit_cast(bf16x8, t2); }
    const int T = 4 * qb + 4, tmax = 4 * qb + (w >> 1);
    const int krow = tid >> 3, kch = tid & 7;
    const int rrow = (tid & 255) >> 2, rch = tid & 3;
    const bf16_t* knp = KN + (rb + krow) * 512 + h * 64 + 8 * kch;
    const bf16_t* krp = KR + (rb + rrow) * 32 + 8 * rch;
    const bf16_t* vtp = VT + (size_t)(h * 64 + krow) * MH + rb + 8 * kch;
    u32x4 gk, gr = (u32x4){0u, 0u, 0u, 0u}, gv;
#define MLA_LOAD(t) do { gk = *(const u32x4*)(knp + (size_t)(t) * 64 * 512); if (tid < 256) gr = *(const u32x4*)(krp + (size_t)(t) * 64 * 32); gv = *(const u32x4*)(vtp + (size_t)(t) * 64); } while (0)
#define MLA_STORE(b) do { *(LAS u32x4*)(lds + (b) * KBUF + krow * (KP * 2) + kch * 16) = gk; if (tid < 256) *(LAS u32x4*)(lds + (b) * KBUF + rrow * (KP * 2) + 128 + rch * 16) = gr; \
        *(LAS u32x4*)(lds + OFF_V + (b) * VBUF + krow * (VP * 2) + kch * 16) = gv; } while (0)
    f32x16 o[2];
#pragma unroll
    for (int r = 0; r < 16; ++r) { o[0][r] = 0.f; o[1][r] = 0.f; }
    float m_run = -INFINITY, l_run = 0.f;
    MLA_LOAD(0); MLA_STORE(0);
    __syncthreads();
    for (int t = 0; t < T; ++t) {
        if (t + 1 < T) MLA_LOAD(t + 1);
        if (t <= tmax) {
            f32x16 p0, p1;
            qk_tile<6, KP>(lds + (t & 1) * KBUF, qf, p0, p1, r32, hi);
            softmax_pv(p0, p1, o, m_run, l_run, lds + OFF_V + (t & 1) * VBUF, sc, r32, hi);
        }
        if (t + 1 < T) MLA_STORE((t + 1) & 1);
        __syncthreads();
    }
#undef MLA_LOAD
#undef MLA_STORE
    attn_finish(o, l_run, Y, rb + (size_t)qb * 256 + 32 * w, 1536, 1024 + h * 64, sc, r32, hi);
    __syncthreads();
}

__device__ __forceinline__ void bandattn_unit(const bf16_t* P, const float* relb  , bf16_t* Y, int bl, int h, int grp, LAS unsigned char* lds) {
    OPAQUE_TID(tid);
    constexpr int KP = 72, KBUF = 64 * KP * 2, VBUF = 64 * VP * 2, OFF_V = 2 * KBUF, OFF_SC = OFF_V + 2 * VBUF, OFF_TB = OFF_SC + 8 * 128;
    const int lane = tid & 63, w = __builtin_amdgcn_readfirstlane(tid >> 6), r32 = lane & 31, hi = lane >> 5;
    const size_t rb = (size_t)bl * SEQ;
    LAS float* sc = (LAS float*)(lds + OFF_SC) + w * 32;
    LAS float* tb = (LAS float*)(lds + OFF_TB);
    if (tid < 257) tb[tid] = relb[tid] * LOG2E;
    const float QS = 0.125f * LOG2E;
    bf16x8 qf[4];
    { const size_t qrow = rb + (size_t)grp * 256 + 32 * w + r32;
      const bf16_t* qp = P + qrow * 4096 + h * 64;
#pragma unroll
      for (int d0 = 0; d0 < 4; ++d0) { const u32x4 raw = *(const u32x4*)(qp + 16 * d0 + 8 * hi);
          u32x4 t; t.x = pk2(bflo(raw.x) * QS, bfhi(raw.x) * QS); t.y = pk2(bflo(raw.y) * QS, bfhi(raw.y) * QS); t.z = pk2(bflo(raw.z) * QS, bfhi(raw.z) * QS); t.w = pk2(bflo(raw.w) * QS, bfhi(raw.w) * QS);
          qf[d0] = __builtin_bit_cast(bf16x8, t); } }
    const int c = 4 * grp + (w >> 1);
    const int kc0 = (4 * grp - 8) > 0 ? (4 * grp - 8) : 0, kc1 = 4 * grp + 3;
    const int krow = tid >> 3, kch = tid & 7;
    const int vkv = tid & 63, vch = tid >> 6;
    const bf16_t* kp = P + (rb + krow) * 4096 + 512 + h * 64 + 8 * kch;
    const bf16_t* vp = P + (rb + vkv) * 4096 + 1024 + h * 64 + 8 * vch;
    u32x4 gk, gv;
#define BA_LOAD(kc) do { gk = *(const u32x4*)(kp + (size_t)(kc) * 64 * 4096); gv = *(const u32x4*)(vp + (size_t)(kc) * 64 * 4096); } while (0)
#define BA_STORE(b) do { *(LAS u32x4*)(lds + (b) * KBUF + krow * (KP * 2) + kch * 16) = gk; \
        LAS bf16_t* vd = (LAS bf16_t*)(lds + OFF_V + (b) * VBUF) + (8 * vch) * VP + vkv; \
        vd[0 * VP] = (bf16_t)(gv.x & 0xffffu); vd[1 * VP] = (bf16_t)(gv.x >> 16); vd[2 * VP] = (bf16_t)(gv.y & 0xffffu); vd[3 * VP] = (bf16_t)(gv.y >> 16); \
        vd[4 * VP] = (bf16_t)(gv.z & 0xffffu); vd[5 * VP] = (bf16_t)(gv.z >> 16); vd[6 * VP] = (bf16_t)(gv.w & 0xffffu); vd[7 * VP] = (bf16_t)(gv.w >> 16); } while (0)
    f32x16 o[2];
#pragma unroll
    for (int r = 0; r < 16; ++r) { o[0][r] = 0.f; o[1][r] = 0.f; }
    float m_run = -INFINITY, l_run = 0.f;
    BA_LOAD(kc0); BA_STORE(0);
    __syncthreads();
    const int qpos = 64 * c + 32 * (w & 1) + r32;
    for (int kc = kc0, it = 0; kc <= kc1; ++kc, ++it) {
        if (kc + 1 <= kc1) BA_LOAD(kc + 1);
        if (kc >= c - 8 && kc <= c) {
            f32x16 p0, p1;
            qk_tile<4, KP>(lds + (it & 1) * KBUF, qf, p0, p1, r32, hi);
            if (c - kc >= 3) { const float bb = tb[256];
#pragma unroll
                for (int r = 0; r < 16; ++r) { p0[r] += bb; p1[r] += bb; }
            } else {
#pragma unroll
                for (int r = 0; r < 16; ++r) { const int d0 = qpos - (64 * kc + crow(r, hi));
                    int i0 = d0 < -128 ? -128 : (d0 > 128 ? 128 : d0), i1 = (d0 - 32) < -128 ? -128 : ((d0 - 32) > 128 ? 128 : (d0 - 32));
                    p0[r] += tb[i0 + 128]; p1[r] += tb[i1 + 128]; }
            }
            softmax_pv(p0, p1, o, m_run, l_run, lds + OFF_V + (it & 1) * VBUF, sc, r32, hi);
        }
        if (kc + 1 <= kc1) BA_STORE((it + 1) & 1);
        __syncthreads();
    }
#undef BA_LOAD
#undef BA_STORE
    attn_finish(o, l_run, Y, rb + (size_t)grp * 256 + 32 * w, 1536, h * 64, sc, r32, hi);
    __syncthreads();
}

__device__ __forceinline__ void hgrn_unit(const bf16_t* P, const float* lbl  , const float* ng  , bf16_t* Y, int layer, int bl, int h, LAS unsigned char* lds) {
    OPAQUE_TID(tid);
    constexpr int RP = 144;
    constexpr int O_LF = 0, O_SEG = 16384, O_QT = 18432, O_KT = 27648, O_QH = 36864, O_KH = 46080, O_VT = 55296, O_ST0 = 64512, O_ST1 = 73728, O_OB = 82944, O_DL = 100352;
    const int lane = tid & 63, w = __builtin_amdgcn_readfirstlane(tid >> 6), r32 = lane & 31, hi = lane >> 5;
    const int j = tid >> 3, c8 = tid & 7;
    const size_t rb = (size_t)bl * SEQ;
    LAS float* LF = (LAS float*)(lds + O_LF); LAS float* SEG = (LAS float*)(lds + O_SEG); LAS float* OB = (LAS float*)(lds + O_OB); LAS float* DL = (LAS float*)(lds + O_DL);
    float lbv[8], ngv[8];
#pragma unroll
    for (int i = 0; i < 8; ++i) { const int d = h * 64 + 8 * c8 + i; lbv[i] = (layer == 0) ? 0.f : sigm(lbl[512 + d] - lbl[d]); ngv[i] = ng[8 * c8 + i]; }
    for (int u = tid; u < 9216 / 4; u += 512) ((LAS unsigned*)(lds + O_ST0))[u] = 0u;
    f32x16 st;
#pragma unroll
    for (int r = 0; r < 16; ++r) st[r] = 0.f;
    const bf16_t* base = P + (rb + j) * 4096 + h * 64 + 8 * c8;
    u32x4 nq = *(const u32x4*)(base + 1536), nf = *(const u32x4*)(base + 2048), ni = *(const u32x4*)(base + 2560), ngt = *(const u32x4*)(base + 3072);
    __syncthreads();
#pragma unroll 1
    for (int c = 0; c < 128; ++c) {
        const u32x4 rq = nq, rf = nf, ri = ni, rg = ngt;
        if (c + 1 < 128) { const bf16_t* nb = base + (size_t)(c + 1) * 64 * 4096; nq = *(const u32x4*)(nb + 1536); nf = *(const u32x4*)(nb + 2048); ni = *(const u32x4*)(nb + 2560); ngt = *(const u32x4*)(nb + 3072); }
        float kk[8];
        { const float z[8] = {bflo(rf.x), bfhi(rf.x), bflo(rf.y), bfhi(rf.y), bflo(rf.z), bfhi(rf.z), bflo(rf.w), bfhi(rf.w)};
          float lf[8];
#pragma unroll
          for (int i = 0; i < 8; ++i) { const float sg = sigm(z[i]); const float f = lbv[i] + (1.0f - lbv[i]) * sg; lf[i] = fmaxf(__builtin_amdgcn_logf(f), -80.0f); kk[i] = (1.0f - lbv[i]) * (1.0f - sg); }
          *(LAS f32x4*)(LF + j * 64 + 8 * c8) = (f32x4){lf[0], lf[1], lf[2], lf[3]}; *(LAS f32x4*)(LF + j * 64 + 8 * c8 + 4) = (f32x4){lf[4], lf[5], lf[6], lf[7]}; }
        __syncthreads();
        { const int d = tid & 63, sg = tid >> 6; float v[8];
#pragma unroll
          for (int k = 0; k < 8; ++k) v[k] = LF[(8 * sg + k) * 64 + d];
#pragma unroll
          for (int k = 1; k < 8; ++k) v[k] += v[k - 1];
#pragma unroll
          for (int k = 0; k < 8; ++k) LF[(8 * sg + k) * 64 + d] = v[k];
          SEG[sg * 64 + d] = v[7]; }
        __syncthreads();
        { const int sg = j >> 3;
          float off[8], tot[8], mid[8];
#pragma unroll
          for (int i = 0; i < 8; ++i) { off[i] = 0.f; tot[i] = 0.f; mid[i] = 0.f; }
#pragma unroll
          for (int s2 = 0; s2 < 8; ++s2) { const f32x4 a = *(const LAS f32x4*)(SEG + s2 * 64 + 8 * c8), b = *(const LAS f32x4*)(SEG + s2 * 64 + 8 * c8 + 4);
              const float v8[8] = {a.x, a.y, a.z, a.w, b.x, b.y, b.z, b.w};
#pragma unroll
              for (int i = 0; i < 8; ++i) { if (s2 < sg) off[i] += v8[i]; tot[i] += v8[i]; if (s2 == 3) mid[i] = tot[i]; } }
          const f32x4 ca = *(const LAS f32x4*)(LF + j * 64 + 8 * c8), cb = *(const LAS f32x4*)(LF + j * 64 + 8 * c8 + 4);
          const float cl[8] = {ca.x, ca.y, ca.z, ca.w, cb.x, cb.y, cb.z, cb.w};
          const float qr[8] = {bflo(rq.x), bfhi(rq.x), bflo(rq.y), bfhi(rq.y), bflo(rq.z), bfhi(rq.z), bflo(rq.w), bfhi(rq.w)};
          float qt[8], kt[8], qh[8], kh[8];
#pragma unroll
          for (int i = 0; i < 8; ++i) { const float cum = cl[i] + off[i]; const float qs = qr[i] * sigm(qr[i]);
              qt[i] = qs * ex2(cum - mid[i]); kt[i] = kk[i] * ex2(mid[i] - cum); qh[i] = qs * ex2(cum); kh[i] = kk[i] * ex2(tot[i] - cum); }
          *(LAS u32x4*)(lds + O_QT + j * RP + c8 * 16) = (u32x4){pk2(qt[0], qt[1]), pk2(qt[2], qt[3]), pk2(qt[4], qt[5]), pk2(qt[6], qt[7])};
          *(LAS u32x4*)(lds + O_KT + j * RP + c8 * 16) = (u32x4){pk2(kt[0], kt[1]), pk2(kt[2], kt[3]), pk2(kt[4], kt[5]), pk2(kt[6], kt[7])};
          *(LAS u32x4*)(lds + O_QH + j * RP + c8 * 16) = (u32x4){pk2(qh[0], qh[1]), pk2(qh[2], qh[3]), pk2(qh[4], qh[5]), pk2(qh[6], qh[7])};
          LAS bf16_t* khp = (LAS bf16_t*)(lds + O_KH) + (8 * c8) * 72 + j;
          LAS bf16_t* vtp = (LAS bf16_t*)(lds + O_VT) + (8 * c8) * 72 + j;
          const unsigned vw[4] = {ri.x, ri.y, ri.z, ri.w};
#pragma unroll
          for (int i = 0; i < 8; ++i) { khp[i * 72] = f2bf(kh[i]); vtp[i * 72] = (bf16_t)((i & 1) ? (vw[i >> 1] >> 16) : (vw[i >> 1] & 0xffffu)); }
          if (j == 0) { *(LAS f32x4*)(DL + 8 * c8) = (f32x4){ex2(tot[0]), ex2(tot[1]), ex2(tot[2]), ex2(tot[3])}; *(LAS f32x4*)(DL + 8 * c8 + 4) = (f32x4){ex2(tot[4]), ex2(tot[5]), ex2(tot[6]), ex2(tot[7])}; } }
        __syncthreads();
        { const LAS unsigned char* STc = lds + ((c & 1) ? O_ST1 : O_ST0);
          LAS unsigned char* STn = lds + ((c & 1) ? O_ST0 : O_ST1);
          if (w < 4) {
              const int I = w >> 1, DV = w & 1;
              f32x16 o;
#pragma unroll
              for (int r = 0; r < 16; ++r) o[r] = 0.f;
#pragma unroll
              for (int ks = 0; ks < 4; ++ks) { const bf16x8 a = *(const LAS bf16x8*)(lds + O_QH + (32 * I + r32) * RP + (16 * ks + 8 * hi) * 2);
                  const bf16x8 b = *(const LAS bf16x8*)(STc + (32 * DV + r32) * RP + (16 * ks + 8 * hi) * 2); o = MFMA32(a, b, o); }
              for (int J = 0; J <= I; ++J) {
                  f32x16 p;
#pragma unroll
                  for (int r = 0; r < 16; ++r) p[r] = 0.f;
#pragma unroll
                  for (int ks = 0; ks < 4; ++ks) { const bf16x8 a = *(const LAS bf16x8*)(lds + O_KT + (32 * J + r32) * RP + (16 * ks + 8 * hi) * 2);
                      const bf16x8 b = *(const LAS bf16x8*)(lds + O_QT + (32 * I + r32) * RP + (16 * ks + 8 * hi) * 2); p = MFMA32(a, b, p); }
                  if (J == I) {
#pragma unroll
                      for (int r = 0; r < 16; ++r) if (crow(r, hi) > r32) p[r] = 0.f;
                  }
#pragma unroll
                  for (int k2 = 0; k2 < 2; ++k2) {
                      u32x4 pw;
                      if (k2 == 0) pw = (u32x4){pk2(p[0], p[1]), pk2(p[2], p[3]), pk2(p[4], p[5]), pk2(p[6], p[7])};
                      else pw = (u32x4){pk2(p[8], p[9]), pk2(p[10], p[11]), pk2(p[12], p[13]), pk2(p[14], p[15])};
                      const LAS unsigned char* vp = lds + O_VT + (32 * DV + r32) * RP + (32 * J + 16 * k2 + 4 * hi) * 2;
                      const u32x2 lo = *(const LAS u32x2*)vp, h2 = *(const LAS u32x2*)(vp + 16);
                      const u32x4 vw4 = (u32x4){lo.x, lo.y, h2.x, h2.y};
                      o = MFMA32(__builtin_bit_cast(bf16x8, pw), __builtin_bit_cast(bf16x8, vw4), o);
                  }
              }
#pragma unroll
              for (int r = 0; r < 16; ++r) OB[(32 * I + crow(r, hi)) * 68 + 32 * DV + r32] = o[r];
          } else {
              const int ww = w - 4, Dt = ww >> 1, DV = ww & 1;
#pragma unroll
              for (int g4 = 0; g4 < 4; ++g4) { const f32x4 dl = *(const LAS f32x4*)(DL + 32 * Dt + 8 * g4 + 4 * hi);
#pragma unroll
                  for (int e = 0; e < 4; ++e) st[4 * g4 + e] *= dl[e]; }
#pragma unroll
              for (int ks = 0; ks < 4; ++ks) { const bf16x8 a = *(const LAS bf16x8*)(lds + O_KH + (32 * Dt + r32) * RP + (16 * ks + 8 * hi) * 2);
                  const bf16x8 b = *(const LAS bf16x8*)(lds + O_VT + (32 * DV + r32) * RP + (16 * ks + 8 * hi) * 2); st = MFMA32(a, b, st); }
#pragma unroll
              for (int g4 = 0; g4 < 4; ++g4) *(LAS u32x2*)(STn + (32 * DV + r32) * RP + (32 * Dt + 8 * g4 + 4 * hi) * 2) = (u32x2){pk2(st[4 * g4], st[4 * g4 + 1]), pk2(st[4 * g4 + 2], st[4 * g4 + 3])};
          } }
        __syncthreads();
        { const f32x4 a = *(const LAS f32x4*)(OB + j * 68 + 8 * c8), b = *(const LAS f32x4*)(OB + j * 68 + 8 * c8 + 4);
          const float ov[8] = {a.x, a.y, a.z, a.w, b.x, b.y, b.z, b.w};
          float ss = 0.f;
#pragma unroll
          for (int i = 0; i < 8; ++i) ss += ov[i] * ov[i];
          ss += shx(ss, 1, lane); ss += shx(ss, 2, lane); ss += shx(ss, 4, lane);
          const float r = 1.0f / sqrtf(ss * (1.0f / 64.0f) + EPS);
          const float gr[8] = {bflo(rg.x), bfhi(rg.x), bflo(rg.y), bfhi(rg.y), bflo(rg.z), bfhi(rg.z), bflo(rg.w), bfhi(rg.w)};
          float ou[8];
#pragma unroll
          for (int i = 0; i < 8; ++i) ou[i] = ov[i] * r * ngv[i] * (gr[i] * sigm(gr[i]));
          *(u32x4*)(Y + (rb + (size_t)c * 64 + j) * 1536 + 512 + h * 64 + 8 * c8) = (u32x4){pk2(ou[0], ou[1]), pk2(ou[2], ou[3]), pk2(ou[4], ou[5]), pk2(ou[6], ou[7])}; }
    }
    __syncthreads();
}

__device__ __forceinline__ void tr_item(const float* W, int ldw, int k0, int nsrc0, bf16_t* WT, int ldt, int nrow0, LAS float* scr, int lane, bool zero) {
    if (!zero) {
#pragma unroll 8
        for (int i = 0; i < 32; ++i) { const int kk = 2 * i + (lane >> 5); scr[kk * 33 + (lane & 31)] = W[(size_t)(k0 + kk) * ldw + nsrc0 + (lane & 31)]; }
    }
    LDS_WAIT();
    const int c = lane & 7;
#pragma unroll
    for (int jj = 0; jj < 4; ++jj) { const int n = (lane >> 3) + 8 * jj; const LAS float* s = scr + (8 * c) * 33 + n;
        u32x4 o = (u32x4){0u, 0u, 0u, 0u};
        if (!zero) { o.x = pk2(s[0 * 33], s[1 * 33]); o.y = pk2(s[2 * 33], s[3 * 33]); o.z = pk2(s[4 * 33], s[5 * 33]); o.w = pk2(s[6 * 33], s[7 * 33]); }
        *(u32x4*)(WT + (size_t)(nrow0 + n) * ldt + k0 + 8 * c) = o; }
    LDS_WAIT();
}

struct Args { const float* in[17]; float* out; unsigned char* ws; };

__global__ void __launch_bounds__(512, 2) fwd_kernel(Args a) {
    extern __shared__ __attribute__((aligned(16))) unsigned char lds_raw[];
    cg::grid_group grid = cg::this_grid();
    LAS unsigned char* lds = (LAS unsigned char*)lds_raw;
    const int G = gridDim.x, NGW = G * 8;
    unsigned char* ws = a.ws;
    {
        OPAQUE_TID(tid); const int lane = tid & 63, wave = __builtin_amdgcn_readfirstlane(tid >> 6), gw = blockIdx.x * 8 + wave;
        LAS float* scr = (LAS float*)(lds + wave * 16384);
        constexpr int I_IN = 16 * 224, I_BR = 768, I_OUT = 512, I_F1 = 2048, I_F2 = 2048, I_L = I_IN + I_BR + I_OUT + I_F1 + I_F2;
        for (int it = gw; it < 2 * I_L; it += NGW) {
            const int l = it / I_L; int r = it % I_L;
            unsigned char* wl = ws + WS_W + (size_t)l * W_LAYER_REAL;
            if (r < I_IN) { const int kb = r / 224, nb = r % 224, n0 = 32 * nb; const bool zero = (n0 >= 4000 && n0 < 4096); const int ns = n0 < 4000 ? n0 : n0 - 96;
                tr_item(a.in[3] + (size_t)l * 1024 * 7072, 7072, 64 * kb, zero ? 0 : ns, (bf16_t*)(wl + WO_IN), 1024, n0, scr, lane, zero); continue; }
            r -= I_IN;
            if (r < I_BR) { const int z = r / 256, rr = r % 256, kb = rr / 32, nb = rr % 32;
                tr_item(a.in[11] + ((size_t)l * 3 + z) * 512 * 1024, 1024, 64 * kb, 32 * nb, (bf16_t*)(wl + WO_BR) + (size_t)z * 1024 * 512, 512, 32 * nb, scr, lane, false); continue; }
            r -= I_BR;
            if (r < I_OUT) { const int kb = r / 32, nb = r % 32; tr_item(a.in[12] + (size_t)l * 1024 * 1024, 1024, 64 * kb, 32 * nb, (bf16_t*)(wl + WO_OUT), 1024, 32 * nb, scr, lane, false); continue; }
            r -= I_OUT;
            if (r < I_F1) { const int kb = r / 128, nb = r % 128; tr_item(a.in[14] + (size_t)l * 1024 * 4096, 4096, 64 * kb, 32 * nb, (bf16_t*)(wl + WO_F1), 1024, 32 * nb, scr, lane, false); continue; }
            r -= I_F1;
            { const int kb = r / 32, nb = r % 32; tr_item(a.in[15] + (size_t)l * 4096 * 1024, 1024, 64 * kb, 32 * nb, (bf16_t*)(wl + WO_F2), 4096, 32 * nb, scr, lane, false); }
        }
        const int gt = blockIdx.x * 512 + tid, GT_ = G * 512;
        for (int idx = gt; idx < 2 * 86016; idx += GT_) {
            const int l = idx / 86016; int r = idx % 86016;
            unsigned char* wl = ws + WS_W + (size_t)l * W_LAYER_REAL;
            const float* wuq = a.in[9] + (size_t)l * 256 * 768; const float* wukv = a.in[10] + (size_t)l * 128 * 1024;
            float v[8]; bf16_t* dst;
            if (r < 61440) { const int n = r % 1280, kc = r / 1280; dst = (bf16_t*)(wl + WO_QK) + (size_t)n * 384 + 8 * kc;
#pragma unroll
                for (int i = 0; i < 8; ++i) { const int k = 8 * kc + i;
                    v[i] = (n < 768) ? (k < 256 ? wuq[(size_t)k * 768 + n] : 0.f) : (k >= 256 ? wukv[(size_t)(k - 256) * 1024 + ((n - 768) >> 6) * 128 + ((n - 768) & 63)] : 0.f); }
            } else { r -= 61440; const int n = r % 512, kc = r / 512; dst = (bf16_t*)(wl + WO_V) + (size_t)n * 384 + 8 * kc;
#pragma unroll
                for (int i = 0; i < 8; ++i) { const int k = 8 * kc + i; v[i] = (k >= 256) ? wukv[(size_t)(k - 256) * 1024 + (n >> 6) * 128 + 64 + (n & 63)] : 0.f; }
            }
            *(u32x4*)dst = (u32x4){pk2(v[0], v[1]), pk2(v[2], v[3]), pk2(v[4], v[5]), pk2(v[6], v[7])};
        }
    }
    grid.sync();

#pragma unroll 1
    for (int l = 0; l < 2; ++l) {
        unsigned char* wl = ws + WS_W + (size_t)l * W_LAYER_REAL;
        const bf16_t* Win_t = (const bf16_t*)(wl + WO_IN); const bf16_t* WQK_t = (const bf16_t*)(wl + WO_QK); const bf16_t* WV_t = (const bf16_t*)(wl + WO_V);
        const bf16_t* Wbr_t = (const bf16_t*)(wl + WO_BR); const bf16_t* Wout_t = (const bf16_t*)(wl + WO_OUT); const bf16_t* W1_t = (const bf16_t*)(wl + WO_F1); const bf16_t* W2_t = (const bf16_t*)(wl + WO_F2);
        const float* xin = (l == 0) ? a.in[0] : a.out;
#pragma unroll 1
        for (int hf = 0; hf < 2; ++hf) {
            const size_t R0 = (size_t)hf * MH;
            unsigned char* wsq = a.ws; asm volatile("" : "+s"(wsq));
            unsigned* ctl = (unsigned*)(wsq + WS_CTL);
            bf16_t* XN = (bf16_t*)(wsq + WS_XN); bf16_t* CAT = (bf16_t*)(wsq + WS_CAT); bf16_t* KR = (bf16_t*)(wsq + WS_KR); float* CS = (float*)(wsq + WS_CS);
            bf16_t* P = (bf16_t*)(wsq + WS_P); bf16_t* GT = (bf16_t*)(wsq + WS_G); bf16_t* Q = (bf16_t*)(wsq + WS_Q); bf16_t* KN = (bf16_t*)(wsq + WS_KN); bf16_t* VT = (bf16_t*)(wsq + WS_VT);
            bf16_t* Y = (bf16_t*)(wsq + WS_Y); bf16_t* MG = (bf16_t*)(wsq + WS_MG);
            norm_rows_bf16(xin + R0 * DM, a.in[2] + l * DM, XN, MH, NGW);
            grid.sync();
            { pg8::Gemm g{XN, Win_t, MH, NIN, DM, DM, DM, 0, 0}; pg8::StaticOrder S; S.init(MH, NIN, G, (int)blockIdx.x);
              pg8::EpiSplit<0, 1> E{P, 4096, 16, GT, 3072};
              pg8::gemm_phase(lds, g, S, E); }
            grid.sync();
            mla_prep(P, (const int*)a.in[1] + R0, a.in[7] + l * 256, a.in[8] + l * 128, CAT, KR, CS, NGW);
            grid.sync();
            { pg8::Gemm g{CAT, WQK_t, MH, 1280, 384, 384, 384, 0, 0}; pg8::StaticOrder S; S.init(MH, 1280, G, (int)blockIdx.x);
              pg8::EpiSplit<0, 0> E{Q, 768, 3, KN, 512};
              pg8::gemm_phase(lds, g, S, E); }
            { pg8::Gemm g{WV_t, CAT, 512, MH, 384, 384, 384, 0, 0}; pg8::StaticOrder S; S.init(512, MH, G, (int)blockIdx.x);
              pg8::EpiSplit<0, 0> E{VT, MH, 1 << 30, VT, MH};
              pg8::gemm_phase(lds, g, S, E); }
            grid.sync();
            {
                OPAQUE_TID(tid);
                unsigned* ctr = ctl + 64 * (l * 2 + hf);
                LAS int* slot = (LAS int*)(lds + 131072);
                for (;;) {
                    if (tid == 0) slot[0] = (int)__hip_atomic_fetch_add(ctr, 1u, __ATOMIC_RELAXED, __HIP_MEMORY_SCOPE_AGENT);
                    __syncthreads();
                    const int item = __builtin_amdgcn_readfirstlane(slot[0]);
                    __syncthreads();
                    if (item >= 16 + 512 + 512) break;
                    if (item < 16) hgrn_unit(P, a.in[5], a.in[6] + l * 64, Y, l, item >> 3, item & 7, lds);
                    else if (item < 16 + 512) { const int k = item - 16; mla_unit(Q, KN, KR, VT, CS, Y, (k & 15) >> 3, k & 7, 31 - (k >> 4), lds); }
                    else { const int k = item - 528; bandattn_unit(P, a.in[4] + ((size_t)l * 8 + (k & 7)) * 257, Y, (k & 15) >> 3, k & 7, k >> 4, lds); }
                }
            }
            grid.sync();
            { pg8::Gemm g{Y, Wbr_t, MH, 1024, 512, 1536, 512, (size_t)512 * 2, (size_t)1024 * 512 * 2}; pg8::BranchOrder S{G, (int)blockIdx.x};
              pg8::EpiBranch E{GT, MG};
              pg8::gemm_phase(lds, g, S, E); }
            grid.sync();
            { pg8::Gemm g{MG, Wout_t, MH, DM, DM, DM, DM, 0, 0}; pg8::StaticOrder S; S.init(MH, DM, G, (int)blockIdx.x);
              pg8::EpiResid E{xin + R0 * DM, a.out + R0 * DM};
              pg8::gemm_phase(lds, g, S, E); }
            grid.sync();
        }
        unsigned char* wsf = a.ws; asm volatile("" : "+s"(wsf));
        bf16_t* XN = (bf16_t*)(wsf + WS_XN); bf16_t* HB = (bf16_t*)(wsf + WS_H);
        norm_rows_bf16(a.out, a.in[13] + l * DM, XN, MTOT, NGW);
        grid.sync();
        { pg8::Gemm g{XN, W1_t, MTOT, FF, DM, DM, DM, 0, 0}; pg8::StaticOrder S; S.init(MTOT, FF, G, (int)blockIdx.x);
          pg8::EpiSplit<2, 2> E{HB, FF, 1 << 30, HB, FF};
          pg8::gemm_phase(lds, g, S, E); }
        grid.sync();
        { pg8::Gemm g{HB, W2_t, MTOT, DM, FF, FF, FF, 0, 0}; pg8::StaticOrder S; S.init(MTOT, DM, G, (int)blockIdx.x);
          pg8::EpiResid E{a.out, a.out};
          pg8::gemm_phase(lds, g, S, E); }
        grid.sync();
    }
    norm_rows_f32_inplace(a.out, a.in[16], MTOT, NGW);
}

extern "C" void kernel_launch(void* const* d_in, const int* in_sizes, int n_in, void* d_out, int out_size, void* d_ws, size_t ws_size, hipStream_t stream) {
    static int grid = 0;
    if (grid == 0) {
        int dev = 0, cus = 0, per_cu = 0;
        (void)hipGetDevice(&dev);
        (void)hipDeviceGetAttribute(&cus, hipDeviceAttributeMultiprocessorCount, dev);
        (void)hipFuncSetAttribute((const void*)fwd_kernel, hipFuncAttributeMaxDynamicSharedMemorySize, LDS_BYTES);
        (void)hipOccupancyMaxActiveBlocksPerMultiprocessor(&per_cu, (const void*)fwd_kernel, 512, LDS_BYTES);
        if (per_cu < 1) per_cu = 1;
        grid = cus * per_cu;
        if (ws_size < (size_t)504 * MiB) fprintf(stderr, "kernel_launch: workspace too small (%zu)\n", ws_size);
    }
    (void)hipMemsetAsync((char*)d_ws + WS_CTL, 0, 4096, stream);
    Args a{};
    for (int i = 0; i < 17; ++i) a.in[i] = (const float*)d_in[i];
    a.out = (float*)d_out; a.ws = (unsigned char*)d_ws;
    void* args[] = {&a};
    hipError_t e = hipLaunchCooperativeKernel((void*)fwd_kernel, dim3(grid), dim3(512), args, LDS_BYTES, stream);
    if (e != hipSuccess) fprintf(stderr, "cooperative launch failed: %s (grid %d)\n", hipGetErrorString(e), grid);
}
```

```cpp
#include <hip/hip_runtime.h>
#include <hip/hip_cooperative_groups.h>
#include <cstdio>
#include <cstdint>
namespace cg = cooperative_groups;

#define LAS __attribute__((address_space(3)))
typedef unsigned short bf16_t;
typedef short bf16x8 __attribute__((ext_vector_type(8)));
typedef float f32x4 __attribute__((ext_vector_type(4)));
typedef float f32x16 __attribute__((ext_vector_type(16)));
typedef unsigned u32x4 __attribute__((ext_vector_type(4)));
typedef unsigned u32x2 __attribute__((ext_vector_type(2)));
typedef float f32x2_t __attribute__((ext_vector_type(2)));
typedef __bf16 bf16x2_t __attribute__((ext_vector_type(2)));

__device__ __forceinline__ unsigned pk2(float lo, float hi) { f32x2_t v = {lo, hi}; bf16x2_t b = __builtin_convertvector(v, bf16x2_t); return __builtin_bit_cast(unsigned, b); }
__device__ __forceinline__ bf16_t f2bf(float f) { return (bf16_t)(pk2(f, 0.f) & 0xffffu); }
__device__ __forceinline__ float bflo(unsigned w) { return __uint_as_float(w << 16); }
__device__ __forceinline__ float bfhi(unsigned w) { return __uint_as_float(w & 0xffff0000u); }
__device__ __forceinline__ float ex2(float x) { return __builtin_amdgcn_exp2f(x); }
__device__ __forceinline__ float sigm(float x) { return __builtin_amdgcn_rcpf(1.0f + ex2(-1.4426950408889634f * x)); }
__device__ __forceinline__ int crow(int r, int hi) { return (r & 3) + 8 * (r >> 2) + 4 * hi; }
__device__ __forceinline__ float shx(float v, int mask, int lane) { return __int_as_float(__builtin_amdgcn_ds_bpermute((lane ^ mask) << 2, __float_as_int(v))); }
__device__ __forceinline__ float wave_sum(float v, int lane) {
#pragma unroll
    for (int o = 1; o < 64; o <<= 1) v += shx(v, o, lane);
    return v;
}
#define LDS_WAIT() asm volatile("s_waitcnt lgkmcnt(0)" ::: "memory")
#define MFMA32(a, b, c) __builtin_amdgcn_mfma_f32_32x32x16_bf16((a), (b), (c), 0, 0, 0)

namespace pg8 {
constexpr int BM = 256, BK = 64, HALF = 128, HTB = HALF * BK * 2, STAGE_BYTES = 8 * HTB, NXCD = 8, WGM = 8;
__host__ __device__ __forceinline__ int lds_byte(int r, int c) { const int st = (r >> 4) * 2 + (c >> 5), rr = r & 15, cc = c & 31, ob = rr * 64 + cc * 2; return st * 1024 + (ob ^ (((ob >> 9) & 1) << 5)); }
__host__ __device__ __forceinline__ void stage_rc(int b, int& R, int& C) { const int st = b / 1024, sb = b % 1024, swz = sb ^ (((sb >> 9) & 1) << 5); R = (st >> 1) * 16 + swz / 64; C = (st & 1) * 32 + (swz % 64) / 2; }
__host__ __device__ __forceinline__ int perm32(int rho) { const int n = rho >> 4, i = rho & 15; return 8 * (i >> 2) + 4 * n + (i & 3); }

struct Unit { int pm, pn, z; };
struct Gemm { const bf16_t* A; const bf16_t* Bt; int M, N, K, lda, ldb; size_t za, zb; };

struct StaticOrder {
    int nM, nN, nwg, G, c;
    __device__ void init(int M, int N, int G_, int c_) { nM = M / BM; nN = N / BM; nwg = nM * nN; G = G_; c = c_; }
    __device__ bool next(int i, Unit& u) const {
        const long L = (long)i * G + c; if (L >= nwg) return false;
        int wgid = (int)L; { const int q = nwg / NXCD, r = nwg % NXCD, xcd = wgid % NXCD, off = wgid / NXCD; wgid = (xcd < r ? xcd * (q + 1) : r * (q + 1) + (xcd - r) * q) + off; }
        const int nig = WGM * nN, gid = wgid / nig, fm = gid * WGM, gsz = (nM - fm) < WGM ? (nM - fm) : WGM;
        u.pm = fm + ((wgid % nig) % gsz); u.pn = (wgid % nig) / gsz; u.z = 0; return true;
    }
};
struct BranchOrder {
    int G, c;
    __device__ bool next(int i, Unit& u) const {
        const int p = (i / 3) * G + c; if (p >= 256) return false;
        const int xcd = p & 7, off = p >> 3; u.pm = xcd * 8 + (off >> 2); u.pn = off & 3; u.z = i % 3; return true;
    }
};

template <int ACT0, int ACT1> struct EpiSplit {
    static constexpr bool PERM = true;
    bf16_t* O0; int ld0; int nsplit; bf16_t* O1; int ld1;
    __device__ __forceinline__ void operator()(const f32x4 (&acc)[2][2][4][2], const Unit& u, int wr, int wc, int fr, int fq) const {
        const bool first = u.pn < nsplit;
        bf16_t* base = first ? O0 : O1; const int ldc = first ? ld0 : ld1; const int colt = (first ? u.pn : u.pn - nsplit) * BM;
        const int act = first ? ACT0 : ACT1;
        const int row0 = u.pm * BM + wr * 64 + fr, col0 = colt + wc * 32 + 8 * fq;
#pragma unroll
        for (int ai = 0; ai < 2; ++ai)
#pragma unroll
            for (int m = 0; m < 4; ++m) { bf16_t* rowp = base + (size_t)(row0 + ai * HALF + m * 16) * ldc + col0;
#pragma unroll
                for (int bj = 0; bj < 2; ++bj) { f32x4 v0 = acc[ai][bj][m][0], v1 = acc[ai][bj][m][1];
                    if (act == 1) {
#pragma unroll
                        for (int e = 0; e < 4; ++e) { v0[e] = sigm(v0[e]); v1[e] = sigm(v1[e]); }
                    } else if (act == 2) {
#pragma unroll
                        for (int e = 0; e < 4; ++e) { const float a = fmaxf(v0[e], 0.f), b = fmaxf(v1[e], 0.f); v0[e] = a * a; v1[e] = b * b; }
                    }
                    u32x4 w; w.x = pk2(v0[0], v0[1]); w.y = pk2(v0[2], v0[3]); w.z = pk2(v1[0], v1[1]); w.w = pk2(v1[2], v1[3]);
                    *(u32x4*)(rowp + bj * HALF) = w; } }
    }
};
struct EpiBranch {
    static constexpr bool PERM = true;
    const bf16_t* Gt; bf16_t* Mg;
    __device__ __forceinline__ void operator()(const f32x4 (&acc)[2][2][4][2], const Unit& u, int wr, int wc, int fr, int fq) const {
        const int row0 = u.pm * BM + wr * 64 + fr, col0 = u.pn * BM + wc * 32 + 8 * fq;
#pragma unroll
        for (int ai = 0; ai < 2; ++ai)
#pragma unroll
            for (int m = 0; m < 4; ++m) { const size_t row = (size_t)(row0 + ai * HALF + m * 16);
#pragma unroll
                for (int bj = 0; bj < 2; ++bj) { const f32x4 v0 = acc[ai][bj][m][0], v1 = acc[ai][bj][m][1];
                    const u32x4 g = *(const u32x4*)(Gt + row * 3072 + u.z * 1024 + col0 + bj * HALF);
                    bf16_t* mp = Mg + row * 1024 + col0 + bj * HALF;
                    u32x4 pv = (u32x4){0u, 0u, 0u, 0u}; if (u.z > 0) pv = *(const u32x4*)mp;
                    float o[8];
                    o[0] = bflo(pv.x) + bflo(g.x) * v0[0]; o[1] = bfhi(pv.x) + bfhi(g.x) * v0[1]; o[2] = bflo(pv.y) + bflo(g.y) * v0[2]; o[3] = bfhi(pv.y) + bfhi(g.y) * v0[3];
                    o[4] = bflo(pv.z) + bflo(g.z) * v1[0]; o[5] = bfhi(pv.z) + bfhi(g.z) * v1[1]; o[6] = bflo(pv.w) + bflo(g.w) * v1[2]; o[7] = bfhi(pv.w) + bfhi(g.w) * v1[3];
                    u32x4 w; w.x = pk2(o[0], o[1]); w.y = pk2(o[2], o[3]); w.z = pk2(o[4], o[5]); w.w = pk2(o[6], o[7]);
                    *(u32x4*)mp = w; } }
    }
};
struct EpiResid {
    static constexpr bool PERM = true;
    const float* base; float* out;
    __device__ __forceinline__ void operator()(const f32x4 (&acc)[2][2][4][2], const Unit& u, int wr, int wc, int fr, int fq) const {
        const int row0 = u.pm * BM + wr * 64 + fr, col0 = u.pn * BM + wc * 32 + 8 * fq;
#pragma unroll
        for (int ai = 0; ai < 2; ++ai)
#pragma unroll
            for (int m = 0; m < 4; ++m) { const size_t off = (size_t)(row0 + ai * HALF + m * 16) * 1024 + col0;
#pragma unroll
                for (int bj = 0; bj < 2; ++bj) { const f32x4 b0 = *(const f32x4*)(base + off + bj * HALF), b1 = *(const f32x4*)(base + off + bj * HALF + 4);
                    *(f32x4*)(out + off + bj * HALF) = b0 + acc[ai][bj][m][0]; *(f32x4*)(out + off + bj * HALF + 4) = b1 + acc[ai][bj][m][1]; } }
    }
};

template <class Epi, class Sched>
__device__ __forceinline__ void gemm_phase(LAS unsigned char* lds, const Gemm g, const Sched& S, const Epi& E) {
    int tid = threadIdx.x; asm volatile("" : "+v"(tid));
    const int wid = __builtin_amdgcn_readfirstlane(tid >> 6), lane = tid & 63, wr = wid >> 2, wc = wid & 3, fr = lane & 15, fq = lane >> 4;
    const int K = g.K, nt = K / BK;
    unsigned voffA[2], voffB[2];
#pragma unroll
    for (int i = 0; i < 2; ++i) { int R, C; stage_rc(tid * 16 + i * 8192, R, C); const int Rb = Epi::PERM ? ((R & ~31) + perm32(R & 31)) : R;
        voffA[i] = (unsigned)(R * g.lda + C) * 2u; voffB[i] = (unsigned)(Rb * g.ldb + C) * 2u; }
    const size_t kstep = (size_t)(BK * 2);
    const size_t hstepA = (size_t)HALF * g.lda * 2, hstepB = (size_t)HALF * g.ldb * 2;
    const size_t tstepA = 2 * hstepA, tstepB = 2 * hstepB;
    const unsigned ldsw = (unsigned)wid * 1024u;
    const int aoff = lds_byte(wr * 64 + fr, fq * 8), boff = lds_byte(wc * 32 + fr, fq * 8);
#define PG8_SA(b, h) (((b) * 2 + (h)) * HTB)
#define PG8_SB(b, h) ((4 + (b) * 2 + (h)) * HTB)
#define PG8_STAGE(bufoff, gbase, voff) do { _Pragma("unroll") for (int _i = 0; _i < 2; ++_i) \
        __builtin_amdgcn_global_load_lds((const unsigned*)((const char*)(gbase) + (voff)[_i]), (LAS unsigned*)(lds + (bufoff) + ldsw + _i * 8192), 16, 0, 0); } while (0)
#define PG8_LDA(dst, b, h) do { _Pragma("unroll") for (int m = 0; m < 4; ++m) _Pragma("unroll") for (int k = 0; k < 2; ++k) dst[m][k] = *(const LAS bf16x8*)(lds + PG8_SA(b, h) + aoff + m * 2048 + k * 1024); } while (0)
#define PG8_LDB(dst, b, h) do { _Pragma("unroll") for (int n = 0; n < 2; ++n) _Pragma("unroll") for (int k = 0; k < 2; ++k) dst[n][k] = *(const LAS bf16x8*)(lds + PG8_SB(b, h) + boff + n * 2048 + k * 1024); } while (0)
#define PG8_MMA(ai, bj, At, Bt) do { __builtin_amdgcn_s_setprio(1); _Pragma("unroll") for (int m = 0; m < 4; ++m) _Pragma("unroll") for (int n = 0; n < 2; ++n) _Pragma("unroll") for (int k = 0; k < 2; ++k) \
        acc[ai][bj][m][n] = __builtin_amdgcn_mfma_f32_16x16x32_bf16(Bt[n][k], At[m][k], acc[ai][bj][m][n], 0, 0, 0); __builtin_amdgcn_s_setprio(0); } while (0)
#define PG8_WAIT_V(n) asm volatile("s_waitcnt vmcnt(" #n ")" ::: "memory")
#define PG8_WAIT_L(n) asm volatile("s_waitcnt lgkmcnt(" #n ")" ::: "memory")
#define PG8_BAR __builtin_amdgcn_s_barrier()
#define PG8_SCHED __builtin_amdgcn_sched_barrier(0)
    Unit cur, nxt; int ui = 0;
    if (!S.next(0, cur)) return;
    f32x4 acc[2][2][4][2];
#pragma unroll
    for (int a = 0; a < 2; ++a)
#pragma unroll
        for (int b = 0; b < 2; ++b)
#pragma unroll
            for (int m = 0; m < 4; ++m)
#pragma unroll
                for (int n = 0; n < 2; ++n) acc[a][b][m][n] = (f32x4){0.f, 0.f, 0.f, 0.f};
    bf16x8 At[4][2], B0[2][2], B1[2][2];
    const char* cA = (const char*)g.A + (size_t)cur.pm * tstepA + (size_t)cur.z * g.za; const char* cB = (const char*)g.Bt + (size_t)cur.pn * tstepB + (size_t)cur.z * g.zb;
    PG8_STAGE(PG8_SB(0, 0), cB, voffB); PG8_STAGE(PG8_SB(0, 1), cB + hstepB, voffB); PG8_STAGE(PG8_SA(0, 0), cA, voffA); PG8_STAGE(PG8_SA(0, 1), cA + hstepA, voffA);
    if (wr == 1) PG8_BAR;
    PG8_WAIT_V(2); PG8_BAR;
    PG8_STAGE(PG8_SB(1, 0), cB + kstep, voffB); PG8_STAGE(PG8_SA(1, 0), cA + kstep, voffA); PG8_STAGE(PG8_SB(1, 1), cB + hstepB + kstep, voffB);
    PG8_WAIT_V(6); PG8_BAR;
    for (;;) {
        const bool has_next = S.next(ui + 1, nxt);
        const char* nA = has_next ? (const char*)g.A + (size_t)nxt.pm * tstepA + (size_t)nxt.z * g.za : cA; const char* nB = has_next ? (const char*)g.Bt + (size_t)nxt.pn * tstepB + (size_t)nxt.z * g.zb : cB;
        for (int t = 0; t < nt; t += 2) {
            const bool last = (t == nt - 2);
            const char* a1 = cA + (size_t)(t + 1) * kstep;
            const char* a2 = last ? nA : cA + (size_t)(t + 2) * kstep; const char* b2 = last ? nB : cB + (size_t)(t + 2) * kstep;
            const char* a3 = a2 + kstep; const char* b3 = b2 + kstep;
            PG8_LDB(B0, 0, 0); PG8_LDB(B1, 0, 1); PG8_SCHED; PG8_LDA(At, 0, 0); PG8_STAGE(PG8_SA(1, 1), a1 + hstepA, voffA);
            PG8_WAIT_V(8); PG8_WAIT_L(0); PG8_BAR; PG8_MMA(0, 0, At, B0); PG8_MMA(0, 1, At, B1); PG8_BAR; PG8_SCHED;
            PG8_LDA(At, 0, 1); PG8_STAGE(PG8_SB(0, 0), b2, voffB); PG8_STAGE(PG8_SB(0, 1), b2 + hstepB, voffB); PG8_STAGE(PG8_SA(0, 0), a2, voffA);
            PG8_WAIT_V(8); PG8_WAIT_L(0); PG8_BAR; PG8_MMA(1, 0, At, B0); PG8_MMA(1, 1, At, B1); PG8_BAR; PG8_SCHED;
            PG8_LDB(B0, 1, 0); PG8_LDB(B1, 1, 1); PG8_SCHED; PG8_LDA(At, 1, 0); PG8_STAGE(PG8_SA(0, 1), a2 + hstepA, voffA);
            PG8_WAIT_V(8); PG8_WAIT_L(0); PG8_BAR; PG8_MMA(0, 0, At, B0); PG8_MMA(0, 1, At, B1); PG8_BAR; PG8_SCHED;
            PG8_LDA(At, 1, 1); PG8_STAGE(PG8_SB(1, 0), b3, voffB); PG8_STAGE(PG8_SB(1, 1), b3 + hstepB, voffB); PG8_STAGE(PG8_SA(1, 0), a3, voffA);
            PG8_WAIT_V(8); PG8_WAIT_L(0); PG8_BAR; PG8_MMA(1, 0, At, B0); PG8_MMA(1, 1, At, B1); PG8_BAR; PG8_SCHED;
        }
        if (wr == 0) PG8_BAR;
        { int t2_ = threadIdx.x; asm volatile("" : "+v"(t2_)); E(acc, cur, wr, wc, t2_ & 15, (t2_ >> 4) & 3); }
        if (!has_next) break;
#pragma unroll
        for (int a = 0; a < 2; ++a)
#pragma unroll
            for (int b = 0; b < 2; ++b)
#pragma unroll
                for (int m = 0; m < 4; ++m)
#pragma unroll
                    for (int n = 0; n < 2; ++n) acc[a][b][m][n] = (f32x4){0.f, 0.f, 0.f, 0.f};
        cur = nxt; cA = nA; cB = nB; ++ui;
        if (wr == 1) PG8_BAR;
    }
    PG8_WAIT_V(0);
    PG8_BAR;
#undef PG8_SA
#undef PG8_SB
#undef PG8_STAGE
#undef PG8_LDA
#undef PG8_LDB
#undef PG8_MMA
#undef PG8_WAIT_V
#undef PG8_WAIT_L
#undef PG8_BAR
#undef PG8_SCHED
}
}

constexpr int DM = 1024, SEQ = 8192, MTOT = 32768, MH = 16384, NIN = 7168, FF = 4096;
constexpr float EPS = 1e-6f, LOG2E = 1.4426950408889634f;
constexpr int LDS_BYTES = 147456;
constexpr size_t MiB = 1u << 20;
constexpr size_t WS_CTL = 0;
constexpr size_t WS_W = 1 * MiB, W_LAYER = 36 * MiB;
constexpr size_t WO_IN = 0, WO_QK = 14 * MiB, WO_V = 15 * MiB, WO_BR = 16 * MiB, WO_OUT = 19 * MiB, WO_F1 = 21 * MiB, WO_F2 = 29 * MiB;
constexpr size_t W_LAYER_REAL = 37 * MiB;
constexpr size_t WS_DL = 75 * MiB;
constexpr size_t WS_XN = 80 * MiB;
constexpr size_t WS_CAT = 112 * MiB;
constexpr size_t WS_KR = 124 * MiB;
constexpr size_t WS_CS = 125 * MiB;
constexpr size_t WS_P = 144 * MiB;
constexpr size_t WS_G = 272 * MiB;
constexpr size_t WS_Q = 368 * MiB;
constexpr size_t WS_KN = 392 * MiB;
constexpr size_t WS_VT = 408 * MiB;
constexpr size_t WS_Y = 424 * MiB;
constexpr size_t WS_MG = 472 * MiB;
constexpr size_t WS_H = 144 * MiB;
static_assert(WS_W + 2 * W_LAYER_REAL <= WS_XN, "weights fit");

#define OPAQUE_TID(t) int t = threadIdx.x; asm volatile("" : "+v"(t))
__device__ __forceinline__ void norm_rows_bf16(const float* x, const float* g, bf16_t* dst, int rows, int NGW) {
    OPAQUE_TID(tid_); const int lane = tid_ & 63, gw = blockIdx.x * 8 + __builtin_amdgcn_readfirstlane(tid_ >> 6);
    for (int m = gw; m < rows; m += NGW) {
        const f32x4* xr = (const f32x4*)(x + (size_t)m * DM) + lane;
        f32x4 v[4]; float s = 0.f;
#pragma unroll
        for (int j = 0; j < 4; ++j) { v[j] = xr[64 * j]; s += (v[j].x * v[j].x + v[j].y * v[j].y) + (v[j].z * v[j].z + v[j].w * v[j].w); }
        const float r = 1.0f / sqrtf(wave_sum(s, lane) * (1.0f / DM) + EPS);
        unsigned long long* o8 = (unsigned long long*)(dst + (size_t)m * DM) + lane;
#pragma unroll
        for (int j = 0; j < 4; ++j) { const f32x4 gg = ((const f32x4*)g)[lane + 64 * j];
            o8[64 * j] = (unsigned long long)pk2(v[j].x * r * gg.x, v[j].y * r * gg.y) | ((unsigned long long)pk2(v[j].z * r * gg.z, v[j].w * r * gg.w) << 32); }
    }
}
__device__ __forceinline__ void norm_rows_f32_inplace(float* x, const float* g, int rows, int NGW) {
    OPAQUE_TID(tid_); const int lane = tid_ & 63, gw = blockIdx.x * 8 + __builtin_amdgcn_readfirstlane(tid_ >> 6);
    for (int m = gw; m < rows; m += NGW) {
        f32x4* xr = (f32x4*)(x + (size_t)m * DM) + lane;
        f32x4 v[4]; float s = 0.f;
#pragma unroll
        for (int j = 0; j < 4; ++j) { v[j] = xr[64 * j]; s += (v[j].x * v[j].x + v[j].y * v[j].y) + (v[j].z * v[j].z + v[j].w * v[j].w); }
        const float r = 1.0f / sqrtf(wave_sum(s, lane) * (1.0f / DM) + EPS);
#pragma unroll
        for (int j = 0; j < 4; ++j) { const f32x4 gg = ((const f32x4*)g)[lane + 64 * j]; xr[64 * j] = v[j] * r * gg; }
    }
}
__device__ __forceinline__ void mla_prep(const bf16_t* P, const int* pos, const float* gq, const float* gkv, bf16_t* cat, bf16_t* kr, float* cs, int NGW) {
    OPAQUE_TID(tid_); const int lane = tid_ & 63, gw = blockIdx.x * 8 + __builtin_amdgcn_readfirstlane(tid_ >> 6);
    for (int m = gw; m < MH; m += NGW) {
        const bf16_t* prow = P + (size_t)m * 4096 + 3584;
        { const u32x2 w = *(const u32x2*)(prow + 4 * lane);
          const float a = bflo(w.x), b = bfhi(w.x), c = bflo(w.y), d = bfhi(w.y);
          const float r = 1.0f / sqrtf(wave_sum((a * a + b * b) + (c * c + d * d), lane) * (1.0f / 256.0f) + EPS);
          const f32x4 gg = ((const f32x4*)gq)[lane];
          u32x2 o; o.x = pk2(a * r * gg.x, b * r * gg.y); o.y = pk2(c * r * gg.z, d * r * gg.w);
          *(u32x2*)(cat + (size_t)m * 384 + 4 * lane) = o; }
        { const unsigned w = *(const unsigned*)(prow + 256 + 2 * lane);
          const float a = bflo(w), b = bfhi(w);
          const float r = 1.0f / sqrtf(wave_sum(a * a + b * b, lane) * (1.0f / 128.0f) + EPS);
          *(unsigned*)(cat + (size_t)m * 384 + 256 + 2 * lane) = pk2(a * r * gkv[2 * lane], b * r * gkv[2 * lane + 1]); }
        if (lane < 16) {
            const float x1 = __uint_as_float((unsigned)prow[384 + lane] << 16), x2 = __uint_as_float((unsigned)prow[400 + lane] << 16);
            const float invf = exp2f(-(float)lane * 0.83048202372184059f);
            double fr = (double)pos[m] * (double)invf * 0.15915494309189535;
            fr -= rint(fr);
            const float c = __builtin_amdgcn_cosf((float)fr), s = __builtin_amdgcn_sinf((float)fr);
            cs[(size_t)m * 32 + lane] = c; cs[(size_t)m * 32 + 16 + lane] = s;
            kr[(size_t)m * 32 + lane] = f2bf(x1 * c - x2 * s); kr[(size_t)m * 32 + 16 + lane] = f2bf(x2 * c + x1 * s);
        }
    }
}

constexpr int VP = 72;
template <int ND0, int KP>
__device__ __forceinline__ void qk_tile(const LAS unsigned char* Ks, const bf16x8 (&qf)[ND0], f32x16& p0, f32x16& p1, int r32, int hi) {
#pragma unroll
    for (int r = 0; r < 16; ++r) { p0[r] = 0.f; p1[r] = 0.f; }
#pragma unroll
    for (int d0 = 0; d0 < ND0; ++d0) {
        const bf16x8 a0 = *(const LAS bf16x8*)(Ks + r32 * (KP * 2) + (16 * d0 + 8 * hi) * 2);
        const bf16x8 a1 = *(const LAS bf16x8*)(Ks + (r32 + 32) * (KP * 2) + (16 * d0 + 8 * hi) * 2);
        p0 = MFMA32(a0, qf[d0], p0); p1 = MFMA32(a1, qf[d0], p1);
    }
}
__device__ __forceinline__ void softmax_pv(f32x16& p0, f32x16& p1, f32x16 (&o)[2], float& m_run, float& l_run, const LAS unsigned char* Vts, LAS float* sc, int r32, int hi) {
    float mx = fmaxf(p0[0], p1[0]);
#pragma unroll
    for (int r = 1; r < 16; ++r) mx = fmaxf(mx, fmaxf(p0[r], p1[r]));
    mx = fmaxf(mx, shx(mx, 32, r32 + 32 * hi));
    const float mn = fmaxf(m_run, mx);
    const float alpha = ex2(m_run - mn);
    m_run = mn;
    float s = 0.f;
#pragma unroll
    for (int r = 0; r < 16; ++r) { p0[r] = ex2(p0[r] - mn); p1[r] = ex2(p1[r] - mn); s += p0[r] + p1[r]; }
    l_run = l_run * alpha + s;
    if (hi == 0) sc[r32] = alpha;
    LDS_WAIT();
#pragma unroll
    for (int g4 = 0; g4 < 4; ++g4) { const f32x4 a = *(const LAS f32x4*)(sc + 8 * g4 + 4 * hi);
#pragma unroll
        for (int e = 0; e < 4; ++e) { o[0][4 * g4 + e] *= a[e]; o[1][4 * g4 + e] *= a[e]; } }
    LDS_WAIT();
#pragma unroll
    for (int ks = 0; ks < 4; ++ks) {
        u32x4 pw;
        if (ks == 0) pw = (u32x4){pk2(p0[0], p0[1]), pk2(p0[2], p0[3]), pk2(p0[4], p0[5]), pk2(p0[6], p0[7])};
        else if (ks == 1) pw = (u32x4){pk2(p0[8], p0[9]), pk2(p0[10], p0[11]), pk2(p0[12], p0[13]), pk2(p0[14], p0[15])};
        else if (ks == 2) pw = (u32x4){pk2(p1[0], p1[1]), pk2(p1[2], p1[3]), pk2(p1[4], p1[5]), pk2(p1[6], p1[7])};
        else pw = (u32x4){pk2(p1[8], p1[9]), pk2(p1[10], p1[11]), pk2(p1[12], p1[13]), pk2(p1[14], p1[15])};
        const bf16x8 pa = __builtin_bit_cast(bf16x8, pw);
        const int kvb = 16 * (ks & 1) + 32 * (ks >> 1);
#pragma unroll
        for (int db = 0; db < 2; ++db) {
            const LAS unsigned char* vp = Vts + (32 * db + r32) * (VP * 2) + (kvb + 4 * hi) * 2;
            const u32x2 lo = *(const LAS u32x2*)vp, h2 = *(const LAS u32x2*)(vp + 16);
            const u32x4 vw = (u32x4){lo.x, lo.y, h2.x, h2.y};
            o[db] = MFMA32(pa, __builtin_bit_cast(bf16x8, vw), o[db]);
        }
    }
}
__device__ __forceinline__ void attn_finish(f32x16 (&o)[2], float l_run, bf16_t* y, size_t row0, int ldy, int col0, LAS float* sc, int r32, int hi) {
    const float lt = l_run + shx(l_run, 32, r32 + 32 * hi);
    if (hi == 0) sc[r32] = 1.0f / lt;
    LDS_WAIT();
#pragma unroll
    for (int g4 = 0; g4 < 4; ++g4) { const f32x4 a = *(const LAS f32x4*)(sc + 8 * g4 + 4 * hi);
#pragma unroll
        for (int e = 0; e < 4; ++e) { const int r = 4 * g4 + e; bf16_t* yp = y + (row0 + crow(r, hi)) * ldy + col0 + r32;
            yp[0] = f2bf(o[0][r] * a[e]); yp[32] = f2bf(o[1][r] * a[e]); } }
    LDS_WAIT();
}

__device__ __forceinline__ void mla_unit(const bf16_t* Q, const bf16_t* KN, const bf16_t* KR, const bf16_t* VT, const float* CS, bf16_t* Y, int bl, int h, int qb, LAS unsigned char* lds) {
    OPAQUE_TID(tid);
    constexpr int KP = 104, KBUF = 64 * KP * 2, VBUF = 64 * VP * 2, OFF_V = 2 * KBUF, OFF_SC = OFF_V + 2 * VBUF;
    const int lane = tid & 63, w = __builtin_amdgcn_readfirstlane(tid >> 6), r32 = lane & 31, hi = lane >> 5;
    const size_t rb = (size_t)bl * SEQ;
    LAS float* sc = (LAS float*)(lds + OFF_SC) + w * 32;
    const float QS = 0.10206207261596577f * LOG2E;
    bf16x8 qf[6];
    { const size_t qrow = rb + (size_t)qb * 256 + 32 * w + r32;
      const bf16_t* qp = Q + qrow * 768 + h * 96;
#pragma unroll
      for (int d0 = 0; d0 < 4; ++d0) { const u32x4 raw = *(const u32x4*)(qp + 16 * d0 + 8 * hi);
          u32x4 t; t.x = pk2(bflo(raw.x) * QS, bfhi(raw.x) * QS); t.y = pk2(bflo(raw.y) * QS, bfhi(raw.y) * QS); t.z = pk2(bflo(raw.z) * QS, bfhi(raw.z) * QS); t.w = pk2(bflo(raw.w) * QS, bfhi(raw.w) * QS);
          qf[d0] = __builtin_bit_cast(bf16x8, t); }
      const u32x4 r1 = *(const u32x4*)(qp + 64 + 8 * hi), r2 = *(const u32x4*)(qp + 80 + 8 * hi);
      const f32x4 c0 = *(const f32x4*)(CS + qrow * 32 + 8 * hi), c1 = *(const f32x4*)(CS + qrow * 32 + 8 * hi + 4);
      const f32x4 s0 = *(const f32x4*)(CS + qrow * 32 + 16 + 8 * hi), s1 = *(const f32x4*)(CS + qrow * 32 + 16 + 8 * hi + 4);
      const float x1[8] = {bflo(r1.x), bfhi(r1.x), bflo(r1.y), bfhi(r1.y), bflo(r1.z), bfhi(r1.z), bflo(r1.w), bfhi(r1.w)};
      const float x2[8] = {bflo(r2.x), bfhi(r2.x), bflo(r2.y), bfhi(r2.y), bflo(r2.z), bfhi(r2.z), bflo(r2.w), bfhi(r2.w)};
      const float cc[8] = {c0.x, c0.y, c0.z, c0.w, c1.x, c1.y, c1.z, c1.w}, ss[8] = {s0.x, s0.y, s0.z, s0.w, s1.x, s1.y, s1.z, s1.w};
      float o1[8], o2[8];
#pragma unroll
      for (int i = 0; i < 8; ++i) { o1[i] = (x1[i] * cc[i] - x2[i] * ss[i]) * QS; o2[i] = (x2[i] * cc[i] + x1[i] * ss[i]) * QS; }
      u32x4 t1 = (u32x4){pk2(o1[0], o1[1]), pk2(o1[2], o1[3]), pk2(o1[4], o1[5]), pk2(o1[6], o1[7])}, t2 = (u32x4){pk2(o2[0], o2[1]), pk2(o2[2], o2[3]), pk2(o2[4], o2[5]), pk2(o2[6], o2[7])};
      qf[4] = __builtin_bit_cast(bf16x8, t1); qf[5] = __builtin_bit_cast(bf16x8, t2); }
    const int T = 4 * qb + 4, tmax = 4 * qb + (w >> 1);
    const int krow = tid >> 3, kch = tid & 7;
    const int rrow = (tid & 255) >> 2, rch = tid & 3;
    const bf16_t* knp = KN + (rb + krow) * 512 + h * 64 + 8 * kch;
    const bf16_t* krp = KR + (rb + rrow) * 32 + 8 * rch;
    const bf16_t* vtp = VT + (size_t)(h * 64 + krow) * MH + rb + 8 * kch;
    u32x4 gk, gr = (u32x4){0u, 0u, 0u, 0u}, gv;
#define MLA_LOAD(t) do { gk = *(const u32x4*)(knp + (size_t)(t) * 64 * 512); if (tid < 256) gr = *(const u32x4*)(krp + (size_t)(t) * 64 * 32); gv = *(const u32x4*)(vtp + (size_t)(t) * 64); } while (0)
#define MLA_STORE(b) do { *(LAS u32x4*)(lds + (b) * KBUF + krow * (KP * 2) + kch * 16) = gk; if (tid < 256) *(LAS u32x4*)(lds + (b) * KBUF + rrow * (KP * 2) + 128 + rch * 16) = gr; \
        *(LAS u32x4*)(lds + OFF_V + (b) * VBUF + krow * (VP * 2) + kch * 16) = gv; } while (0)
    f32x16 o[2];
#pragma unroll
    for (int r = 0; r < 16; ++r) { o[0][r] = 0.f; o[1][r] = 0.f; }
    float m_run = -INFINITY, l_run = 0.f;
    MLA_LOAD(0); MLA_STORE(0);
    __syncthreads();
    for (int t = 0; t < T; ++t) {
        if (t + 1 < T) MLA_LOAD(t + 1);
        if (t <= tmax) {
            f32x16 p0, p1;
            qk_tile<6, KP>(lds + (t & 1) * KBUF, qf, p0, p1, r32, hi);
            softmax_pv(p0, p1, o, m_run, l_run, lds + OFF_V + (t & 1) * VBUF, sc, r32, hi);
        }
        if (t + 1 < T) MLA_STORE((t + 1) & 1);
        __syncthreads();
    }
#undef MLA_LOAD
#undef MLA_STORE
    attn_finish(o, l_run, Y, rb + (size_t)qb * 256 + 32 * w, 1536, 1024 + h * 64, sc, r32, hi);
    __syncthreads();
}

__device__ __forceinline__ void bandattn_unit(const bf16_t* P, const float* relb  , bf16_t* Y, int bl, int h, int grp, LAS unsigned char* lds) {
    OPAQUE_TID(tid);
    constexpr int KP = 72, KBUF = 64 * KP * 2, VBUF = 64 * VP * 2, OFF_V = 2 * KBUF, OFF_SC = OFF_V + 2 * VBUF, OFF_TB = OFF_SC + 8 * 128;
    const int lane = tid & 63, w = __builtin_amdgcn_readfirstlane(tid >> 6), r32 = lane & 31, hi = lane >> 5;
    const size_t rb = (size_t)bl * SEQ;
    LAS float* sc = (LAS float*)(lds + OFF_SC) + w * 32;
    LAS float* tb = (LAS float*)(lds + OFF_TB);
    if (tid < 257) tb[tid] = relb[tid] * LOG2E;
    const float QS = 0.125f * LOG2E;
    bf16x8 qf[4];
    { const size_t qrow = rb + (size_t)grp * 256 + 32 * w + r32;
      const bf16_t* qp = P + qrow * 4096 + h * 64;
#pragma unroll
      for (int d0 = 0; d0 < 4; ++d0) { const u32x4 raw = *(const u32x4*)(qp + 16 * d0 + 8 * hi);
          u32x4 t; t.x = pk2(bflo(raw.x) * QS, bfhi(raw.x) * QS); t.y = pk2(bflo(raw.y) * QS, bfhi(raw.y) * QS); t.z = pk2(bflo(raw.z) * QS, bfhi(raw.z) * QS); t.w = pk2(bflo(raw.w) * QS, bfhi(raw.w) * QS);
          qf[d0] = __builtin_bit_cast(bf16x8, t); } }
    const int c = 4 * grp + (w >> 1);
    const int kc0 = (4 * grp - 8) > 0 ? (4 * grp - 8) : 0, kc1 = 4 * grp + 3;
    const int krow = tid >> 3, kch = tid & 7;
    const int vkv = tid & 63, vch = tid >> 6;
    const bf16_t* kp = P + (rb + krow) * 4096 + 512 + h * 64 + 8 * kch;
    const bf16_t* vp = P + (rb + vkv) * 4096 + 1024 + h * 64 + 8 * vch;
    u32x4 gk, gv;
#define BA_LOAD(kc) do { gk = *(const u32x4*)(kp + (size_t)(kc) * 64 * 4096); gv = *(const u32x4*)(vp + (size_t)(kc) * 64 * 4096); } while (0)
#define BA_STORE(b) do { *(LAS u32x4*)(lds + (b) * KBUF + krow * (KP * 2) + kch * 16) = gk; \
        LAS bf16_t* vd = (LAS bf16_t*)(lds + OFF_V + (b) * VBUF) + (8 * vch) * VP + vkv; \
        vd[0 * VP] = (bf16_t)(gv.x & 0xffffu); vd[1 * VP] = (bf16_t)(gv.x >> 16); vd[2 * VP] = (bf16_t)(gv.y & 0xffffu); vd[3 * VP] = (bf16_t)(gv.y >> 16); \
        vd[4 * VP] = (bf16_t)(gv.z & 0xffffu); vd[5 * VP] = (bf16_t)(gv.z >> 16); vd[6 * VP] = (bf16_t)(gv.w & 0xffffu); vd[7 * VP] = (bf16_t)(gv.w >> 16); } while (0)
    f32x16 o[2];
#pragma unroll
    for (int r = 0; r < 16; ++r) { o[0][r] = 0.f; o[1][r] = 0.f; }
    float m_run = -INFINITY, l_run = 0.f;
    BA_LOAD(kc0); BA_STORE(0);
    __syncthreads();
    const int qpos = 64 * c + 32 * (w & 1) + r32;
    for (int kc = kc0, it = 0; kc <= kc1; ++kc, ++it) {
        if (kc + 1 <= kc1) BA_LOAD(kc + 1);
        if (kc >= c - 8 && kc <= c) {
            f32x16 p0, p1;
            qk_tile<4, KP>(lds + (it & 1) * KBUF, qf, p0, p1, r32, hi);
            if (c - kc >= 3) { const float bb = tb[256];
#pragma unroll
                for (int r = 0; r < 16; ++r) { p0[r] += bb; p1[r] += bb; }
            } else {
#pragma unroll
                for (int r = 0; r < 16; ++r) { const int d0 = qpos - (64 * kc + crow(r, hi));
                    int i0 = d0 < -128 ? -128 : (d0 > 128 ? 128 : d0), i1 = (d0 - 32) < -128 ? -128 : ((d0 - 32) > 128 ? 128 : (d0 - 32));
                    p0[r] += tb[i0 + 128]; p1[r] += tb[i1 + 128]; }
            }
            softmax_pv(p0, p1, o, m_run, l_run, lds + OFF_V + (it & 1) * VBUF, sc, r32, hi);
        }
        if (kc + 1 <= kc1) BA_STORE((it + 1) & 1);
        __syncthreads();
    }
#undef BA_LOAD
#undef BA_STORE
    attn_finish(o, l_run, Y, rb + (size_t)grp * 256 + 32 * w, 1536, h * 64, sc, r32, hi);
    __syncthreads();
}

__device__ __forceinline__ void hgrn_x_unit(bf16_t* P, const float* lbl, float* DLg, int layer, int bl, int h, int c, LAS unsigned char* lds) {
    OPAQUE_TID(tid);
    constexpr int RP = 144;
    constexpr int O_LF = 0, O_SEG = 16384, O_QT = 18432, O_KT = 27648, O_KH = 36864, O_VT = 46080;
    const int lane = tid & 63, w = __builtin_amdgcn_readfirstlane(tid >> 6), r32 = lane & 31, hi = lane >> 5;
    const int j = tid >> 3, c8 = tid & 7;
    const size_t rb = (size_t)bl * SEQ + (size_t)c * 64;
    LAS float* LF = (LAS float*)(lds + O_LF); LAS float* SEG = (LAS float*)(lds + O_SEG);
    bf16_t* base = P + (rb + j) * 4096 + h * 64 + 8 * c8;
    const u32x4 rq = *(const u32x4*)(base + 1536), rf = *(const u32x4*)(base + 2048), ri = *(const u32x4*)(base + 2560);
    float kk[8];
    { const float z[8] = {bflo(rf.x), bfhi(rf.x), bflo(rf.y), bfhi(rf.y), bflo(rf.z), bfhi(rf.z), bflo(rf.w), bfhi(rf.w)};
      float lf[8];
#pragma unroll
      for (int i = 0; i < 8; ++i) { const int d = h * 64 + 8 * c8 + i; const float lb = (layer == 0) ? 0.f : sigm(lbl[512 + d] - lbl[d]);
          const float sg = sigm(z[i]); const float f = lb + (1.0f - lb) * sg; lf[i] = fmaxf(__builtin_amdgcn_logf(f), -80.0f); kk[i] = (1.0f - lb) * (1.0f - sg); }
      *(LAS f32x4*)(LF + j * 64 + 8 * c8) = (f32x4){lf[0], lf[1], lf[2], lf[3]}; *(LAS f32x4*)(LF + j * 64 + 8 * c8 + 4) = (f32x4){lf[4], lf[5], lf[6], lf[7]}; }
    __syncthreads();
    { const int d = tid & 63, sg = tid >> 6; float v[8];
#pragma unroll
      for (int k = 0; k < 8; ++k) v[k] = LF[(8 * sg + k) * 64 + d];
#pragma unroll
      for (int k = 1; k < 8; ++k) v[k] += v[k - 1];
#pragma unroll
      for (int k = 0; k < 8; ++k) LF[(8 * sg + k) * 64 + d] = v[k];
      SEG[sg * 64 + d] = v[7]; }
    __syncthreads();
    { const int sg = j >> 3;
      float off[8], tot[8], mid[8];
#pragma unroll
      for (int i = 0; i < 8; ++i) { off[i] = 0.f; tot[i] = 0.f; mid[i] = 0.f; }
#pragma unroll
      for (int s2 = 0; s2 < 8; ++s2) { const f32x4 a = *(const LAS f32x4*)(SEG + s2 * 64 + 8 * c8), b = *(const LAS f32x4*)(SEG + s2 * 64 + 8 * c8 + 4);
          const float v8[8] = {a.x, a.y, a.z, a.w, b.x, b.y, b.z, b.w};
#pragma unroll
          for (int i = 0; i < 8; ++i) { if (s2 < sg) off[i] += v8[i]; tot[i] += v8[i]; if (s2 == 3) mid[i] = tot[i]; } }
      const f32x4 ca = *(const LAS f32x4*)(LF + j * 64 + 8 * c8), cb = *(const LAS f32x4*)(LF + j * 64 + 8 * c8 + 4);
      const float cl[8] = {ca.x, ca.y, ca.z, ca.w, cb.x, cb.y, cb.z, cb.w};
      const float qr[8] = {bflo(rq.x), bfhi(rq.x), bflo(rq.y), bfhi(rq.y), bflo(rq.z), bfhi(rq.z), bflo(rq.w), bfhi(rq.w)};
      float qt[8], kt[8], qh[8], kh[8];
#pragma unroll
      for (int i = 0; i < 8; ++i) { const float cum = cl[i] + off[i]; const float qs = qr[i] * sigm(qr[i]);
          qt[i] = qs * ex2(cum - mid[i]); kt[i] = kk[i] * ex2(mid[i] - cum); qh[i] = qs * ex2(cum); kh[i] = kk[i] * ex2(tot[i] - cum); }
      *(LAS u32x4*)(lds + O_QT + j * RP + c8 * 16) = (u32x4){pk2(qt[0], qt[1]), pk2(qt[2], qt[3]), pk2(qt[4], qt[5]), pk2(qt[6], qt[7])};
      *(LAS u32x4*)(lds + O_KT + j * RP + c8 * 16) = (u32x4){pk2(kt[0], kt[1]), pk2(kt[2], kt[3]), pk2(kt[4], kt[5]), pk2(kt[6], kt[7])};
      *(u32x4*)(base + 1536) = (u32x4){pk2(qh[0], qh[1]), pk2(qh[2], qh[3]), pk2(qh[4], qh[5]), pk2(qh[6], qh[7])};
      LAS bf16_t* khp = (LAS bf16_t*)(lds + O_KH) + (8 * c8) * 72 + j;
      LAS bf16_t* vtp = (LAS bf16_t*)(lds + O_VT) + (8 * c8) * 72 + j;
      const unsigned vw[4] = {ri.x, ri.y, ri.z, ri.w};
#pragma unroll
      for (int i = 0; i < 8; ++i) { khp[i * 72] = f2bf(kh[i]); vtp[i * 72] = (bf16_t)((i & 1) ? (vw[i >> 1] >> 16) : (vw[i >> 1] & 0xffffu)); }
      if (j == 0) { float* dlp = DLg + ((size_t)((bl * 8 + h) * 128 + c)) * 64 + 8 * c8;
          *(f32x4*)dlp = (f32x4){ex2(tot[0]), ex2(tot[1]), ex2(tot[2]), ex2(tot[3])}; *(f32x4*)(dlp + 4) = (f32x4){ex2(tot[4]), ex2(tot[5]), ex2(tot[6]), ex2(tot[7])}; } }
    __syncthreads();
    if (w < 4) {
        const int I = w >> 1, DV = w & 1;
        f32x16 o;
#pragma unroll
        for (int r = 0; r < 16; ++r) o[r] = 0.f;
        for (int J = 0; J <= I; ++J) {
            f32x16 p;
#pragma unroll
            for (int r = 0; r < 16; ++r) p[r] = 0.f;
#pragma unroll
            for (int ks = 0; ks < 4; ++ks) { const bf16x8 a = *(const LAS bf16x8*)(lds + O_KT + (32 * J + r32) * RP + (16 * ks + 8 * hi) * 2);
                const bf16x8 b = *(const LAS bf16x8*)(lds + O_QT + (32 * I + r32) * RP + (16 * ks + 8 * hi) * 2); p = MFMA32(a, b, p); }
            if (J == I) {
#pragma unroll
                for (int r = 0; r < 16; ++r) if (crow(r, hi) > r32) p[r] = 0.f;
            }
#pragma unroll
            for (int k2 = 0; k2 < 2; ++k2) {
                u32x4 pw;
                if (k2 == 0) pw = (u32x4){pk2(p[0], p[1]), pk2(p[2], p[3]), pk2(p[4], p[5]), pk2(p[6], p[7])};
                else pw = (u32x4){pk2(p[8], p[9]), pk2(p[10], p[11]), pk2(p[12], p[13]), pk2(p[14], p[15])};
                const LAS unsigned char* vp = lds + O_VT + (32 * DV + r32) * RP + (32 * J + 16 * k2 + 4 * hi) * 2;
                const u32x2 lo = *(const LAS u32x2*)vp, h2 = *(const LAS u32x2*)(vp + 16);
                const u32x4 vw4 = (u32x4){lo.x, lo.y, h2.x, h2.y};
                o = MFMA32(__builtin_bit_cast(bf16x8, pw), __builtin_bit_cast(bf16x8, vw4), o);
            }
        }
        bf16_t* op = P + (rb + 32 * I) * 4096 + 2048 + h * 64 + 32 * DV + r32;
#pragma unroll
        for (int r = 0; r < 16; ++r) op[(size_t)crow(r, hi) * 4096] = f2bf(o[r]);
    } else {
        const int ww = w - 4, Dt = ww >> 1, DV = ww & 1;
        f32x16 zt;
#pragma unroll
        for (int r = 0; r < 16; ++r) zt[r] = 0.f;
#pragma unroll
        for (int ks = 0; ks < 4; ++ks) { const bf16x8 a = *(const LAS bf16x8*)(lds + O_VT + (32 * DV + r32) * RP + (16 * ks + 8 * hi) * 2);
            const bf16x8 b = *(const LAS bf16x8*)(lds + O_KH + (32 * Dt + r32) * RP + (16 * ks + 8 * hi) * 2); zt = MFMA32(a, b, zt); }
        bf16_t* zp = P + (rb + 32 * DV) * 4096 + 2560 + h * 64 + 32 * Dt + r32;
#pragma unroll
        for (int r = 0; r < 16; ++r) zp[(size_t)crow(r, hi) * 4096] = f2bf(zt[r]);
    }
    __syncthreads();
}
__device__ __forceinline__ void hgrn_scan(bf16_t* P, const float* DLg, int slice) {
    OPAQUE_TID(tid);
    const int chain = slice >> 3, bl = chain >> 3, h = chain & 7, dv = 8 * (slice & 7) + (tid >> 6), d = tid & 63;
    bf16_t* p = P + ((size_t)bl * SEQ + dv) * 4096 + 2560 + h * 64 + d;
    const float* dl = DLg + (size_t)chain * 128 * 64 + d;
    float s = 0.f;
#pragma unroll 1
    for (int c0 = 0; c0 < 128; c0 += 8) {
        bf16_t z[8]; float e[8];
#pragma unroll
        for (int k = 0; k < 8; ++k) { z[k] = p[(size_t)(c0 + k) * 64 * 4096]; e[k] = dl[(c0 + k) * 64]; }
#pragma unroll
        for (int k = 0; k < 8; ++k) { s = e[k] * s + __uint_as_float((unsigned)z[k] << 16); p[(size_t)(c0 + k) * 64 * 4096] = f2bf(s); }
    }
}
__device__ __forceinline__ void hgrn_z_unit(const bf16_t* P, const float* ng, bf16_t* Y, int bl, int h, int cp, LAS unsigned char* lds) {
    OPAQUE_TID(tid);
    const int lane = tid & 63, w = __builtin_amdgcn_readfirstlane(tid >> 6), r32 = lane & 31, hi = lane >> 5;
    const size_t rb = (size_t)bl * SEQ;
    LAS float* OB = (LAS float*)lds;
    { const int cw = 2 * cp + (w >> 2), I = (w >> 1) & 1, DV = w & 1;
      f32x16 o;
#pragma unroll
      for (int r = 0; r < 16; ++r) o[r] = 0.f;
      if (cw > 0) {
          const bf16_t* ap = P + (rb + (size_t)cw * 64 + 32 * I + r32) * 4096 + 1536 + h * 64 + 8 * hi;
          const bf16_t* bp = P + (rb + (size_t)(cw - 1) * 64 + 32 * DV + r32) * 4096 + 2560 + h * 64 + 8 * hi;
#pragma unroll
          for (int ks = 0; ks < 4; ++ks) { const bf16x8 a = *(const bf16x8*)(ap + 16 * ks), b = *(const bf16x8*)(bp + 16 * ks); o = MFMA32(a, b, o); }
      }
#pragma unroll
      for (int r = 0; r < 16; ++r) OB[((w >> 2) * 64 + 32 * I + crow(r, hi)) * 68 + 32 * DV + r32] = o[r]; }
    __syncthreads();
    const int c8 = tid & 7;
    float ngv[8];
#pragma unroll
    for (int i = 0; i < 8; ++i) ngv[i] = ng[8 * c8 + i];
#pragma unroll
    for (int it = 0; it < 2; ++it) {
        const int row = it * 64 + (tid >> 3);
        const bf16_t* pr = P + (rb + (size_t)cp * 128 + row) * 4096 + h * 64 + 8 * c8;
        const u32x4 oi = *(const u32x4*)(pr + 2048), rg = *(const u32x4*)(pr + 3072);
        const f32x4 a = *(const LAS f32x4*)(OB + row * 68 + 8 * c8), b = *(const LAS f32x4*)(OB + row * 68 + 8 * c8 + 4);
        const float ov[8] = {a.x + bflo(oi.x), a.y + bfhi(oi.x), a.z + bflo(oi.y), a.w + bfhi(oi.y), b.x + bflo(oi.z), b.y + bfhi(oi.z), b.z + bflo(oi.w), b.w + bfhi(oi.w)};
        float ss = 0.f;
#pragma unroll
        for (int i = 0; i < 8; ++i) ss += ov[i] * ov[i];
        ss += shx(ss, 1, lane); ss += shx(ss, 2, lane); ss += shx(ss, 4, lane);
        const float r = 1.0f / sqrtf(ss * (1.0f / 64.0f) + EPS);
        const float gr[8] = {bflo(rg.x), bfhi(rg.x), bflo(rg.y), bfhi(rg.y), bflo(rg.z), bfhi(rg.z), bflo(rg.w), bfhi(rg.w)};
        float ou[8];
#pragma unroll
        for (int i = 0; i < 8; ++i) ou[i] = ov[i] * r * ngv[i] * (gr[i] * sigm(gr[i]));
        *(u32x4*)(Y + (rb + (size_t)cp * 128 + row) * 1536 + 512 + h * 64 + 8 * c8) = (u32x4){pk2(ou[0], ou[1]), pk2(ou[2], ou[3]), pk2(ou[4], ou[5]), pk2(ou[6], ou[7])};
    }
    __syncthreads();
}

__device__ __forceinline__ void tr_item(const float* W, int ldw, int k0, int nsrc0, bf16_t* WT, int ldt, int nrow0, LAS float* scr, int lane, bool zero) {
    if (!zero) {
#pragma unroll 8
        for (int i = 0; i < 32; ++i) { const int kk = 2 * i + (lane >> 5); scr[kk * 33 + (lane & 31)] = W[(size_t)(k0 + kk) * ldw + nsrc0 + (lane & 31)]; }
    }
    LDS_WAIT();
    const int c = lane & 7;
#pragma unroll
    for (int jj = 0; jj < 4; ++jj) { const int n = (lane >> 3) + 8 * jj; const LAS float* s = scr + (8 * c) * 33 + n;
        u32x4 o = (u32x4){0u, 0u, 0u, 0u};
        if (!zero) { o.x = pk2(s[0 * 33], s[1 * 33]); o.y = pk2(s[2 * 33], s[3 * 33]); o.z = pk2(s[4 * 33], s[5 * 33]); o.w = pk2(s[6 * 33], s[7 * 33]); }
        *(u32x4*)(WT + (size_t)(nrow0 + n) * ldt + k0 + 8 * c) = o; }
    LDS_WAIT();
}

struct Args { const float* in[17]; float* out; unsigned char* ws; };

__global__ void __launch_bounds__(512, 2) fwd_kernel(Args a) {
    extern __shared__ __attribute__((aligned(16))) unsigned char lds_raw[];
    cg::grid_group grid = cg::this_grid();
    LAS unsigned char* lds = (LAS unsigned char*)lds_raw;
    const int G = gridDim.x, NGW = G * 8;
    typedef const __attribute__((address_space(4))) Args* KArgs;
#define KARGS(name) KArgs name = (KArgs)__builtin_amdgcn_kernarg_segment_ptr(); asm volatile("" : "+s"(name))
    {
        KARGS(ka);
        unsigned char* ws = ka->ws;
        OPAQUE_TID(tid); const int lane = tid & 63, wave = __builtin_amdgcn_readfirstlane(tid >> 6), gw = blockIdx.x * 8 + wave;
        LAS float* scr = (LAS float*)(lds + wave * 16384);
        constexpr int I_IN = 16 * 224, I_BR = 768, I_OUT = 512, I_F1 = 2048, I_F2 = 2048, I_L = I_IN + I_BR + I_OUT + I_F1 + I_F2;
        for (int it = gw; it < 2 * I_L; it += NGW) {
            const int l = it / I_L; int r = it % I_L;
            unsigned char* wl = ws + WS_W + (size_t)l * W_LAYER_REAL;
            if (r < I_IN) { const int kb = r / 224, nb = r % 224, n0 = 32 * nb; const bool zero = (n0 >= 4000 && n0 < 4096); const int ns = n0 < 4000 ? n0 : n0 - 96;
                tr_item(ka->in[3] + (size_t)l * 1024 * 7072, 7072, 64 * kb, zero ? 0 : ns, (bf16_t*)(wl + WO_IN), 1024, n0, scr, lane, zero); continue; }
            r -= I_IN;
            if (r < I_BR) { const int z = r / 256, rr = r % 256, kb = rr / 32, nb = rr % 32;
                tr_item(ka->in[11] + ((size_t)l * 3 + z) * 512 * 1024, 1024, 64 * kb, 32 * nb, (bf16_t*)(wl + WO_BR) + (size_t)z * 1024 * 512, 512, 32 * nb, scr, lane, false); continue; }
            r -= I_BR;
            if (r < I_OUT) { const int kb = r / 32, nb = r % 32; tr_item(ka->in[12] + (size_t)l * 1024 * 1024, 1024, 64 * kb, 32 * nb, (bf16_t*)(wl + WO_OUT), 1024, 32 * nb, scr, lane, false); continue; }
            r -= I_OUT;
            if (r < I_F1) { const int kb = r / 128, nb = r % 128; tr_item(ka->in[14] + (size_t)l * 1024 * 4096, 4096, 64 * kb, 32 * nb, (bf16_t*)(wl + WO_F1), 1024, 32 * nb, scr, lane, false); continue; }
            r -= I_F1;
            { const int kb = r / 32, nb = r % 32; tr_item(ka->in[15] + (size_t)l * 4096 * 1024, 1024, 64 * kb, 32 * nb, (bf16_t*)(wl + WO_F2), 4096, 32 * nb, scr, lane, false); }
        }
        const int gt = blockIdx.x * 512 + tid, GT_ = G * 512;
        for (int idx = gt; idx < 2 * 86016; idx += GT_) {
            const int l = idx / 86016; int r = idx % 86016;
            unsigned char* wl = ws + WS_W + (size_t)l * W_LAYER_REAL;
            const float* wuq = ka->in[9] + (size_t)l * 256 * 768; const float* wukv = ka->in[10] + (size_t)l * 128 * 1024;
            float v[8]; bf16_t* dst;
            if (r < 61440) { const int n = r % 1280, kc = r / 1280; dst = (bf16_t*)(wl + WO_QK) + (size_t)n * 384 + 8 * kc;
#pragma unroll
                for (int i = 0; i < 8; ++i) { const int k = 8 * kc + i;
                    v[i] = (n < 768) ? (k < 256 ? wuq[(size_t)k * 768 + n] : 0.f) : (k >= 256 ? wukv[(size_t)(k - 256) * 1024 + ((n - 768) >> 6) * 128 + ((n - 768) & 63)] : 0.f); }
            } else { r -= 61440; const int n = r % 512, kc = r / 512; dst = (bf16_t*)(wl + WO_V) + (size_t)n * 384 + 8 * kc;
#pragma unroll
                for (int i = 0; i < 8; ++i) { const int k = 8 * kc + i; v[i] = (k >= 256) ? wukv[(size_t)(k - 256) * 1024 + (n >> 6) * 128 + 64 + (n & 63)] : 0.f; }
            }
            *(u32x4*)dst = (u32x4){pk2(v[0], v[1]), pk2(v[2], v[3]), pk2(v[4], v[5]), pk2(v[6], v[7])};
        }
    }
    grid.sync();

#pragma unroll 1
    for (int l = 0; l < 2; ++l) {
        KARGS(ka); unsigned char* ws = ka->ws;
        unsigned char* wl = ws + WS_W + (size_t)l * W_LAYER_REAL;
        const bf16_t* Win_t = (const bf16_t*)(wl + WO_IN); const bf16_t* WQK_t = (const bf16_t*)(wl + WO_QK); const bf16_t* WV_t = (const bf16_t*)(wl + WO_V);
        const bf16_t* Wbr_t = (const bf16_t*)(wl + WO_BR); const bf16_t* Wout_t = (const bf16_t*)(wl + WO_OUT); const bf16_t* W1_t = (const bf16_t*)(wl + WO_F1); const bf16_t* W2_t = (const bf16_t*)(wl + WO_F2);
        const float* xin = (l == 0) ? ka->in[0] : ka->out;
#pragma unroll 1
        for (int hf = 0; hf < 2; ++hf) {
            const size_t R0 = (size_t)hf * MH;
            KARGS(ka);
            unsigned char* wsq = ka->ws; asm volatile("" : "+s"(wsq));
            unsigned* ctl = (unsigned*)(wsq + WS_CTL);
            bf16_t* XN = (bf16_t*)(wsq + WS_XN); bf16_t* CAT = (bf16_t*)(wsq + WS_CAT); bf16_t* KR = (bf16_t*)(wsq + WS_KR); float* CS = (float*)(wsq + WS_CS);
            bf16_t* P = (bf16_t*)(wsq + WS_P); bf16_t* GT = (bf16_t*)(wsq + WS_G); bf16_t* Q = (bf16_t*)(wsq + WS_Q); bf16_t* KN = (bf16_t*)(wsq + WS_KN); bf16_t* VT = (bf16_t*)(wsq + WS_VT);
            bf16_t* Y = (bf16_t*)(wsq + WS_Y); bf16_t* MG = (bf16_t*)(wsq + WS_MG);
            norm_rows_bf16(xin + R0 * DM, ka->in[2] + l * DM, XN, MH, NGW);
            grid.sync();
            { pg8::Gemm g{XN, Win_t, MH, NIN, DM, DM, DM, 0, 0}; pg8::StaticOrder S; S.init(MH, NIN, G, (int)blockIdx.x);
              pg8::EpiSplit<0, 1> E{P, 4096, 16, GT, 3072};
              pg8::gemm_phase(lds, g, S, E); }
            grid.sync();
            mla_prep(P, (const int*)ka->in[1] + R0, ka->in[7] + l * 256, ka->in[8] + l * 128, CAT, KR, CS, NGW);
            for (int u = blockIdx.x; u < 2048; u += G) hgrn_x_unit(P, ka->in[5], (float*)(wsq + WS_DL), l, u >> 10, (u >> 7) & 7, u & 127, lds);
            grid.sync();
            { pg8::Gemm g{CAT, WQK_t, MH, 1280, 384, 384, 384, 0, 0}; pg8::StaticOrder S; S.init(MH, 1280, G, (int)blockIdx.x);
              pg8::EpiSplit<0, 0> E{Q, 768, 3, KN, 512};
              pg8::gemm_phase(lds, g, S, E); }
            { pg8::Gemm g{WV_t, CAT, 512, MH, 384, 384, 384, 0, 0}; pg8::StaticOrder S; S.init(512, MH, G, (int)blockIdx.x);
              pg8::EpiSplit<0, 0> E{VT, MH, 1 << 30, VT, MH};
              pg8::gemm_phase(lds, g, S, E); }
            if ((int)blockIdx.x >= G - 128) hgrn_scan(P, (const float*)(wsq + WS_DL), (int)blockIdx.x - (G - 128));
            grid.sync();
#ifndef PROBE_RUN
#define PROBE_RUN 0
#endif
#define PH4_BODY(RUN, CTR) { \
                OPAQUE_TID(tid); \
                unsigned* ctr = (CTR); \
                LAS int* slot = (LAS int*)(lds + 131072); \
                for (;;) { \
                    if (tid == 0) slot[0] = (int)__hip_atomic_fetch_add(ctr, 1u, __ATOMIC_RELAXED, __HIP_MEMORY_SCOPE_AGENT); \
                    __syncthreads(); \
                    const int item = __builtin_amdgcn_readfirstlane(slot[0]); \
                    __syncthreads(); \
                    if (item >= 2048) break; \
                    if (item < 512) { const int k = item; if ((RUN) & 2) mla_unit(Q, KN, KR, VT, CS, Y, (k & 15) >> 3, k & 7, 31 - (k >> 4), lds); } \
                    else if (item < 1024) { const int k = item - 512; if ((RUN) & 4) bandattn_unit(P, ka->in[4] + ((size_t)l * 8 + (k & 7)) * 257, Y, (k & 15) >> 3, k & 7, k >> 4, lds); } \
                    else { const int k = item - 1024; if ((RUN) & 1) hgrn_z_unit(P, ka->in[6] + l * 64, Y, k >> 9, (k >> 6) & 7, k & 63, lds); } \
                } \
                grid.sync(); }
            PH4_BODY(7, ctl + 64 * (l * 2 + hf))
#if PROBE_RUN
            PH4_BODY(PROBE_RUN, ctl + 64 * (l * 2 + hf) + 256)
#endif
            { pg8::Gemm g{Y, Wbr_t, MH, 1024, 512, 1536, 512, (size_t)512 * 2, (size_t)1024 * 512 * 2}; pg8::BranchOrder S{G, (int)blockIdx.x};
              pg8::EpiBranch E{GT, MG};
              pg8::gemm_phase(lds, g, S, E); }
            grid.sync();
            { pg8::Gemm g{MG, Wout_t, MH, DM, DM, DM, DM, 0, 0}; pg8::StaticOrder S; S.init(MH, DM, G, (int)blockIdx.x);
              pg8::EpiResid E{xin + R0 * DM, ka->out + R0 * DM};
              pg8::gemm_phase(lds, g, S, E); }
            grid.sync();
        }
        KARGS(kf); { KArgs ka = kf;
        unsigned char* wsf = ka->ws; asm volatile("" : "+s"(wsf));
        bf16_t* XN = (bf16_t*)(wsf + WS_XN); bf16_t* HB = (bf16_t*)(wsf + WS_H);
        norm_rows_bf16(ka->out, ka->in[13] + l * DM, XN, MTOT, NGW);
        grid.sync();
        { pg8::Gemm g{XN, W1_t, MTOT, FF, DM, DM, DM, 0, 0}; pg8::StaticOrder S; S.init(MTOT, FF, G, (int)blockIdx.x);
          pg8::EpiSplit<2, 2> E{HB, FF, 1 << 30, HB, FF};
          pg8::gemm_phase(lds, g, S, E); }
        grid.sync();
        { pg8::Gemm g{HB, W2_t, MTOT, DM, FF, FF, FF, 0, 0}; pg8::StaticOrder S; S.init(MTOT, DM, G, (int)blockIdx.x);
          pg8::EpiResid E{ka->out, ka->out};
          pg8::gemm_phase(lds, g, S, E); }
        grid.sync(); }
    }
    KARGS(kz);
    norm_rows_f32_inplace(kz->out, kz->in[16], MTOT, NGW);
}

extern "C" void kernel_launch(void* const* d_in, const int* in_sizes, int n_in, void* d_out, int out_size, void* d_ws, size_t ws_size, hipStream_t stream) {
    static int grid = 0;
    if (grid == 0) {
        int dev = 0, cus = 0, per_cu = 0;
        (void)hipGetDevice(&dev);
        (void)hipDeviceGetAttribute(&cus, hipDeviceAttributeMultiprocessorCount, dev);
        (void)hipFuncSetAttribute((const void*)fwd_kernel, hipFuncAttributeMaxDynamicSharedMemorySize, LDS_BYTES);
        (void)hipOccupancyMaxActiveBlocksPerMultiprocessor(&per_cu, (const void*)fwd_kernel, 512, LDS_BYTES);
        if (per_cu < 1) per_cu = 1;
        grid = cus * per_cu;
        if (ws_size < (size_t)504 * MiB) fprintf(stderr, "kernel_launch: workspace too small (%zu)\n", ws_size);
    }
    (void)hipMemsetAsync((char*)d_ws + WS_CTL, 0, 4096, stream);
    Args a{};
    for (int i = 0; i < 17; ++i) a.in[i] = (const float*)d_in[i];
    a.out = (float*)d_out; a.ws = (unsigned char*)d_ws;
    void* args[] = {&a};
    hipError_t e = hipLaunchCooperativeKernel((void*)fwd_kernel, dim3(grid), dim3(512), args, LDS_BYTES, stream);
    if (e != hipSuccess) fprintf(stderr, "cooperative launch failed: %s (grid %d)\n", hipGetErrorString(e), grid);
}
```

```cpp
#include <hip/hip_runtime.h>
#include <hip/hip_cooperative_groups.h>
#include <cstdio>
#include <cstdint>
namespace cg = cooperative_groups;

#define LAS __attribute__((address_space(3)))
typedef unsigned short bf16_t;
typedef short bf16x8 __attribute__((ext_vector_type(8)));
typedef float f32x4 __attribute__((ext_vector_type(4)));
typedef float f32x16 __attribute__((ext_vector_type(16)));
typedef unsigned u32x4 __attribute__((ext_vector_type(4)));
typedef unsigned u32x2 __attribute__((ext_vector_type(2)));
typedef float f32x2_t __attribute__((ext_vector_type(2)));
typedef __bf16 bf16x2_t __attribute__((ext_vector_type(2)));

__device__ __forceinline__ unsigned pk2(float lo, float hi) { f32x2_t v = {lo, hi}; bf16x2_t b = __builtin_convertvector(v, bf16x2_t); return __builtin_bit_cast(unsigned, b); }
__device__ __forceinline__ bf16_t f2bf(float f) { return (bf16_t)(pk2(f, 0.f) & 0xffffu); }
__device__ __forceinline__ float bflo(unsigned w) { return __uint_as_float(w << 16); }
__device__ __forceinline__ float bfhi(unsigned w) { return __uint_as_float(w & 0xffff0000u); }
__device__ __forceinline__ float ex2(float x) { return __builtin_amdgcn_exp2f(x); }
__device__ __forceinline__ float sigm(float x) { return __builtin_amdgcn_rcpf(1.0f + ex2(-1.4426950408889634f * x)); }
__device__ __forceinline__ int crow(int r, int hi) { return (r & 3) + 8 * (r >> 2) + 4 * hi; }
__device__ __forceinline__ float shx(float v, int mask, int lane) { return __int_as_float(__builtin_amdgcn_ds_bpermute((lane ^ mask) << 2, __float_as_int(v))); }
__device__ __forceinline__ float wave_sum(float v, int lane) {
#pragma unroll
    for (int o = 1; o < 64; o <<= 1) v += shx(v, o, lane);
    return v;
}
#define LDS_WAIT() asm volatile("s_waitcnt lgkmcnt(0)" ::: "memory")
#define MFMA32(a, b, c) __builtin_amdgcn_mfma_f32_32x32x16_bf16((a), (b), (c), 0, 0, 0)

namespace pg8 {
constexpr int BM = 256, BK = 64, HALF = 128, HTB = HALF * BK * 2, STAGE_BYTES = 8 * HTB, NXCD = 8, WGM = 8;
__host__ __device__ __forceinline__ int lds_byte(int r, int c) { const int st = (r >> 4) * 2 + (c >> 5), rr = r & 15, cc = c & 31, ob = rr * 64 + cc * 2; return st * 1024 + (ob ^ (((ob >> 9) & 1) << 5)); }
__host__ __device__ __forceinline__ void stage_rc(int b, int& R, int& C) { const int st = b / 1024, sb = b % 1024, swz = sb ^ (((sb >> 9) & 1) << 5); R = (st >> 1) * 16 + swz / 64; C = (st & 1) * 32 + (swz % 64) / 2; }
__host__ __device__ __forceinline__ int perm32(int rho) { const int n = rho >> 4, i = rho & 15; return 8 * (i >> 2) + 4 * n + (i & 3); }

struct Unit { int pm, pn, z; };
struct Gemm { const bf16_t* A; const bf16_t* Bt; int M, N, K, lda, ldb; size_t za, zb; };

struct StaticOrder {
    int nM, nN, nwg, G, c;
    __device__ void init(int M, int N, int G_, int c_) { nM = M / BM; nN = N / BM; nwg = nM * nN; G = G_; c = c_; }
    __device__ bool next(int i, Unit& u) const {
        const long L = (long)i * G + c; if (L >= nwg) return false;
        int wgid = (int)L; { const int q = nwg / NXCD, r = nwg % NXCD, xcd = wgid % NXCD, off = wgid / NXCD; wgid = (xcd < r ? xcd * (q + 1) : r * (q + 1) + (xcd - r) * q) + off; }
        const int nig = WGM * nN, gid = wgid / nig, fm = gid * WGM, gsz = (nM - fm) < WGM ? (nM - fm) : WGM;
        u.pm = fm + ((wgid % nig) % gsz); u.pn = (wgid % nig) / gsz; u.z = 0; return true;
    }
};
struct BranchOrder {
    int G, c;
    __device__ bool next(int i, Unit& u) const {
        const int p = (i / 3) * G + c; if (p >= 256) return false;
        const int xcd = p & 7, off = p >> 3; u.pm = xcd * 8 + (off >> 2); u.pn = off & 3; u.z = i % 3; return true;
    }
};

template <int ACT0, int ACT1> struct EpiSplit {
    static constexpr bool PERM = true;
    bf16_t* O0; int ld0; int nsplit; bf16_t* O1; int ld1;
    __device__ __forceinline__ void operator()(const f32x4 (&acc)[2][2][4][2], const Unit& u, int wr, int wc, int fr, int fq) const {
        const bool first = u.pn < nsplit;
        bf16_t* base = first ? O0 : O1; const int ldc = first ? ld0 : ld1; const int colt = (first ? u.pn : u.pn - nsplit) * BM;
        const int act = first ? ACT0 : ACT1;
        const int row0 = u.pm * BM + wr * 64 + fr, col0 = colt + wc * 32 + 8 * fq;
#pragma unroll
        for (int ai = 0; ai < 2; ++ai)
#pragma unroll
            for (int m = 0; m < 4; ++m) { bf16_t* rowp = base + (size_t)(row0 + ai * HALF + m * 16) * ldc + col0;
#pragma unroll
                for (int bj = 0; bj < 2; ++bj) { f32x4 v0 = acc[ai][bj][m][0], v1 = acc[ai][bj][m][1];
                    if (act == 1) {
#pragma unroll
                        for (int e = 0; e < 4; ++e) { v0[e] = sigm(v0[e]); v1[e] = sigm(v1[e]); }
                    } else if (act == 2) {
#pragma unroll
                        for (int e = 0; e < 4; ++e) { const float a = fmaxf(v0[e], 0.f), b = fmaxf(v1[e], 0.f); v0[e] = a * a; v1[e] = b * b; }
                    }
                    u32x4 w; w.x = pk2(v0[0], v0[1]); w.y = pk2(v0[2], v0[3]); w.z = pk2(v1[0], v1[1]); w.w = pk2(v1[2], v1[3]);
                    *(u32x4*)(rowp + bj * HALF) = w; } }
    }
};
struct EpiBranch {
    static constexpr bool PERM = true;
    const bf16_t* Gt; bf16_t* Mg;
    __device__ __forceinline__ void operator()(const f32x4 (&acc)[2][2][4][2], const Unit& u, int wr, int wc, int fr, int fq) const {
        const int row0 = u.pm * BM + wr * 64 + fr, col0 = u.pn * BM + wc * 32 + 8 * fq;
#pragma unroll
        for (int ai = 0; ai < 2; ++ai)
#pragma unroll
            for (int m = 0; m < 4; ++m) { const size_t row = (size_t)(row0 + ai * HALF + m * 16);
#pragma unroll
                for (int bj = 0; bj < 2; ++bj) { const f32x4 v0 = acc[ai][bj][m][0], v1 = acc[ai][bj][m][1];
                    const u32x4 g = *(const u32x4*)(Gt + row * 3072 + u.z * 1024 + col0 + bj * HALF);
                    bf16_t* mp = Mg + row * 1024 + col0 + bj * HALF;
                    u32x4 pv = (u32x4){0u, 0u, 0u, 0u}; if (u.z > 0) pv = *(const u32x4*)mp;
                    float o[8];
                    o[0] = bflo(pv.x) + bflo(g.x) * v0[0]; o[1] = bfhi(pv.x) + bfhi(g.x) * v0[1]; o[2] = bflo(pv.y) + bflo(g.y) * v0[2]; o[3] = bfhi(pv.y) + bfhi(g.y) * v0[3];
                    o[4] = bflo(pv.z) + bflo(g.z) * v1[0]; o[5] = bfhi(pv.z) + bfhi(g.z) * v1[1]; o[6] = bflo(pv.w) + bflo(g.w) * v1[2]; o[7] = bfhi(pv.w) + bfhi(g.w) * v1[3];
                    u32x4 w; w.x = pk2(o[0], o[1]); w.y = pk2(o[2], o[3]); w.z = pk2(o[4], o[5]); w.w = pk2(o[6], o[7]);
                    *(u32x4*)mp = w; } }
    }
};
struct EpiResid {
    static constexpr bool PERM = true;
    const float* base; float* out;
    __device__ __forceinline__ void operator()(const f32x4 (&acc)[2][2][4][2], const Unit& u, int wr, int wc, int fr, int fq) const {
        const int row0 = u.pm * BM + wr * 64 + fr, col0 = u.pn * BM + wc * 32 + 8 * fq;
#pragma unroll
        for (int ai = 0; ai < 2; ++ai)
#pragma unroll
            for (int m = 0; m < 4; ++m) { const size_t off = (size_t)(row0 + ai * HALF + m * 16) * 1024 + col0;
#pragma unroll
                for (int bj = 0; bj < 2; ++bj) { const f32x4 b0 = *(const f32x4*)(base + off + bj * HALF), b1 = *(const f32x4*)(base + off + bj * HALF + 4);
                    *(f32x4*)(out + off + bj * HALF) = b0 + acc[ai][bj][m][0]; *(f32x4*)(out + off + bj * HALF + 4) = b1 + acc[ai][bj][m][1]; } }
    }
};

template <class Epi, class Sched>
__device__ __forceinline__ void gemm_phase(LAS unsigned char* lds, const Gemm g, const Sched& S, const Epi& E) {
    int tid = threadIdx.x; asm volatile("" : "+v"(tid));
    const int wid = __builtin_amdgcn_readfirstlane(tid >> 6), lane = tid & 63, wr = wid >> 2, wc = wid & 3, fr = lane & 15, fq = lane >> 4;
    const int K = g.K, nt = K / BK;
    unsigned voffA[2], voffB[2];
#pragma unroll
    for (int i = 0; i < 2; ++i) { int R, C; stage_rc(tid * 16 + i * 8192, R, C); const int Rb = Epi::PERM ? ((R & ~31) + perm32(R & 31)) : R;
        voffA[i] = (unsigned)(R * g.lda + C) * 2u; voffB[i] = (unsigned)(Rb * g.ldb + C) * 2u; }
    const size_t kstep = (size_t)(BK * 2);
    const size_t hstepA = (size_t)HALF * g.lda * 2, hstepB = (size_t)HALF * g.ldb * 2;
    const size_t tstepA = 2 * hstepA, tstepB = 2 * hstepB;
    const unsigned ldsw = (unsigned)wid * 1024u;
    const int aoff = lds_byte(wr * 64 + fr, fq * 8), boff = lds_byte(wc * 32 + fr, fq * 8);
#define PG8_SA(b, h) (((b) * 2 + (h)) * HTB)
#define PG8_SB(b, h) ((4 + (b) * 2 + (h)) * HTB)
#define PG8_STAGE(bufoff, gbase, voff) do { _Pragma("unroll") for (int _i = 0; _i < 2; ++_i) \
        __builtin_amdgcn_global_load_lds((const unsigned*)((const char*)(gbase) + (voff)[_i]), (LAS unsigned*)(lds + (bufoff) + ldsw + _i * 8192), 16, 0, 0); } while (0)
#define PG8_LDA(dst, b, h) do { _Pragma("unroll") for (int m = 0; m < 4; ++m) _Pragma("unroll") for (int k = 0; k < 2; ++k) dst[m][k] = *(const LAS bf16x8*)(lds + PG8_SA(b, h) + aoff + m * 2048 + k * 1024); } while (0)
#define PG8_LDB(dst, b, h) do { _Pragma("unroll") for (int n = 0; n < 2; ++n) _Pragma("unroll") for (int k = 0; k < 2; ++k) dst[n][k] = *(const LAS bf16x8*)(lds + PG8_SB(b, h) + boff + n * 2048 + k * 1024); } while (0)
#define PG8_MMA(ai, bj, At, Bt) do { __builtin_amdgcn_s_setprio(1); _Pragma("unroll") for (int m = 0; m < 4; ++m) _Pragma("unroll") for (int n = 0; n < 2; ++n) _Pragma("unroll") for (int k = 0; k < 2; ++k) \
        acc[ai][bj][m][n] = __builtin_amdgcn_mfma_f32_16x16x32_bf16(Bt[n][k], At[m][k], acc[ai][bj][m][n], 0, 0, 0); __builtin_amdgcn_s_setprio(0); } while (0)
#define PG8_WAIT_V(n) asm volatile("s_waitcnt vmcnt(" #n ")" ::: "memory")
#define PG8_WAIT_L(n) asm volatile("s_waitcnt lgkmcnt(" #n ")" ::: "memory")
#define PG8_BAR __builtin_amdgcn_s_barrier()
#define PG8_SCHED __builtin_amdgcn_sched_barrier(0)
    Unit cur, nxt; int ui = 0;
    if (!S.next(0, cur)) return;
    f32x4 acc[2][2][4][2];
#pragma unroll
    for (int a = 0; a < 2; ++a)
#pragma unroll
        for (int b = 0; b < 2; ++b)
#pragma unroll
            for (int m = 0; m < 4; ++m)
#pragma unroll
                for (int n = 0; n < 2; ++n) acc[a][b][m][n] = (f32x4){0.f, 0.f, 0.f, 0.f};
    bf16x8 At[4][2], B0[2][2], B1[2][2];
    const char* cA = (const char*)g.A + (size_t)cur.pm * tstepA + (size_t)cur.z * g.za; const char* cB = (const char*)g.Bt + (size_t)cur.pn * tstepB + (size_t)cur.z * g.zb;
    PG8_STAGE(PG8_SB(0, 0), cB, voffB); PG8_STAGE(PG8_SB(0, 1), cB + hstepB, voffB); PG8_STAGE(PG8_SA(0, 0), cA, voffA); PG8_STAGE(PG8_SA(0, 1), cA + hstepA, voffA);
    if (wr == 1) PG8_BAR;
    PG8_WAIT_V(2); PG8_BAR;
    PG8_STAGE(PG8_SB(1, 0), cB + kstep, voffB); PG8_STAGE(PG8_SA(1, 0), cA + kstep, voffA); PG8_STAGE(PG8_SB(1, 1), cB + hstepB + kstep, voffB);
    PG8_WAIT_V(6); PG8_BAR;
    for (;;) {
        const bool has_next = S.next(ui + 1, nxt);
        const char* nA = has_next ? (const char*)g.A + (size_t)nxt.pm * tstepA + (size_t)nxt.z * g.za : cA; const char* nB = has_next ? (const char*)g.Bt + (size_t)nxt.pn * tstepB + (size_t)nxt.z * g.zb : cB;
        for (int t = 0; t < nt; t += 2) {
            const bool last = (t == nt - 2);
            const char* a1 = cA + (size_t)(t + 1) * kstep;
            const char* a2 = last ? nA : cA + (size_t)(t + 2) * kstep; const char* b2 = last ? nB : cB + (size_t)(t + 2) * kstep;
            const char* a3 = a2 + kstep; const char* b3 = b2 + kstep;
            PG8_LDB(B0, 0, 0); PG8_LDB(B1, 0, 1); PG8_SCHED; PG8_LDA(At, 0, 0); PG8_STAGE(PG8_SA(1, 1), a1 + hstepA, voffA);
            PG8_WAIT_V(8); PG8_WAIT_L(0); PG8_BAR; PG8_MMA(0, 0, At, B0); PG8_MMA(0, 1, At, B1); PG8_BAR; PG8_SCHED;
            PG8_LDA(At, 0, 1); PG8_STAGE(PG8_SB(0, 0), b2, voffB); PG8_STAGE(PG8_SB(0, 1), b2 + hstepB, voffB); PG8_STAGE(PG8_SA(0, 0), a2, voffA);
            PG8_WAIT_V(8); PG8_WAIT_L(0); PG8_BAR; PG8_MMA(1, 0, At, B0); PG8_MMA(1, 1, At, B1); PG8_BAR; PG8_SCHED;
            PG8_LDB(B0, 1, 0); PG8_LDB(B1, 1, 1); PG8_SCHED; PG8_LDA(At, 1, 0); PG8_STAGE(PG8_SA(0, 1), a2 + hstepA, voffA);
            PG8_WAIT_V(8); PG8_WAIT_L(0); PG8_BAR; PG8_MMA(0, 0, At, B0); PG8_MMA(0, 1, At, B1); PG8_BAR; PG8_SCHED;
            PG8_LDA(At, 1, 1); PG8_STAGE(PG8_SB(1, 0), b3, voffB); PG8_STAGE(PG8_SB(1, 1), b3 + hstepB, voffB); PG8_STAGE(PG8_SA(1, 0), a3, voffA);
            PG8_WAIT_V(8); PG8_WAIT_L(0); PG8_BAR; PG8_MMA(1, 0, At, B0); PG8_MMA(1, 1, At, B1); PG8_BAR; PG8_SCHED;
        }
        if (wr == 0) PG8_BAR;
        { int t2_ = threadIdx.x; asm volatile("" : "+v"(t2_)); E(acc, cur, wr, wc, t2_ & 15, (t2_ >> 4) & 3); }
        if (!has_next) break;
#pragma unroll
        for (int a = 0; a < 2; ++a)
#pragma unroll
            for (int b = 0; b < 2; ++b)
#pragma unroll
                for (int m = 0; m < 4; ++m)
#pragma unroll
                    for (int n = 0; n < 2; ++n) acc[a][b][m][n] = (f32x4){0.f, 0.f, 0.f, 0.f};
        cur = nxt; cA = nA; cB = nB; ++ui;
        if (wr == 1) PG8_BAR;
    }
    PG8_WAIT_V(0);
    PG8_BAR;
#undef PG8_SA
#undef PG8_SB
#undef PG8_STAGE
#undef PG8_LDA
#undef PG8_LDB
#undef PG8_MMA
#undef PG8_WAIT_V
#undef PG8_WAIT_L
#undef PG8_BAR
#undef PG8_SCHED
}
}

constexpr int DM = 1024, SEQ = 8192, MTOT = 32768, MH = 16384, NIN = 7168, FF = 4096;
constexpr float EPS = 1e-6f, LOG2E = 1.4426950408889634f;
constexpr int LDS_BYTES = 147456;
constexpr size_t MiB = 1u << 20;
constexpr size_t WS_CTL = 0;
constexpr size_t WS_W = 1 * MiB, W_LAYER = 36 * MiB;
constexpr size_t WO_IN = 0, WO_QK = 14 * MiB, WO_V = 15 * MiB, WO_BR = 16 * MiB, WO_OUT = 19 * MiB, WO_F1 = 21 * MiB, WO_F2 = 29 * MiB;
constexpr size_t W_LAYER_REAL = 37 * MiB;
constexpr size_t WS_DL = 75 * MiB;
constexpr size_t WS_XN = 80 * MiB;
constexpr size_t WS_CAT = 112 * MiB;
constexpr size_t WS_KR = 124 * MiB;
constexpr size_t WS_CS = 125 * MiB;
constexpr size_t WS_P = 144 * MiB;
constexpr size_t WS_G = 272 * MiB;
constexpr size_t WS_Q = 368 * MiB;
constexpr size_t WS_KN = 392 * MiB;
constexpr size_t WS_VT = 408 * MiB;
constexpr size_t WS_Y = 424 * MiB;
constexpr size_t WS_MG = 472 * MiB;
constexpr size_t WS_H = 144 * MiB;
static_assert(WS_W + 2 * W_LAYER_REAL <= WS_XN, "weights fit");

#define OPAQUE_TID(t) int t = threadIdx.x; asm volatile("" : "+v"(t))
__device__ __forceinline__ void norm_rows_bf16(const float* x, const float* g, bf16_t* dst, int rows, int NGW) {
    OPAQUE_TID(tid_); const int lane = tid_ & 63, gw = blockIdx.x * 8 + __builtin_amdgcn_readfirstlane(tid_ >> 6);
    for (int m = gw; m < rows; m += NGW) {
        const f32x4* xr = (const f32x4*)(x + (size_t)m * DM) + lane;
        f32x4 v[4]; float s = 0.f;
#pragma unroll
        for (int j = 0; j < 4; ++j) { v[j] = xr[64 * j]; s += (v[j].x * v[j].x + v[j].y * v[j].y) + (v[j].z * v[j].z + v[j].w * v[j].w); }
        const float r = 1.0f / sqrtf(wave_sum(s, lane) * (1.0f / DM) + EPS);
        unsigned long long* o8 = (unsigned long long*)(dst + (size_t)m * DM) + lane;
#pragma unroll
        for (int j = 0; j < 4; ++j) { const f32x4 gg = ((const f32x4*)g)[lane + 64 * j];
            o8[64 * j] = (unsigned long long)pk2(v[j].x * r * gg.x, v[j].y * r * gg.y) | ((unsigned long long)pk2(v[j].z * r * gg.z, v[j].w * r * gg.w) << 32); }
    }
}
__device__ __forceinline__ void norm_rows_f32_inplace(float* x, const float* g, int rows, int NGW) {
    OPAQUE_TID(tid_); const int lane = tid_ & 63, gw = blockIdx.x * 8 + __builtin_amdgcn_readfirstlane(tid_ >> 6);
    for (int m = gw; m < rows; m += NGW) {
        f32x4* xr = (f32x4*)(x + (size_t)m * DM) + lane;
        f32x4 v[4]; float s = 0.f;
#pragma unroll
        for (int j = 0; j < 4; ++j) { v[j] = xr[64 * j]; s += (v[j].x * v[j].x + v[j].y * v[j].y) + (v[j].z * v[j].z + v[j].w * v[j].w); }
        const float r = 1.0f / sqrtf(wave_sum(s, lane) * (1.0f / DM) + EPS);
#pragma unroll
        for (int j = 0; j < 4; ++j) { const f32x4 gg = ((const f32x4*)g)[lane + 64 * j]; xr[64 * j] = v[j] * r * gg; }
    }
}
__device__ __forceinline__ void mla_prep(const bf16_t* P, const int* pos, const float* gq, const float* gkv, bf16_t* cat, bf16_t* kr, float* cs, int NGW) {
    OPAQUE_TID(tid_); const int lane = tid_ & 63, gw = blockIdx.x * 8 + __builtin_amdgcn_readfirstlane(tid_ >> 6);
    for (int m = gw; m < MH; m += NGW) {
        const bf16_t* prow = P + (size_t)m * 4096 + 3584;
        { const u32x2 w = *(const u32x2*)(prow + 4 * lane);
          const float a = bflo(w.x), b = bfhi(w.x), c = bflo(w.y), d = bfhi(w.y);
          const float r = 1.0f / sqrtf(wave_sum((a * a + b * b) + (c * c + d * d), lane) * (1.0f / 256.0f) + EPS);
          const f32x4 gg = ((const f32x4*)gq)[lane];
          u32x2 o; o.x = pk2(a * r * gg.x, b * r * gg.y); o.y = pk2(c * r * gg.z, d * r * gg.w);
          *(u32x2*)(cat + (size_t)m * 384 + 4 * lane) = o; }
        { const unsigned w = *(const unsigned*)(prow + 256 + 2 * lane);
          const float a = bflo(w), b = bfhi(w);
          const float r = 1.0f / sqrtf(wave_sum(a * a + b * b, lane) * (1.0f / 128.0f) + EPS);
          *(unsigned*)(cat + (size_t)m * 384 + 256 + 2 * lane) = pk2(a * r * gkv[2 * lane], b * r * gkv[2 * lane + 1]); }
        if (lane < 16) {
            const float x1 = __uint_as_float((unsigned)prow[384 + lane] << 16), x2 = __uint_as_float((unsigned)prow[400 + lane] << 16);
            const float invf = exp2f(-(float)lane * 0.83048202372184059f);
            double fr = (double)pos[m] * (double)invf * 0.15915494309189535;
            fr -= rint(fr);
            const float c = __builtin_amdgcn_cosf((float)fr), s = __builtin_amdgcn_sinf((float)fr);
            cs[(size_t)m * 32 + lane] = c; cs[(size_t)m * 32 + 16 + lane] = s;
            kr[(size_t)m * 32 + lane] = f2bf(x1 * c - x2 * s); kr[(size_t)m * 32 + 16 + lane] = f2bf(x2 * c + x1 * s);
        }
    }
}

constexpr int VP = 72;
__device__ __forceinline__ float max3f(float a, float b, float c) { return __builtin_fmaxf(__builtin_fmaxf(a, b), c); }
template <int ND0, int KP>
__device__ __forceinline__ void qk_tile(const LAS unsigned char* Ks, const bf16x8 (&qf)[ND0], const f32x16& negm, f32x16& p0, f32x16& p1, int r32, int hi) {
#pragma unroll
    for (int d0 = 0; d0 < ND0; ++d0) {
        const bf16x8 a0 = *(const LAS bf16x8*)(Ks + r32 * (KP * 2) + (16 * d0 + 8 * hi) * 2);
        const bf16x8 a1 = *(const LAS bf16x8*)(Ks + (r32 + 32) * (KP * 2) + (16 * d0 + 8 * hi) * 2);
        if (d0 == 0) { p0 = MFMA32(a0, qf[0], negm); p1 = MFMA32(a1, qf[0], negm); }
        else { p0 = MFMA32(a0, qf[d0], p0); p1 = MFMA32(a1, qf[d0], p1); }
    }
}
__device__ __forceinline__ void softmax_pv(f32x16& p0, f32x16& p1, f32x16 (&o)[2], float& m_run, float& l_run, f32x16& negm, bool first, const LAS unsigned char* Vts, LAS float* sc, int r32, int hi) {
    float a = max3f(p0[0], p0[1], p1[0]), b = max3f(p0[2], p0[3], p1[1]); a = max3f(a, p1[2], p1[3]);
#pragma unroll
    for (int r = 4; r < 16; r += 4) { a = max3f(a, p0[r], p0[r + 1]); b = max3f(b, p0[r + 2], p0[r + 3]); a = max3f(a, p1[r], p1[r + 1]); b = max3f(b, p1[r + 2], p1[r + 3]); }
    float mx = __builtin_fmaxf(a, b);
    { auto rr = __builtin_amdgcn_permlane32_swap(__float_as_uint(mx), __float_as_uint(mx), false, false); mx = __builtin_fmaxf(__uint_as_float(rr[0]), __uint_as_float(rr[1])); }
    if (first || __any(mx > 8.0f)) {
        const float dl = first ? mx : __builtin_fmaxf(mx, 0.f);
        m_run += dl;
#pragma unroll
        for (int r = 0; r < 16; ++r) { p0[r] -= dl; p1[r] -= dl; negm[r] = -m_run; }
        if (!first) {
            const float al = ex2(-dl); l_run *= al;
            if (hi == 0) sc[r32] = al;
            LDS_WAIT();
#pragma unroll
            for (int g4 = 0; g4 < 4; ++g4) { const f32x4 av = *(const LAS f32x4*)(sc + 8 * g4 + 4 * hi);
#pragma unroll
                for (int e = 0; e < 4; ++e) { o[0][4 * g4 + e] *= av[e]; o[1][4 * g4 + e] *= av[e]; } }
            LDS_WAIT();
        }
    }
    float s = 0.f;
#pragma unroll
    for (int r = 0; r < 16; ++r) { p0[r] = ex2(p0[r]); p1[r] = ex2(p1[r]); s += p0[r] + p1[r]; }
    l_run += s;
#pragma unroll
    for (int ks = 0; ks < 4; ++ks) {
        u32x4 pw;
        if (ks == 0) pw = (u32x4){pk2(p0[0], p0[1]), pk2(p0[2], p0[3]), pk2(p0[4], p0[5]), pk2(p0[6], p0[7])};
        else if (ks == 1) pw = (u32x4){pk2(p0[8], p0[9]), pk2(p0[10], p0[11]), pk2(p0[12], p0[13]), pk2(p0[14], p0[15])};
        else if (ks == 2) pw = (u32x4){pk2(p1[0], p1[1]), pk2(p1[2], p1[3]), pk2(p1[4], p1[5]), pk2(p1[6], p1[7])};
        else pw = (u32x4){pk2(p1[8], p1[9]), pk2(p1[10], p1[11]), pk2(p1[12], p1[13]), pk2(p1[14], p1[15])};
        const bf16x8 pa = __builtin_bit_cast(bf16x8, pw);
#pragma unroll
        for (int db = 0; db < 2; ++db) {
            const bf16x8 vb = *(const LAS bf16x8*)(Vts + (32 * db + r32) * (VP * 2) + (16 * ks + 8 * hi) * 2);
            o[db] = MFMA32(pa, vb, o[db]);
        }
    }
}
__device__ __forceinline__ void attn_finish(f32x16 (&o)[2], float l_run, bf16_t* y, size_t row0, int ldy, int col0, LAS float* sc, int r32, int hi) {
    float lt = l_run;
    { auto rr = __builtin_amdgcn_permlane32_swap(__float_as_uint(lt), __float_as_uint(lt), false, false); lt = __uint_as_float(rr[0]) + __uint_as_float(rr[1]); }
    if (hi == 0) sc[r32] = 1.0f / lt;
    LDS_WAIT();
#pragma unroll
    for (int g4 = 0; g4 < 4; ++g4) { const f32x4 a = *(const LAS f32x4*)(sc + 8 * g4 + 4 * hi);
#pragma unroll
        for (int e = 0; e < 4; ++e) { const int r = 4 * g4 + e; bf16_t* yp = y + (row0 + crow(r, hi)) * ldy + col0 + r32;
            yp[0] = f2bf(o[0][r] * a[e]); yp[32] = f2bf(o[1][r] * a[e]); } }
    LDS_WAIT();
}

__device__ __forceinline__ void mla_unit(const bf16_t* Q, const bf16_t* KN, const bf16_t* KR, const bf16_t* VT, const float* CS, bf16_t* Y, int bl, int h, int qb, LAS unsigned char* lds) {
    OPAQUE_TID(tid);
    constexpr int KP = 104, KBUF = 64 * KP * 2, VBUF = 64 * VP * 2, OFF_V = 2 * KBUF, OFF_SC = OFF_V + 3 * VBUF;
    const int lane = tid & 63, w = __builtin_amdgcn_readfirstlane(tid >> 6), r32 = lane & 31, hi = lane >> 5;
    const size_t rb = (size_t)bl * SEQ;
    LAS float* sc = (LAS float*)(lds + OFF_SC) + w * 32;
    const float QS = 0.10206207261596577f * LOG2E;
    bf16x8 qf[6];
    { const size_t qrow = rb + (size_t)qb * 256 + 32 * w + r32;
      const bf16_t* qp = Q + qrow * 768 + h * 96;
#pragma unroll
      for (int d0 = 0; d0 < 4; ++d0) { const u32x4 raw = *(const u32x4*)(qp + 16 * d0 + 8 * hi);
          u32x4 t; t.x = pk2(bflo(raw.x) * QS, bfhi(raw.x) * QS); t.y = pk2(bflo(raw.y) * QS, bfhi(raw.y) * QS); t.z = pk2(bflo(raw.z) * QS, bfhi(raw.z) * QS); t.w = pk2(bflo(raw.w) * QS, bfhi(raw.w) * QS);
          qf[d0] = __builtin_bit_cast(bf16x8, t); }
      const u32x4 r1 = *(const u32x4*)(qp + 64 + 8 * hi), r2 = *(const u32x4*)(qp + 80 + 8 * hi);
      const f32x4 c0 = *(const f32x4*)(CS + qrow * 32 + 8 * hi), c1 = *(const f32x4*)(CS + qrow * 32 + 8 * hi + 4);
      const f32x4 s0 = *(const f32x4*)(CS + qrow * 32 + 16 + 8 * hi), s1 = *(const f32x4*)(CS + qrow * 32 + 16 + 8 * hi + 4);
      const float x1[8] = {bflo(r1.x), bfhi(r1.x), bflo(r1.y), bfhi(r1.y), bflo(r1.z), bfhi(r1.z), bflo(r1.w), bfhi(r1.w)};
      const float x2[8] = {bflo(r2.x), bfhi(r2.x), bflo(r2.y), bfhi(r2.y), bflo(r2.z), bfhi(r2.z), bflo(r2.w), bfhi(r2.w)};
      const float cc[8] = {c0.x, c0.y, c0.z, c0.w, c1.x, c1.y, c1.z, c1.w}, ss[8] = {s0.x, s0.y, s0.z, s0.w, s1.x, s1.y, s1.z, s1.w};
      float o1[8], o2[8];
#pragma unroll
      for (int i = 0; i < 8; ++i) { o1[i] = (x1[i] * cc[i] - x2[i] * ss[i]) * QS; o2[i] = (x2[i] * cc[i] + x1[i] * ss[i]) * QS; }
      u32x4 t1 = (u32x4){pk2(o1[0], o1[1]), pk2(o1[2], o1[3]), pk2(o1[4], o1[5]), pk2(o1[6], o1[7])}, t2 = (u32x4){pk2(o2[0], o2[1]), pk2(o2[2], o2[3]), pk2(o2[4], o2[5]), pk2(o2[6], o2[7])};
      qf[4] = __builtin_bit_cast(bf16x8, t1); qf[5] = __builtin_bit_cast(bf16x8, t2); }
    const int T = 4 * qb + 4;
    const int qw = w;
    const int tlast = 4 * qb + (qw >> 1);
    const int grp = w >> 2;
    const int krow = tid >> 3, kch = tid & 7;
    const int rrow = (tid & 255) >> 2, rch = tid & 3;
    const bf16_t* knp = KN + (rb + krow) * 512 + h * 64 + 8 * kch;
    const bf16_t* krp = KR + (rb + rrow) * 32 + 8 * rch;
    const bf16_t* vtp = VT + (size_t)(h * 64 + krow) * MH + rb + 8 * kch;
    const int vpos = 16 * (kch >> 1) + ((kch & 1) ? 4 : 0);
    u32x4 gk, gr = (u32x4){0u, 0u, 0u, 0u}, gv;
#define MLA_LOAD(t) do { gk = *(const u32x4*)(knp + (size_t)(t) * 64 * 512); if (tid < 256) gr = *(const u32x4*)(krp + (size_t)(t) * 64 * 32); gv = *(const u32x4*)(vtp + (size_t)(t) * 64); } while (0)
#define MLA_STORE(kb, vb) do { *(LAS u32x4*)(lds + (kb) * KBUF + krow * (KP * 2) + kch * 16) = gk; if (tid < 256) *(LAS u32x4*)(lds + (kb) * KBUF + rrow * (KP * 2) + 128 + rch * 16) = gr; \
        LAS unsigned char* vd_ = lds + OFF_V + (vb) * VBUF + krow * (VP * 2) + vpos * 2; *(LAS u32x2*)vd_ = (u32x2){gv.x, gv.y}; *(LAS u32x2*)(vd_ + 16) = (u32x2){gv.z, gv.w}; } while (0)
    f32x16 o[2], negm, p0, p1;
#pragma unroll
    for (int r = 0; r < 16; ++r) { o[0][r] = 0.f; o[1][r] = 0.f; negm[r] = 0.f; p0[r] = 0.f; p1[r] = 0.f; }
    float m_run = 0.f, l_run = 0.f;
    bool first = true;
    MLA_LOAD(0); MLA_STORE(0, 0);
    __syncthreads();
    int vcur = 0, vprev = 2, vnext = 1;
#pragma unroll 1
    for (int t = 0; t < T; ++t) {
        if (t + 1 < T) MLA_LOAD(t + 1);
        if (grp == 1 && t >= 1 && t - 1 <= tlast) { softmax_pv(p0, p1, o, m_run, l_run, negm, first, lds + OFF_V + vprev * VBUF, sc, r32, hi); first = false; }
        if (t <= tlast) qk_tile<6, KP>(lds + (t & 1) * KBUF, qf, negm, p0, p1, r32, hi);
        if (grp == 0 && t <= tlast) { softmax_pv(p0, p1, o, m_run, l_run, negm, first, lds + OFF_V + vcur * VBUF, sc, r32, hi); first = false; }
        if (t + 1 < T) MLA_STORE((t + 1) & 1, vnext);
        __syncthreads();
        { const int tmp = vprev; vprev = vcur; vcur = vnext; vnext = tmp; }
    }
    if (grp == 1 && T - 1 <= tlast) softmax_pv(p0, p1, o, m_run, l_run, negm, first, lds + OFF_V + vprev * VBUF, sc, r32, hi);
#undef MLA_LOAD
#undef MLA_STORE
    attn_finish(o, l_run, Y, rb + (size_t)qb * 256 + 32 * w, 1536, 1024 + h * 64, sc, r32, hi);
    __syncthreads();
}

__device__ __forceinline__ void bandattn_unit(const bf16_t* P, const float* relb  , bf16_t* Y, int bl, int h, int grp, LAS unsigned char* lds) {
    OPAQUE_TID(tid);
    constexpr int KP = 72, KBUF = 64 * KP * 2, VBUF = 64 * VP * 2, OFF_V = 2 * KBUF, OFF_SC = OFF_V + 3 * VBUF, OFF_TB = OFF_SC + 8 * 128;
    const int lane = tid & 63, w = __builtin_amdgcn_readfirstlane(tid >> 6), r32 = lane & 31, hi = lane >> 5;
    const size_t rb = (size_t)bl * SEQ;
    LAS float* sc = (LAS float*)(lds + OFF_SC) + w * 32;
    LAS float* tb = (LAS float*)(lds + OFF_TB);
    if (tid < 257) tb[tid] = relb[tid] * LOG2E;
    const float QS = 0.125f * LOG2E;
    bf16x8 qf[4];
    { const size_t qrow = rb + (size_t)grp * 256 + 32 * w + r32;
      const bf16_t* qp = P + qrow * 4096 + h * 64;
#pragma unroll
      for (int d0 = 0; d0 < 4; ++d0) { const u32x4 raw = *(const u32x4*)(qp + 16 * d0 + 8 * hi);
          u32x4 t; t.x = pk2(bflo(raw.x) * QS, bfhi(raw.x) * QS); t.y = pk2(bflo(raw.y) * QS, bfhi(raw.y) * QS); t.z = pk2(bflo(raw.z) * QS, bfhi(raw.z) * QS); t.w = pk2(bflo(raw.w) * QS, bfhi(raw.w) * QS);
          qf[d0] = __builtin_bit_cast(bf16x8, t); } }
    const int c = 4 * grp + (w >> 1);
    const int wg = w >> 2;
    const int kc0 = (4 * grp - 8) > 0 ? (4 * grp - 8) : 0, kc1 = 4 * grp + 3;
    const int krow = tid >> 3, kch = tid & 7;
    const int vkv = tid & 63, vch = tid >> 6;
    const int vpos = (vkv & ~12) | ((vkv & 4) << 1) | ((vkv & 8) >> 1);
    const bf16_t* kp = P + (rb + krow) * 4096 + 512 + h * 64 + 8 * kch;
    const bf16_t* vp = P + (rb + vkv) * 4096 + 1024 + h * 64 + 8 * vch;
    u32x4 gk, gv;
#define BA_LOAD(kc) do { gk = *(const u32x4*)(kp + (size_t)(kc) * 64 * 4096); gv = *(const u32x4*)(vp + (size_t)(kc) * 64 * 4096); } while (0)
#define BA_STORE(kb, vb) do { *(LAS u32x4*)(lds + (kb) * KBUF + krow * (KP * 2) + kch * 16) = gk; \
        LAS bf16_t* vd = (LAS bf16_t*)(lds + OFF_V + (vb) * VBUF) + (8 * vch) * VP + vpos; \
        vd[0 * VP] = (bf16_t)(gv.x & 0xffffu); vd[1 * VP] = (bf16_t)(gv.x >> 16); vd[2 * VP] = (bf16_t)(gv.y & 0xffffu); vd[3 * VP] = (bf16_t)(gv.y >> 16); \
        vd[4 * VP] = (bf16_t)(gv.z & 0xffffu); vd[5 * VP] = (bf16_t)(gv.z >> 16); vd[6 * VP] = (bf16_t)(gv.w & 0xffffu); vd[7 * VP] = (bf16_t)(gv.w >> 16); } while (0)
    f32x16 o[2], negm, p0, p1;
#pragma unroll
    for (int r = 0; r < 16; ++r) { o[0][r] = 0.f; o[1][r] = 0.f; negm[r] = 0.f; p0[r] = 0.f; p1[r] = 0.f; }
    float m_run = 0.f, l_run = 0.f;
    bool first = true;
    BA_LOAD(kc0); BA_STORE(0, 0);
    __syncthreads();
    const int qpos = 64 * c + 32 * (w & 1) + r32;
#define BA_QK(kc, kb) do { qk_tile<4, KP>(lds + (kb) * KBUF, qf, negm, p0, p1, r32, hi); \
        if (c - (kc) >= 3) { const float bb = tb[256]; _Pragma("unroll") for (int r = 0; r < 16; ++r) { p0[r] += bb; p1[r] += bb; } } \
        else { _Pragma("unroll") for (int r = 0; r < 16; ++r) { const int d0 = qpos - (64 * (kc) + crow(r, hi)); \
            const int i0 = d0 < -128 ? -128 : (d0 > 128 ? 128 : d0), i1 = (d0 - 32) < -128 ? -128 : ((d0 - 32) > 128 ? 128 : (d0 - 32)); \
            p0[r] += tb[i0 + 128]; p1[r] += tb[i1 + 128]; } } } while (0)
    int vcur = 0, vprev = 2, vnext = 1;
#pragma unroll 1
    for (int kc = kc0, it = 0; kc <= kc1; ++kc, ++it) {
        if (kc + 1 <= kc1) BA_LOAD(kc + 1);
        if (wg == 1 && it >= 1 && kc - 1 >= c - 8 && kc - 1 <= c) { softmax_pv(p0, p1, o, m_run, l_run, negm, first, lds + OFF_V + vprev * VBUF, sc, r32, hi); first = false; }
        if (kc >= c - 8 && kc <= c) BA_QK(kc, it & 1);
        if (wg == 0 && kc >= c - 8 && kc <= c) { softmax_pv(p0, p1, o, m_run, l_run, negm, first, lds + OFF_V + vcur * VBUF, sc, r32, hi); first = false; }
        if (kc + 1 <= kc1) BA_STORE((it + 1) & 1, vnext);
        __syncthreads();
        { const int tmp = vprev; vprev = vcur; vcur = vnext; vnext = tmp; }
    }
    if (wg == 1 && kc1 <= c) softmax_pv(p0, p1, o, m_run, l_run, negm, first, lds + OFF_V + vprev * VBUF, sc, r32, hi);
#undef BA_LOAD
#undef BA_STORE
#undef BA_QK
    attn_finish(o, l_run, Y, rb + (size_t)grp * 256 + 32 * w, 1536, h * 64, sc, r32, hi);
    __syncthreads();
}

__device__ __forceinline__ void hgrn_x_unit(bf16_t* P, const float* lbl, float* DLg, int layer, int bl, int h, int c, LAS unsigned char* lds) {
    OPAQUE_TID(tid);
    constexpr int RP = 144;
    constexpr int O_LF = 0, O_SEG = 16384, O_QT = 18432, O_KT = 27648, O_KH = 36864, O_VT = 46080;
    const int lane = tid & 63, w = __builtin_amdgcn_readfirstlane(tid >> 6), r32 = lane & 31, hi = lane >> 5;
    const int j = tid >> 3, c8 = tid & 7;
    const size_t rb = (size_t)bl * SEQ + (size_t)c * 64;
    LAS float* LF = (LAS float*)(lds + O_LF); LAS float* SEG = (LAS float*)(lds + O_SEG);
    bf16_t* base = P + (rb + j) * 4096 + h * 64 + 8 * c8;
    const u32x4 rq = *(const u32x4*)(base + 1536), rf = *(const u32x4*)(base + 2048), ri = *(const u32x4*)(base + 2560);
    float kk[8];
    { const float z[8] = {bflo(rf.x), bfhi(rf.x), bflo(rf.y), bfhi(rf.y), bflo(rf.z), bfhi(rf.z), bflo(rf.w), bfhi(rf.w)};
      float lf[8];
#pragma unroll
      for (int i = 0; i < 8; ++i) { const int d = h * 64 + 8 * c8 + i; const float lb = (layer == 0) ? 0.f : sigm(lbl[512 + d] - lbl[d]);
          const float sg = sigm(z[i]); const float f = lb + (1.0f - lb) * sg; lf[i] = fmaxf(__builtin_amdgcn_logf(f), -80.0f); kk[i] = (1.0f - lb) * (1.0f - sg); }
      *(LAS f32x4*)(LF + j * 64 + 8 * c8) = (f32x4){lf[0], lf[1], lf[2], lf[3]}; *(LAS f32x4*)(LF + j * 64 + 8 * c8 + 4) = (f32x4){lf[4], lf[5], lf[6], lf[7]}; }
    __syncthreads();
    { const int d = tid & 63, sg = tid >> 6; float v[8];
#pragma unroll
      for (int k = 0; k < 8; ++k) v[k] = LF[(8 * sg + k) * 64 + d];
#pragma unroll
      for (int k = 1; k < 8; ++k) v[k] += v[k - 1];
#pragma unroll
      for (int k = 0; k < 8; ++k) LF[(8 * sg + k) * 64 + d] = v[k];
      SEG[sg * 64 + d] = v[7]; }
    __syncthreads();
    { const int sg = j >> 3;
      float off[8], tot[8], mid[8];
#pragma unroll
      for (int i = 0; i < 8; ++i) { off[i] = 0.f; tot[i] = 0.f; mid[i] = 0.f; }
#pragma unroll
      for (int s2 = 0; s2 < 8; ++s2) { const f32x4 a = *(const LAS f32x4*)(SEG + s2 * 64 + 8 * c8), b = *(const LAS f32x4*)(SEG + s2 * 64 + 8 * c8 + 4);
          const float v8[8] = {a.x, a.y, a.z, a.w, b.x, b.y, b.z, b.w};
#pragma unroll
          for (int i = 0; i < 8; ++i) { if (s2 < sg) off[i] += v8[i]; tot[i] += v8[i]; if (s2 == 3) mid[i] = tot[i]; } }
      const f32x4 ca = *(const LAS f32x4*)(LF + j * 64 + 8 * c8), cb = *(const LAS f32x4*)(LF + j * 64 + 8 * c8 + 4);
      const float cl[8] = {ca.x, ca.y, ca.z, ca.w, cb.x, cb.y, cb.z, cb.w};
      const float qr[8] = {bflo(rq.x), bfhi(rq.x), bflo(rq.y), bfhi(rq.y), bflo(rq.z), bfhi(rq.z), bflo(rq.w), bfhi(rq.w)};
      float qt[8], kt[8], qh[8], kh[8];
#pragma unroll
      for (int i = 0; i < 8; ++i) { const float cum = cl[i] + off[i]; const float qs = qr[i] * sigm(qr[i]);
          qt[i] = qs * ex2(cum - mid[i]); kt[i] = kk[i] * ex2(mid[i] - cum); qh[i] = qs * ex2(cum); kh[i] = kk[i] * ex2(tot[i] - cum); }
      *(LAS u32x4*)(lds + O_QT + j * RP + c8 * 16) = (u32x4){pk2(qt[0], qt[1]), pk2(qt[2], qt[3]), pk2(qt[4], qt[5]), pk2(qt[6], qt[7])};
      *(LAS u32x4*)(lds + O_KT + j * RP + c8 * 16) = (u32x4){pk2(kt[0], kt[1]), pk2(kt[2], kt[3]), pk2(kt[4], kt[5]), pk2(kt[6], kt[7])};
      *(u32x4*)(base + 1536) = (u32x4){pk2(qh[0], qh[1]), pk2(qh[2], qh[3]), pk2(qh[4], qh[5]), pk2(qh[6], qh[7])};
      LAS bf16_t* khp = (LAS bf16_t*)(lds + O_KH) + (8 * c8) * 72 + j;
      LAS bf16_t* vtp = (LAS bf16_t*)(lds + O_VT) + (8 * c8) * 72 + j;
      const unsigned vw[4] = {ri.x, ri.y, ri.z, ri.w};
#pragma unroll
      for (int i = 0; i < 8; ++i) { khp[i * 72] = f2bf(kh[i]); vtp[i * 72] = (bf16_t)((i & 1) ? (vw[i >> 1] >> 16) : (vw[i >> 1] & 0xffffu)); }
      if (j == 0) { float* dlp = DLg + ((size_t)((bl * 8 + h) * 128 + c)) * 64 + 8 * c8;
          *(f32x4*)dlp = (f32x4){ex2(tot[0]), ex2(tot[1]), ex2(tot[2]), ex2(tot[3])}; *(f32x4*)(dlp + 4) = (f32x4){ex2(tot[4]), ex2(tot[5]), ex2(tot[6]), ex2(tot[7])}; } }
    __syncthreads();
    if (w < 4) {
        const int I = w >> 1, DV = w & 1;
        f32x16 o;
#pragma unroll
        for (int r = 0; r < 16; ++r) o[r] = 0.f;
        for (int J = 0; J <= I; ++J) {
            f32x16 p;
#pragma unroll
            for (int r = 0; r < 16; ++r) p[r] = 0.f;
#pragma unroll
            for (int ks = 0; ks < 4; ++ks) { const bf16x8 a = *(const LAS bf16x8*)(lds + O_KT + (32 * J + r32) * RP + (16 * ks + 8 * hi) * 2);
                const bf16x8 b = *(const LAS bf16x8*)(lds + O_QT + (32 * I + r32) * RP + (16 * ks + 8 * hi) * 2); p = MFMA32(a, b, p); }
            if (J == I) {
#pragma unroll
                for (int r = 0; r < 16; ++r) if (crow(r, hi) > r32) p[r] = 0.f;
            }
#pragma unroll
            for (int k2 = 0; k2 < 2; ++k2) {
                u32x4 pw;
                if (k2 == 0) pw = (u32x4){pk2(p[0], p[1]), pk2(p[2], p[3]), pk2(p[4], p[5]), pk2(p[6], p[7])};
                else pw = (u32x4){pk2(p[8], p[9]), pk2(p[10], p[11]), pk2(p[12], p[13]), pk2(p[14], p[15])};
                const LAS unsigned char* vp = lds + O_VT + (32 * DV + r32) * RP + (32 * J + 16 * k2 + 4 * hi) * 2;
                const u32x2 lo = *(const LAS u32x2*)vp, h2 = *(const LAS u32x2*)(vp + 16);
                const u32x4 vw4 = (u32x4){lo.x, lo.y, h2.x, h2.y};
                o = MFMA32(__builtin_bit_cast(bf16x8, pw), __builtin_bit_cast(bf16x8, vw4), o);
            }
        }
        bf16_t* op = P + (rb + 32 * I) * 4096 + 2048 + h * 64 + 32 * DV + r32;
#pragma unroll
        for (int r = 0; r < 16; ++r) op[(size_t)crow(r, hi) * 4096] = f2bf(o[r]);
    } else {
        const int ww = w - 4, Dt = ww >> 1, DV = ww & 1;
        f32x16 zt;
#pragma unroll
        for (int r = 0; r < 16; ++r) zt[r] = 0.f;
#pragma unroll
        for (int ks = 0; ks < 4; ++ks) { const bf16x8 a = *(const LAS bf16x8*)(lds + O_VT + (32 * DV + r32) * RP + (16 * ks + 8 * hi) * 2);
            const bf16x8 b = *(const LAS bf16x8*)(lds + O_KH + (32 * Dt + r32) * RP + (16 * ks + 8 * hi) * 2); zt = MFMA32(a, b, zt); }
        bf16_t* zp = P + (rb + 32 * DV) * 4096 + 2560 + h * 64 + 32 * Dt + r32;
#pragma unroll
        for (int r = 0; r < 16; ++r) zp[(size_t)crow(r, hi) * 4096] = f2bf(zt[r]);
    }
    __syncthreads();
}
__device__ __forceinline__ void hgrn_scan(bf16_t* P, const float* DLg, int slice) {
    OPAQUE_TID(tid);
    const int chain = slice >> 3, bl = chain >> 3, h = chain & 7, dv = 8 * (slice & 7) + (tid >> 6), d = tid & 63;
    bf16_t* p = P + ((size_t)bl * SEQ + dv) * 4096 + 2560 + h * 64 + d;
    const float* dl = DLg + (size_t)chain * 128 * 64 + d;
    float s = 0.f;
#pragma unroll 1
    for (int c0 = 0; c0 < 128; c0 += 8) {
        bf16_t z[8]; float e[8];
#pragma unroll
        for (int k = 0; k < 8; ++k) { z[k] = p[(size_t)(c0 + k) * 64 * 4096]; e[k] = dl[(c0 + k) * 64]; }
#pragma unroll
        for (int k = 0; k < 8; ++k) { s = e[k] * s + __uint_as_float((unsigned)z[k] << 16); p[(size_t)(c0 + k) * 64 * 4096] = f2bf(s); }
    }
}
__device__ __forceinline__ void hgrn_z_unit(const bf16_t* P, const float* ng, bf16_t* Y, int bl, int h, int cp, LAS unsigned char* lds) {
    OPAQUE_TID(tid);
    const int lane = tid & 63, w = __builtin_amdgcn_readfirstlane(tid >> 6), r32 = lane & 31, hi = lane >> 5;
    const size_t rb = (size_t)bl * SEQ;
    LAS float* OB = (LAS float*)lds;
    { const int cw = 2 * cp + (w >> 2), I = (w >> 1) & 1, DV = w & 1;
      f32x16 o;
#pragma unroll
      for (int r = 0; r < 16; ++r) o[r] = 0.f;
      if (cw > 0) {
          const bf16_t* ap = P + (rb + (size_t)cw * 64 + 32 * I + r32) * 4096 + 1536 + h * 64 + 8 * hi;
          const bf16_t* bp = P + (rb + (size_t)(cw - 1) * 64 + 32 * DV + r32) * 4096 + 2560 + h * 64 + 8 * hi;
#pragma unroll
          for (int ks = 0; ks < 4; ++ks) { const bf16x8 a = *(const bf16x8*)(ap + 16 * ks), b = *(const bf16x8*)(bp + 16 * ks); o = MFMA32(a, b, o); }
      }
#pragma unroll
      for (int r = 0; r < 16; ++r) OB[((w >> 2) * 64 + 32 * I + crow(r, hi)) * 68 + 32 * DV + r32] = o[r]; }
    __syncthreads();
    const int c8 = tid & 7;
    float ngv[8];
#pragma unroll
    for (int i = 0; i < 8; ++i) ngv[i] = ng[8 * c8 + i];
#pragma unroll
    for (int it = 0; it < 2; ++it) {
        const int row = it * 64 + (tid >> 3);
        const bf16_t* pr = P + (rb + (size_t)cp * 128 + row) * 4096 + h * 64 + 8 * c8;
        const u32x4 oi = *(const u32x4*)(pr + 2048), rg = *(const u32x4*)(pr + 3072);
        const f32x4 a = *(const LAS f32x4*)(OB + row * 68 + 8 * c8), b = *(const LAS f32x4*)(OB + row * 68 + 8 * c8 + 4);
        const float ov[8] = {a.x + bflo(oi.x), a.y + bfhi(oi.x), a.z + bflo(oi.y), a.w + bfhi(oi.y), b.x + bflo(oi.z), b.y + bfhi(oi.z), b.z + bflo(oi.w), b.w + bfhi(oi.w)};
        float ss = 0.f;
#pragma unroll
        for (int i = 0; i < 8; ++i) ss += ov[i] * ov[i];
        ss += shx(ss, 1, lane); ss += shx(ss, 2, lane); ss += shx(ss, 4, lane);
        const float r = 1.0f / sqrtf(ss * (1.0f / 64.0f) + EPS);
        const float gr[8] = {bflo(rg.x), bfhi(rg.x), bflo(rg.y), bfhi(rg.y), bflo(rg.z), bfhi(rg.z), bflo(rg.w), bfhi(rg.w)};
        float ou[8];
#pragma unroll
        for (int i = 0; i < 8; ++i) ou[i] = ov[i] * r * ngv[i] * (gr[i] * sigm(gr[i]));
        *(u32x4*)(Y + (rb + (size_t)cp * 128 + row) * 1536 + 512 + h * 64 + 8 * c8) = (u32x4){pk2(ou[0], ou[1]), pk2(ou[2], ou[3]), pk2(ou[4], ou[5]), pk2(ou[6], ou[7])};
    }
    __syncthreads();
}

__device__ __forceinline__ void tr_item(const float* W, int ldw, int k0, int nsrc0, bf16_t* WT, int ldt, int nrow0, LAS float* scr, int lane, bool zero) {
    if (!zero) {
#pragma unroll 8
        for (int i = 0; i < 32; ++i) { const int kk = 2 * i + (lane >> 5); scr[kk * 33 + (lane & 31)] = W[(size_t)(k0 + kk) * ldw + nsrc0 + (lane & 31)]; }
    }
    LDS_WAIT();
    const int c = lane & 7;
#pragma unroll
    for (int jj = 0; jj < 4; ++jj) { const int n = (lane >> 3) + 8 * jj; const LAS float* s = scr + (8 * c) * 33 + n;
        u32x4 o = (u32x4){0u, 0u, 0u, 0u};
        if (!zero) { o.x = pk2(s[0 * 33], s[1 * 33]); o.y = pk2(s[2 * 33], s[3 * 33]); o.z = pk2(s[4 * 33], s[5 * 33]); o.w = pk2(s[6 * 33], s[7 * 33]); }
        *(u32x4*)(WT + (size_t)(nrow0 + n) * ldt + k0 + 8 * c) = o; }
    LDS_WAIT();
}

struct Args { const float* in[17]; float* out; unsigned char* ws; };

__global__ void __launch_bounds__(512, 2) fwd_kernel(Args a) {
    extern __shared__ __attribute__((aligned(16))) unsigned char lds_raw[];
    cg::grid_group grid = cg::this_grid();
    LAS unsigned char* lds = (LAS unsigned char*)lds_raw;
    const int G = gridDim.x, NGW = G * 8;
    typedef const __attribute__((address_space(4))) Args* KArgs;
#define KARGS(name) KArgs name = (KArgs)__builtin_amdgcn_kernarg_segment_ptr(); asm volatile("" : "+s"(name))
    {
        KARGS(ka);
        unsigned char* ws = ka->ws;
        OPAQUE_TID(tid); const int lane = tid & 63, wave = __builtin_amdgcn_readfirstlane(tid >> 6), gw = blockIdx.x * 8 + wave;
        LAS float* scr = (LAS float*)(lds + wave * 16384);
        constexpr int I_IN = 16 * 224, I_BR = 768, I_OUT = 512, I_F1 = 2048, I_F2 = 2048, I_L = I_IN + I_BR + I_OUT + I_F1 + I_F2;
        for (int it = gw; it < 2 * I_L; it += NGW) {
            const int l = it / I_L; int r = it % I_L;
            unsigned char* wl = ws + WS_W + (size_t)l * W_LAYER_REAL;
            if (r < I_IN) { const int kb = r / 224, nb = r % 224, n0 = 32 * nb; const bool zero = (n0 >= 4000 && n0 < 4096); const int ns = n0 < 4000 ? n0 : n0 - 96;
                tr_item(ka->in[3] + (size_t)l * 1024 * 7072, 7072, 64 * kb, zero ? 0 : ns, (bf16_t*)(wl + WO_IN), 1024, n0, scr, lane, zero); continue; }
            r -= I_IN;
            if (r < I_BR) { const int z = r / 256, rr = r % 256, kb = rr / 32, nb = rr % 32;
                tr_item(ka->in[11] + ((size_t)l * 3 + z) * 512 * 1024, 1024, 64 * kb, 32 * nb, (bf16_t*)(wl + WO_BR) + (size_t)z * 1024 * 512, 512, 32 * nb, scr, lane, false); continue; }
            r -= I_BR;
            if (r < I_OUT) { const int kb = r / 32, nb = r % 32; tr_item(ka->in[12] + (size_t)l * 1024 * 1024, 1024, 64 * kb, 32 * nb, (bf16_t*)(wl + WO_OUT), 1024, 32 * nb, scr, lane, false); continue; }
            r -= I_OUT;
            if (r < I_F1) { const int kb = r / 128, nb = r % 128; tr_item(ka->in[14] + (size_t)l * 1024 * 4096, 4096, 64 * kb, 32 * nb, (bf16_t*)(wl + WO_F1), 1024, 32 * nb, scr, lane, false); continue; }
            r -= I_F1;
            { const int kb = r / 32, nb = r % 32; tr_item(ka->in[15] + (size_t)l * 4096 * 1024, 1024, 64 * kb, 32 * nb, (bf16_t*)(wl + WO_F2), 4096, 32 * nb, scr, lane, false); }
        }
        const int gt = blockIdx.x * 512 + tid, GT_ = G * 512;
        for (int idx = gt; idx < 2 * 86016; idx += GT_) {
            const int l = idx / 86016; int r = idx % 86016;
            unsigned char* wl = ws + WS_W + (size_t)l * W_LAYER_REAL;
            const float* wuq = ka->in[9] + (size_t)l * 256 * 768; const float* wukv = ka->in[10] + (size_t)l * 128 * 1024;
            float v[8]; bf16_t* dst;
            if (r < 61440) { const int n = r % 1280, kc = r / 1280; dst = (bf16_t*)(wl + WO_QK) + (size_t)n * 384 + 8 * kc;
#pragma unroll
                for (int i = 0; i < 8; ++i) { const int k = 8 * kc + i;
                    v[i] = (n < 768) ? (k < 256 ? wuq[(size_t)k * 768 + n] : 0.f) : (k >= 256 ? wukv[(size_t)(k - 256) * 1024 + ((n - 768) >> 6) * 128 + ((n - 768) & 63)] : 0.f); }
            } else { r -= 61440; const int n = r % 512, kc = r / 512; dst = (bf16_t*)(wl + WO_V) + (size_t)n * 384 + 8 * kc;
#pragma unroll
                for (int i = 0; i < 8; ++i) { const int k = 8 * kc + i; v[i] = (k >= 256) ? wukv[(size_t)(k - 256) * 1024 + (n >> 6) * 128 + 64 + (n & 63)] : 0.f; }
            }
            *(u32x4*)dst = (u32x4){pk2(v[0], v[1]), pk2(v[2], v[3]), pk2(v[4], v[5]), pk2(v[6], v[7])};
        }
    }
    grid.sync();

#pragma unroll 1
    for (int l = 0; l < 2; ++l) {
        KARGS(ka); unsigned char* ws = ka->ws;
        unsigned char* wl = ws + WS_W + (size_t)l * W_LAYER_REAL;
        const bf16_t* Win_t = (const bf16_t*)(wl + WO_IN); const bf16_t* WQK_t = (const bf16_t*)(wl + WO_QK); const bf16_t* WV_t = (const bf16_t*)(wl + WO_V);
        const bf16_t* Wbr_t = (const bf16_t*)(wl + WO_BR); const bf16_t* Wout_t = (const bf16_t*)(wl + WO_OUT); const bf16_t* W1_t = (const bf16_t*)(wl + WO_F1); const bf16_t* W2_t = (const bf16_t*)(wl + WO_F2);
        const float* xin = (l == 0) ? ka->in[0] : ka->out;
#pragma unroll 1
        for (int hf = 0; hf < 2; ++hf) {
            const size_t R0 = (size_t)hf * MH;
            KARGS(ka);
            unsigned char* wsq = ka->ws; asm volatile("" : "+s"(wsq));
            unsigned* ctl = (unsigned*)(wsq + WS_CTL);
            bf16_t* XN = (bf16_t*)(wsq + WS_XN); bf16_t* CAT = (bf16_t*)(wsq + WS_CAT); bf16_t* KR = (bf16_t*)(wsq + WS_KR); float* CS = (float*)(wsq + WS_CS);
            bf16_t* P = (bf16_t*)(wsq + WS_P); bf16_t* GT = (bf16_t*)(wsq + WS_G); bf16_t* Q = (bf16_t*)(wsq + WS_Q); bf16_t* KN = (bf16_t*)(wsq + WS_KN); bf16_t* VT = (bf16_t*)(wsq + WS_VT);
            bf16_t* Y = (bf16_t*)(wsq + WS_Y); bf16_t* MG = (bf16_t*)(wsq + WS_MG);
            norm_rows_bf16(xin + R0 * DM, ka->in[2] + l * DM, XN, MH, NGW);
            grid.sync();
            { pg8::Gemm g{XN, Win_t, MH, NIN, DM, DM, DM, 0, 0}; pg8::StaticOrder S; S.init(MH, NIN, G, (int)blockIdx.x);
              pg8::EpiSplit<0, 1> E{P, 4096, 16, GT, 3072};
              pg8::gemm_phase(lds, g, S, E); }
            grid.sync();
            mla_prep(P, (const int*)ka->in[1] + R0, ka->in[7] + l * 256, ka->in[8] + l * 128, CAT, KR, CS, NGW);
            for (int u = blockIdx.x; u < 2048; u += G) hgrn_x_unit(P, ka->in[5], (float*)(wsq + WS_DL), l, u >> 10, (u >> 7) & 7, u & 127, lds);
            grid.sync();
            { pg8::Gemm g{CAT, WQK_t, MH, 1280, 384, 384, 384, 0, 0}; pg8::StaticOrder S; S.init(MH, 1280, G, (int)blockIdx.x);
              pg8::EpiSplit<0, 0> E{Q, 768, 3, KN, 512};
              pg8::gemm_phase(lds, g, S, E); }
            { pg8::Gemm g{WV_t, CAT, 512, MH, 384, 384, 384, 0, 0}; pg8::StaticOrder S; S.init(512, MH, G, (int)blockIdx.x);
              pg8::EpiSplit<0, 0> E{VT, MH, 1 << 30, VT, MH};
              pg8::gemm_phase(lds, g, S, E); }
            if ((int)blockIdx.x >= G - 128) hgrn_scan(P, (const float*)(wsq + WS_DL), (int)blockIdx.x - (G - 128));
            grid.sync();
#ifndef PROBE_RUN
#define PROBE_RUN 0
#endif
#define PH4_BODY(RUN, CTR) { \
                OPAQUE_TID(tid); \
                unsigned* ctr = (CTR); \
                LAS int* slot = (LAS int*)(lds + 131072); \
                for (;;) { \
                    if (tid == 0) slot[0] = (int)__hip_atomic_fetch_add(ctr, 1u, __ATOMIC_RELAXED, __HIP_MEMORY_SCOPE_AGENT); \
                    __syncthreads(); \
                    const int item = __builtin_amdgcn_readfirstlane(slot[0]); \
                    __syncthreads(); \
                    if (item >= 2048) break; \
                    if (item < 512) { const int k = item; if ((RUN) & 2) mla_unit(Q, KN, KR, VT, CS, Y, (k & 15) >> 3, k & 7, 31 - (k >> 4), lds); } \
                    else if (item < 1024) { const int k = item - 512; if ((RUN) & 4) bandattn_unit(P, ka->in[4] + ((size_t)l * 8 + (k & 7)) * 257, Y, (k & 15) >> 3, k & 7, k >> 4, lds); } \
                    else { const int k = item - 1024; if ((RUN) & 1) hgrn_z_unit(P, ka->in[6] + l * 64, Y, k >> 9, (k >> 6) & 7, k & 63, lds); } \
                } \
                grid.sync(); }
            PH4_BODY(7, ctl + 64 * (l * 2 + hf))
#if PROBE_RUN
            PH4_BODY(PROBE_RUN, ctl + 64 * (l * 2 + hf) + 256)
#endif
            { pg8::Gemm g{Y, Wbr_t, MH, 1024, 512, 1536, 512, (size_t)512 * 2, (size_t)1024 * 512 * 2}; pg8::BranchOrder S{G, (int)blockIdx.x};
              pg8::EpiBranch E{GT, MG};
              pg8::gemm_phase(lds, g, S, E); }
            grid.sync();
            { pg8::Gemm g{MG, Wout_t, MH, DM, DM, DM, DM, 0, 0}; pg8::StaticOrder S; S.init(MH, DM, G, (int)blockIdx.x);
              pg8::EpiResid E{xin + R0 * DM, ka->out + R0 * DM};
              pg8::gemm_phase(lds, g, S, E); }
            grid.sync();
        }
        KARGS(kf); { KArgs ka = kf;
        unsigned char* wsf = ka->ws; asm volatile("" : "+s"(wsf));
        bf16_t* XN = (bf16_t*)(wsf + WS_XN); bf16_t* HB = (bf16_t*)(wsf + WS_H);
        norm_rows_bf16(ka->out, ka->in[13] + l * DM, XN, MTOT, NGW);
        grid.sync();
        { pg8::Gemm g{XN, W1_t, MTOT, FF, DM, DM, DM, 0, 0}; pg8::StaticOrder S; S.init(MTOT, FF, G, (int)blockIdx.x);
          pg8::EpiSplit<2, 2> E{HB, FF, 1 << 30, HB, FF};
          pg8::gemm_phase(lds, g, S, E); }
        grid.sync();
        { pg8::Gemm g{HB, W2_t, MTOT, DM, FF, FF, FF, 0, 0}; pg8::StaticOrder S; S.init(MTOT, DM, G, (int)blockIdx.x);
          pg8::EpiResid E{ka->out, ka->out};
          pg8::gemm_phase(lds, g, S, E); }
        grid.sync(); }
    }
    KARGS(kz);
    norm_rows_f32_inplace(kz->out, kz->in[16], MTOT, NGW);
}

extern "C" void kernel_launch(void* const* d_in, const int* in_sizes, int n_in, void* d_out, int out_size, void* d_ws, size_t ws_size, hipStream_t stream) {
    static int grid = 0;
    if (grid == 0) {
        int dev = 0, cus = 0, per_cu = 0;
        (void)hipGetDevice(&dev);
        (void)hipDeviceGetAttribute(&cus, hipDeviceAttributeMultiprocessorCount, dev);
        (void)hipFuncSetAttribute((const void*)fwd_kernel, hipFuncAttributeMaxDynamicSharedMemorySize, LDS_BYTES);
        (void)hipOccupancyMaxActiveBlocksPerMultiprocessor(&per_cu, (const void*)fwd_kernel, 512, LDS_BYTES);
        if (per_cu < 1) per_cu = 1;
        grid = cus * per_cu;
        if (ws_size < (size_t)504 * MiB) fprintf(stderr, "kernel_launch: workspace too small (%zu)\n", ws_size);
    }
    (void)hipMemsetAsync((char*)d_ws + WS_CTL, 0, 4096, stream);
    Args a{};
    for (int i = 0; i < 17; ++i) a.in[i] = (const float*)d_in[i];
    a.out = (float*)d_out; a.ws = (unsigned char*)d_ws;
    void* args[] = {&a};
    hipError_t e = hipLaunchCooperativeKernel((void*)fwd_kernel, dim3(grid), dim3(512), args, LDS_BYTES, stream);
    if (e != hipSuccess) fprintf(stderr, "cooperative launch failed: %s (grid %d)\n", hipGetErrorString(e), grid);
}
```

```cpp
#include <hip/hip_runtime.h>
#include <hip/hip_cooperative_groups.h>
#include <cstdio>
#include <cstdint>
namespace cg = cooperative_groups;

#define LAS __attribute__((address_space(3)))
#define GAS __attribute__((address_space(1)))
typedef unsigned short bf16_t;
typedef short bf16x8 __attribute__((ext_vector_type(8)));
typedef float f32x4 __attribute__((ext_vector_type(4)));
typedef float f32x16 __attribute__((ext_vector_type(16)));
typedef unsigned u32x4 __attribute__((ext_vector_type(4)));
typedef unsigned u32x2 __attribute__((ext_vector_type(2)));
typedef float f32x2_t __attribute__((ext_vector_type(2)));
typedef __bf16 bf16x2_t __attribute__((ext_vector_type(2)));

__device__ __forceinline__ unsigned pk2(float lo, float hi) { f32x2_t v = {lo, hi}; bf16x2_t b = __builtin_convertvector(v, bf16x2_t); return __builtin_bit_cast(unsigned, b); }
__device__ __forceinline__ bf16_t f2bf(float f) { return (bf16_t)(pk2(f, 0.f) & 0xffffu); }
__device__ __forceinline__ float bflo(unsigned w) { return __uint_as_float(w << 16); }
__device__ __forceinline__ float bfhi(unsigned w) { return __uint_as_float(w & 0xffff0000u); }
__device__ __forceinline__ float ex2(float x) { return __builtin_amdgcn_exp2f(x); }
__device__ __forceinline__ float sigm(float x) { return __builtin_amdgcn_rcpf(1.0f + ex2(-1.4426950408889634f * x)); }
__device__ __forceinline__ int crow(int r, int hi) { return (r & 3) + 8 * (r >> 2) + 4 * hi; }
__device__ __forceinline__ float shx(float v, int mask, int lane) { return __int_as_float(__builtin_amdgcn_ds_bpermute((lane ^ mask) << 2, __float_as_int(v))); }
__device__ __forceinline__ float wave_sum(float v, int lane) {
#pragma unroll
    for (int o = 1; o < 64; o <<= 1) v += shx(v, o, lane);
    return v;
}
template <class T> __device__ __forceinline__ T* as_global(T* p) { return (T*)(__attribute__((address_space(1))) T*)p; }
#define OPAQUE_TID(t) int t; asm volatile("v_mbcnt_lo_u32_b32 %0, -1, 0\n\tv_mbcnt_hi_u32_b32 %0, -1, %0\n\tv_lshl_add_u32 %0, %1, 6, %0" : "=&v"(t) : "s"(wv_))
#define LDS_WAIT() asm volatile("s_waitcnt lgkmcnt(0)" ::: "memory")
#define MFMA32(a, b, c) __builtin_amdgcn_mfma_f32_32x32x16_bf16((a), (b), (c), 0, 0, 0)

namespace pg8 {
constexpr int BM = 256, BK = 64, HALF = 128, HTB = HALF * BK * 2, STAGE_BYTES = 8 * HTB, NXCD = 8, WGM = 8;
__host__ __device__ __forceinline__ int lds_byte(int r, int c) { const int st = (r >> 4) * 2 + (c >> 5), rr = r & 15, cc = c & 31, ob = rr * 64 + cc * 2; return st * 1024 + (ob ^ (((ob >> 9) & 1) << 5)); }
__host__ __device__ __forceinline__ void stage_rc(int b, int& R, int& C) { const int st = b / 1024, sb = b % 1024, swz = sb ^ (((sb >> 9) & 1) << 5); R = (st >> 1) * 16 + swz / 64; C = (st & 1) * 32 + (swz % 64) / 2; }
__host__ __device__ __forceinline__ int perm32(int rho) { const int n = rho >> 4, i = rho & 15; return 8 * (i >> 2) + 4 * n + (i & 3); }

struct Unit { int pm, pn, z; };
struct Gemm { const bf16_t* A; const bf16_t* Bt; int M, N, K, lda, ldb; size_t za, zb; };

struct StaticOrder {
    int nM, nN, nwg, G, c;
    __device__ void init(int M, int N, int G_, int c_) { nM = M / BM; nN = N / BM; nwg = nM * nN; G = G_; c = c_; }
    __device__ bool next(int i, Unit& u) const {
        const long L = (long)i * G + c; if (L >= nwg) return false;
        int wgid = (int)L; { const int q = nwg / NXCD, r = nwg % NXCD, xcd = wgid % NXCD, off = wgid / NXCD; wgid = (xcd < r ? xcd * (q + 1) : r * (q + 1) + (xcd - r) * q) + off; }
        const int nig = WGM * nN, gid = wgid / nig, fm = gid * WGM, gsz = (nM - fm) < WGM ? (nM - fm) : WGM;
        u.pm = fm + ((wgid % nig) % gsz); u.pn = (wgid % nig) / gsz; u.z = 0; return true;
    }
};
struct BranchOrder {
    int G, c;
    __device__ bool next(int i, Unit& u) const {
        const int p = (i / 3) * G + c; if (p >= 256) return false;
        const int xcd = p & 7, off = p >> 3; u.pm = xcd * 8 + (off >> 2); u.pn = off & 3; u.z = i % 3; return true;
    }
};

template <int ACT0, int ACT1> struct EpiSplit {
    static constexpr bool PERM = true;
    bf16_t* O0; int ld0; int nsplit; bf16_t* O1; int ld1; const float* ss;
    __device__ __forceinline__ void operator()(const f32x4 (&acc)[2][2][4][2], const Unit& u, int wr, int wc, int fr, int fq) const {
        const bool first = u.pn < nsplit;
        bf16_t* base = first ? O0 : O1; const int ldc = first ? ld0 : ld1; const int colt = (first ? u.pn : u.pn - nsplit) * BM;
        const int act = first ? ACT0 : ACT1;
        const int row0 = u.pm * BM + wr * 64 + fr, col0 = colt + wc * 32 + 8 * fq;
#pragma unroll
        for (int ai = 0; ai < 2; ++ai)
#pragma unroll
            for (int m = 0; m < 4; ++m) { bf16_t* rowp = base + (size_t)(row0 + ai * HALF + m * 16) * ldc + col0;
                float rs = 1.0f; if (ss) rs = 1.0f / sqrtf(((const GAS float*)ss)[row0 + ai * HALF + m * 16] * (1.0f / 1024.0f) + 1e-6f);
#pragma unroll
                for (int bj = 0; bj < 2; ++bj) { f32x4 v0 = acc[ai][bj][m][0] * rs, v1 = acc[ai][bj][m][1] * rs;
                    if (act == 1) {
#pragma unroll
                        for (int e = 0; e < 4; ++e) { v0[e] = sigm(v0[e]); v1[e] = sigm(v1[e]); }
                    } else if (act == 2) {
#pragma unroll
                        for (int e = 0; e < 4; ++e) { const float a = fmaxf(v0[e], 0.f), b = fmaxf(v1[e], 0.f); v0[e] = a * a; v1[e] = b * b; }
                    }
                    u32x4 w; w.x = pk2(v0[0], v0[1]); w.y = pk2(v0[2], v0[3]); w.z = pk2(v1[0], v1[1]); w.w = pk2(v1[2], v1[3]);
                    *(GAS u32x4*)(rowp + bj * HALF) = w; } }
    }
};
struct EpiBranch {
    static constexpr bool PERM = true;
    const bf16_t* Gt; bf16_t* Mg;
    __device__ __forceinline__ void operator()(const f32x4 (&acc)[2][2][4][2], const Unit& u, int wr, int wc, int fr, int fq) const {
        const int row0 = u.pm * BM + wr * 64 + fr, col0 = u.pn * BM + wc * 32 + 8 * fq;
#pragma unroll
        for (int ai = 0; ai < 2; ++ai) {
            u32x4 g[2][4], pv[2][4];
#pragma unroll
            for (int bj = 0; bj < 2; ++bj)
#pragma unroll
                for (int m = 0; m < 4; ++m) { const size_t row = (size_t)(row0 + ai * HALF + m * 16);
                    g[bj][m] = *(const GAS u32x4*)(Gt + row * 3072 + u.z * 1024 + col0 + bj * HALF);
                    pv[bj][m] = (u32x4){0u, 0u, 0u, 0u}; if (u.z > 0) pv[bj][m] = *(const GAS u32x4*)(Mg + row * 1024 + col0 + bj * HALF); }
#pragma unroll
            for (int bj = 0; bj < 2; ++bj)
#pragma unroll
                for (int m = 0; m < 4; ++m) { const size_t row = (size_t)(row0 + ai * HALF + m * 16);
                    const f32x4 v0 = acc[ai][bj][m][0], v1 = acc[ai][bj][m][1]; const u32x4 gg = g[bj][m], pp = pv[bj][m];
                    float o[8];
                    o[0] = bflo(pp.x) + bflo(gg.x) * v0[0]; o[1] = bfhi(pp.x) + bfhi(gg.x) * v0[1]; o[2] = bflo(pp.y) + bflo(gg.y) * v0[2]; o[3] = bfhi(pp.y) + bfhi(gg.y) * v0[3];
                    o[4] = bflo(pp.z) + bflo(gg.z) * v1[0]; o[5] = bfhi(pp.z) + bfhi(gg.z) * v1[1]; o[6] = bflo(pp.w) + bflo(gg.w) * v1[2]; o[7] = bfhi(pp.w) + bfhi(gg.w) * v1[3];
                    u32x4 w; w.x = pk2(o[0], o[1]); w.y = pk2(o[2], o[3]); w.z = pk2(o[4], o[5]); w.w = pk2(o[6], o[7]);
                    *(GAS u32x4*)(Mg + row * 1024 + col0 + bj * HALF) = w; }
        }
    }
};
struct EpiResid {
    static constexpr bool PERM = true;
    const float* base; float* out; bf16_t* xb; float* ssq;
    __device__ __forceinline__ void operator()(const f32x4 (&acc)[2][2][4][2], const Unit& u, int wr, int wc, int fr, int fq) const {
        const int row0 = u.pm * BM + wr * 64 + fr, col0 = u.pn * BM + wc * 32 + 8 * fq, lane = fr + 16 * fq;
#pragma unroll
        for (int ai = 0; ai < 2; ++ai) {
            f32x4 b[4][2][2];
#pragma unroll
            for (int m = 0; m < 4; ++m) { const size_t off = (size_t)(row0 + ai * HALF + m * 16) * 1024 + col0;
#pragma unroll
                for (int bj = 0; bj < 2; ++bj) { b[m][bj][0] = *(const GAS f32x4*)(base + off + bj * HALF); b[m][bj][1] = *(const GAS f32x4*)(base + off + bj * HALF + 4); } }
#pragma unroll
            for (int m = 0; m < 4; ++m) { const int row = row0 + ai * HALF + m * 16; const size_t off = (size_t)row * 1024 + col0;
                float sq = 0.f;
#pragma unroll
                for (int bj = 0; bj < 2; ++bj) { const f32x4 o0 = b[m][bj][0] + acc[ai][bj][m][0], o1 = b[m][bj][1] + acc[ai][bj][m][1];
                    *(GAS f32x4*)(out + off + bj * HALF) = o0; *(GAS f32x4*)(out + off + bj * HALF + 4) = o1;
                    *(GAS u32x4*)(xb + off + bj * HALF) = (u32x4){pk2(o0[0], o0[1]), pk2(o0[2], o0[3]), pk2(o1[0], o1[1]), pk2(o1[2], o1[3])};
                    sq += (o0[0] * o0[0] + o0[1] * o0[1]) + (o0[2] * o0[2] + o0[3] * o0[3]) + (o1[0] * o1[0] + o1[1] * o1[1]) + (o1[2] * o1[2] + o1[3] * o1[3]); }
                sq += shx(sq, 16, lane); sq += shx(sq, 32, lane);
                if (fq == 0) __hip_atomic_fetch_add((GAS float*)(ssq + row), sq, __ATOMIC_RELAXED, __HIP_MEMORY_SCOPE_AGENT); }
        }
    }
};

template <class Epi, class Sched>
__device__ __forceinline__ void gemm_phase(LAS unsigned char* lds, const Gemm g, const Sched& S, const Epi& E, int wv_) {
    OPAQUE_TID(tid);
    const int wid = __builtin_amdgcn_readfirstlane(tid >> 6), lane = tid & 63, wr = wid >> 2, wc = wid & 3, fr = lane & 15, fq = lane >> 4;
    const int K = g.K, nt = K / BK;
    unsigned voffA[2], voffB[2];
#pragma unroll
    for (int i = 0; i < 2; ++i) { int R, C; stage_rc(tid * 16 + i * 8192, R, C); const int Rb = Epi::PERM ? ((R & ~31) + perm32(R & 31)) : R;
        voffA[i] = (unsigned)(R * g.lda + C) * 2u; voffB[i] = (unsigned)(Rb * g.ldb + C) * 2u; }
    const size_t kstep = (size_t)(BK * 2);
    const size_t hstepA = (size_t)HALF * g.lda * 2, hstepB = (size_t)HALF * g.ldb * 2;
    const size_t tstepA = 2 * hstepA, tstepB = 2 * hstepB;
    const unsigned ldsw = (unsigned)wid * 1024u;
    const int aoff = lds_byte(wr * 64 + fr, fq * 8), boff = lds_byte(wc * 32 + fr, fq * 8);
#define PG8_SA(b, h) (((b) * 2 + (h)) * HTB)
#define PG8_SB(b, h) ((4 + (b) * 2 + (h)) * HTB)
#define PG8_STAGE(bufoff, gbase, voff) do { _Pragma("unroll") for (int _i = 0; _i < 2; ++_i) { unsigned vo_ = (voff)[_i]; asm volatile("" : "+v"(vo_));     \
        __builtin_amdgcn_global_load_lds((const unsigned*)((const char*)(gbase) + vo_), (LAS unsigned*)(lds + (bufoff) + ldsw + _i * 8192), 16, 0, 0); } } while (0)
#define PG8_LDA(dst, b, h) do { _Pragma("unroll") for (int m = 0; m < 4; ++m) _Pragma("unroll") for (int k = 0; k < 2; ++k) dst[m][k] = *(const LAS bf16x8*)(lds + PG8_SA(b, h) + aoff + m * 2048 + k * 1024); } while (0)
#define PG8_LDB(dst, b, h) do { _Pragma("unroll") for (int n = 0; n < 2; ++n) _Pragma("unroll") for (int k = 0; k < 2; ++k) dst[n][k] = *(const LAS bf16x8*)(lds + PG8_SB(b, h) + boff + n * 2048 + k * 1024); } while (0)
#define PG8_MMA(ai, bj, At, Bt) do { __builtin_amdgcn_s_setprio(1); _Pragma("unroll") for (int m = 0; m < 4; ++m) _Pragma("unroll") for (int n = 0; n < 2; ++n) _Pragma("unroll") for (int k = 0; k < 2; ++k) \
        acc[ai][bj][m][n] = __builtin_amdgcn_mfma_f32_16x16x32_bf16(Bt[n][k], At[m][k], acc[ai][bj][m][n], 0, 0, 0); __builtin_amdgcn_s_setprio(0); } while (0)
#define PG8_WAIT_V(n) asm volatile("s_waitcnt vmcnt(" #n ")" ::: "memory")
#define PG8_WAIT_L(n) asm volatile("s_waitcnt lgkmcnt(" #n ")" ::: "memory")
#define PG8_BAR __builtin_amdgcn_s_barrier()
#define PG8_SCHED __builtin_amdgcn_sched_barrier(0)
    Unit cur, nxt; int ui = 0;
    if (!S.next(0, cur)) return;
    f32x4 acc[2][2][4][2];
#pragma unroll
    for (int a = 0; a < 2; ++a)
#pragma unroll
        for (int b = 0; b < 2; ++b)
#pragma unroll
            for (int m = 0; m < 4; ++m)
#pragma unroll
                for (int n = 0; n < 2; ++n) acc[a][b][m][n] = (f32x4){0.f, 0.f, 0.f, 0.f};
    bf16x8 At[4][2], B0[2][2], B1[2][2];
    const char* cA = (const char*)g.A + (size_t)cur.pm * tstepA + (size_t)cur.z * g.za; const char* cB = (const char*)g.Bt + (size_t)cur.pn * tstepB + (size_t)cur.z * g.zb;
    PG8_STAGE(PG8_SB(0, 0), cB, voffB); PG8_STAGE(PG8_SB(0, 1), cB + hstepB, voffB); PG8_STAGE(PG8_SA(0, 0), cA, voffA); PG8_STAGE(PG8_SA(0, 1), cA + hstepA, voffA);
    if (wr == 1) PG8_BAR;
    PG8_WAIT_V(2); PG8_BAR;
    PG8_STAGE(PG8_SB(1, 0), cB + kstep, voffB); PG8_STAGE(PG8_SA(1, 0), cA + kstep, voffA); PG8_STAGE(PG8_SB(1, 1), cB + hstepB + kstep, voffB);
    PG8_WAIT_V(6); PG8_BAR;
    for (;;) {
        const bool has_next = S.next(ui + 1, nxt);
        const char* nA = has_next ? (const char*)g.A + (size_t)nxt.pm * tstepA + (size_t)nxt.z * g.za : cA; const char* nB = has_next ? (const char*)g.Bt + (size_t)nxt.pn * tstepB + (size_t)nxt.z * g.zb : cB;
        for (int t = 0; t < nt; t += 2) {
            const bool last = (t == nt - 2);
            const char* a1 = cA + (size_t)(t + 1) * kstep;
            const char* a2 = last ? nA : cA + (size_t)(t + 2) * kstep; const char* b2 = last ? nB : cB + (size_t)(t + 2) * kstep;
            const char* a3 = a2 + kstep; const char* b3 = b2 + kstep;
            PG8_LDB(B0, 0, 0); PG8_LDB(B1, 0, 1); PG8_SCHED; PG8_LDA(At, 0, 0); PG8_STAGE(PG8_SA(1, 1), a1 + hstepA, voffA);
            PG8_WAIT_V(8); PG8_WAIT_L(0); PG8_BAR; PG8_MMA(0, 0, At, B0); PG8_MMA(0, 1, At, B1); PG8_BAR; PG8_SCHED;
            PG8_LDA(At, 0, 1); PG8_STAGE(PG8_SB(0, 0), b2, voffB); PG8_STAGE(PG8_SB(0, 1), b2 + hstepB, voffB); PG8_STAGE(PG8_SA(0, 0), a2, voffA);
            PG8_WAIT_V(8); PG8_WAIT_L(0); PG8_BAR; PG8_MMA(1, 0, At, B0); PG8_MMA(1, 1, At, B1); PG8_BAR; PG8_SCHED;
            PG8_LDB(B0, 1, 0); PG8_LDB(B1, 1, 1); PG8_SCHED; PG8_LDA(At, 1, 0); PG8_STAGE(PG8_SA(0, 1), a2 + hstepA, voffA);
            PG8_WAIT_V(8); PG8_WAIT_L(0); PG8_BAR; PG8_MMA(0, 0, At, B0); PG8_MMA(0, 1, At, B1); PG8_BAR; PG8_SCHED;
            PG8_LDA(At, 1, 1); PG8_STAGE(PG8_SB(1, 0), b3, voffB); PG8_STAGE(PG8_SB(1, 1), b3 + hstepB, voffB); PG8_STAGE(PG8_SA(1, 0), a3, voffA);
            PG8_WAIT_V(8); PG8_WAIT_L(0); PG8_BAR; PG8_MMA(1, 0, At, B0); PG8_MMA(1, 1, At, B1); PG8_BAR; PG8_SCHED;
        }
        if (wr == 0) PG8_BAR;
        { OPAQUE_TID(t2_); E(acc, cur, wr, wc, t2_ & 15, (t2_ >> 4) & 3); }
        if (!has_next) break;
#pragma unroll
        for (int a = 0; a < 2; ++a)
#pragma unroll
            for (int b = 0; b < 2; ++b)
#pragma unroll
                for (int m = 0; m < 4; ++m)
#pragma unroll
                    for (int n = 0; n < 2; ++n) acc[a][b][m][n] = (f32x4){0.f, 0.f, 0.f, 0.f};
        cur = nxt; cA = nA; cB = nB; ++ui;
        if (wr == 1) PG8_BAR;
    }
    PG8_WAIT_V(0);
    PG8_BAR;
#undef PG8_SA
#undef PG8_SB
#undef PG8_STAGE
#undef PG8_LDA
#undef PG8_LDB
#undef PG8_MMA
#undef PG8_WAIT_V
#undef PG8_WAIT_L
#undef PG8_BAR
#undef PG8_SCHED
}
}

constexpr int DM = 1024, SEQ = 8192, MTOT = 32768, MH = 16384, NIN = 7168, FF = 4096;
constexpr float EPS = 1e-6f, LOG2E = 1.4426950408889634f;
constexpr int LDS_BYTES = 147456;
constexpr size_t MiB = 1u << 20;
constexpr size_t WS_CTL = 0;
constexpr size_t WS_W = 1 * MiB, W_LAYER = 36 * MiB;
constexpr size_t WO_IN = 0, WO_QK = 14 * MiB, WO_V = 15 * MiB, WO_BR = 16 * MiB, WO_OUT = 19 * MiB, WO_F1 = 21 * MiB, WO_F2 = 29 * MiB;
constexpr size_t W_LAYER_REAL = 37 * MiB;
constexpr size_t WS_DL = 75 * MiB;
constexpr size_t WS_XN = 80 * MiB;
constexpr size_t WS_CS = 75 * MiB + 512 * 1024;
constexpr size_t WS_SS = 78 * MiB;
constexpr size_t WS_P = 144 * MiB;
constexpr size_t WS_G = 272 * MiB;
constexpr size_t WS_Q = 368 * MiB;
constexpr size_t WS_KN = 392 * MiB;
constexpr size_t WS_VT = 408 * MiB;
constexpr size_t WS_Y = 424 * MiB;
constexpr size_t WS_MG = 472 * MiB;
constexpr size_t WS_H = 144 * MiB;
static_assert(WS_W + 2 * W_LAYER_REAL <= WS_XN, "weights fit");

__device__ __forceinline__ void rows_bf16_ssq(const float* x, bf16_t* dst, float* ssq, int rows, int NGW, int wv_) {
    OPAQUE_TID(tid_); const int lane = tid_ & 63, gw = blockIdx.x * 8 + __builtin_amdgcn_readfirstlane(tid_ >> 6);
    for (int m0 = gw * 4; m0 < rows; m0 += NGW * 4) {
        f32x4 v[4][4];
#pragma unroll
        for (int q = 0; q < 4; ++q) { const GAS f32x4* xr = (const GAS f32x4*)(x + (size_t)(m0 + q) * DM) + lane;
#pragma unroll
            for (int j = 0; j < 4; ++j) v[q][j] = xr[64 * j]; }
#pragma unroll
        for (int q = 0; q < 4; ++q) { float s = 0.f;
            GAS unsigned long long* o8 = (GAS unsigned long long*)(dst + (size_t)(m0 + q) * DM) + lane;
#pragma unroll
            for (int j = 0; j < 4; ++j) { const f32x4 t = v[q][j]; s += (t.x * t.x + t.y * t.y) + (t.z * t.z + t.w * t.w);
                o8[64 * j] = (unsigned long long)pk2(t.x, t.y) | ((unsigned long long)pk2(t.z, t.w) << 32); }
            s = wave_sum(s, lane);
            if (lane == 0) ((GAS float*)ssq)[m0 + q] = s; }
    }
}
__device__ __forceinline__ void final_norm(float* x, const float* g, const float* ssq, int G, int wv_) {
    OPAQUE_TID(tid_);
    const size_t n4 = (size_t)MTOT * DM / 4, stride = (size_t)G * 512;
    for (size_t i = (size_t)blockIdx.x * 512 + tid_; i < n4; i += stride) {
        const f32x4 v = ((const GAS f32x4*)x)[i];
        const float r = 1.0f / sqrtf(((const GAS float*)ssq)[i >> 8] * (1.0f / DM) + EPS);
        const f32x4 gg = ((const GAS f32x4*)g)[i & 255];
        ((GAS f32x4*)x)[i] = v * r * gg;
    }
}
__device__ __forceinline__ void mla_prep(bf16_t* P, const int* pos, const float* gq, const float* gkv, float* cs, int NGW, int wv_) {
    OPAQUE_TID(tid_); const int lane = tid_ & 63, gw = blockIdx.x * 8 + __builtin_amdgcn_readfirstlane(tid_ >> 6);
    const f32x4 gg = ((const GAS f32x4*)gq)[lane];
    const float gk0 = ((const GAS float*)gkv)[2 * lane], gk1 = ((const GAS float*)gkv)[2 * lane + 1];
    const float invf = exp2f(-(float)(lane & 15) * 0.83048202372184059f);
    for (int m0 = gw * 4; m0 < MH; m0 += NGW * 4) {
        u32x2 wq[4]; unsigned wk[4]; float x1[4], x2[4]; int ps[4];
#pragma unroll
        for (int q = 0; q < 4; ++q) { GAS bf16_t* prow = (GAS bf16_t*)(P + (size_t)(m0 + q) * 4096 + 3584);
            wq[q] = *(const GAS u32x2*)(prow + 4 * lane); wk[q] = *(const GAS unsigned*)(prow + 256 + 2 * lane);
            x1[q] = __uint_as_float((unsigned)prow[384 + (lane & 15)] << 16); x2[q] = __uint_as_float((unsigned)prow[400 + (lane & 15)] << 16); ps[q] = ((const GAS int*)pos)[m0 + q]; }
#pragma unroll
        for (int q = 0; q < 4; ++q) { GAS bf16_t* prow = (GAS bf16_t*)(P + (size_t)(m0 + q) * 4096 + 3584); const int m = m0 + q;
            { const float a = bflo(wq[q].x), b = bfhi(wq[q].x), c = bflo(wq[q].y), d = bfhi(wq[q].y);
              const float r = 1.0f / sqrtf(wave_sum((a * a + b * b) + (c * c + d * d), lane) * (1.0f / 256.0f) + EPS);
              u32x2 o; o.x = pk2(a * r * gg.x, b * r * gg.y); o.y = pk2(c * r * gg.z, d * r * gg.w);
              *(GAS u32x2*)(prow + 4 * lane) = o; }
            { const float a = bflo(wk[q]), b = bfhi(wk[q]);
              const float r = 1.0f / sqrtf(wave_sum(a * a + b * b, lane) * (1.0f / 128.0f) + EPS);
              *(GAS unsigned*)(prow + 256 + 2 * lane) = pk2(a * r * gk0, b * r * gk1); }
            if (lane < 16) {
                double fr = (double)ps[q] * (double)invf * 0.15915494309189535;
                fr -= rint(fr);
                const float c = __builtin_amdgcn_cosf((float)fr), s = __builtin_amdgcn_sinf((float)fr);
                ((GAS float*)cs)[(size_t)m * 32 + lane] = c; ((GAS float*)cs)[(size_t)m * 32 + 16 + lane] = s;
                prow[384 + lane] = f2bf(x1[q] * c - x2[q] * s); prow[400 + lane] = f2bf(x2[q] * c + x1[q] * s);
            } }
    }
}

constexpr int VP = 72;
__device__ __forceinline__ float max3f(float a, float b, float c) { return __builtin_fmaxf(__builtin_fmaxf(a, b), c); }
template <int ND0, int KP>
__device__ __forceinline__ void qk_tile(const LAS unsigned char* Ks, const bf16x8 (&qf)[ND0], const f32x16& negm, f32x16& p0, f32x16& p1, int r32, int hi) {
#pragma unroll
    for (int d0 = 0; d0 < ND0; ++d0) {
        const bf16x8 a0 = *(const LAS bf16x8*)(Ks + r32 * (KP * 2) + (16 * d0 + 8 * hi) * 2);
        const bf16x8 a1 = *(const LAS bf16x8*)(Ks + (r32 + 32) * (KP * 2) + (16 * d0 + 8 * hi) * 2);
        if (d0 == 0) { p0 = MFMA32(a0, qf[0], negm); p1 = MFMA32(a1, qf[0], negm); }
        else { p0 = MFMA32(a0, qf[d0], p0); p1 = MFMA32(a1, qf[d0], p1); }
    }
}
__device__ __forceinline__ void softmax_pv(f32x16& p0, f32x16& p1, f32x16 (&o)[2], float& m_run, float& l_run, f32x16& negm, bool first, const LAS unsigned char* Vts, LAS float* sc, int r32, int hi) {
    float a = max3f(p0[0], p0[1], p1[0]), b = max3f(p0[2], p0[3], p1[1]); a = max3f(a, p1[2], p1[3]);
#pragma unroll
    for (int r = 4; r < 16; r += 4) { a = max3f(a, p0[r], p0[r + 1]); b = max3f(b, p0[r + 2], p0[r + 3]); a = max3f(a, p1[r], p1[r + 1]); b = max3f(b, p1[r + 2], p1[r + 3]); }
    float mx = __builtin_fmaxf(a, b);
    { auto rr = __builtin_amdgcn_permlane32_swap(__float_as_uint(mx), __float_as_uint(mx), false, false); mx = __builtin_fmaxf(__uint_as_float(rr[0]), __uint_as_float(rr[1])); }
    if (first || __any(mx > 8.0f)) {
        const float dl = first ? mx : __builtin_fmaxf(mx, 0.f);
        m_run += dl;
#pragma unroll
        for (int r = 0; r < 16; ++r) { p0[r] -= dl; p1[r] -= dl; negm[r] = -m_run; }
        if (!first) {
            const float al = ex2(-dl); l_run *= al;
            if (hi == 0) sc[r32] = al;
            LDS_WAIT();
#pragma unroll
            for (int g4 = 0; g4 < 4; ++g4) { const f32x4 av = *(const LAS f32x4*)(sc + 8 * g4 + 4 * hi);
#pragma unroll
                for (int e = 0; e < 4; ++e) { o[0][4 * g4 + e] *= av[e]; o[1][4 * g4 + e] *= av[e]; } }
            LDS_WAIT();
        }
    }
    float s = 0.f;
#pragma unroll
    for (int r = 0; r < 16; ++r) { p0[r] = ex2(p0[r]); p1[r] = ex2(p1[r]); s += p0[r] + p1[r]; }
    l_run += s;
#pragma unroll
    for (int ks = 0; ks < 4; ++ks) {
        u32x4 pw;
        if (ks == 0) pw = (u32x4){pk2(p0[0], p0[1]), pk2(p0[2], p0[3]), pk2(p0[4], p0[5]), pk2(p0[6], p0[7])};
        else if (ks == 1) pw = (u32x4){pk2(p0[8], p0[9]), pk2(p0[10], p0[11]), pk2(p0[12], p0[13]), pk2(p0[14], p0[15])};
        else if (ks == 2) pw = (u32x4){pk2(p1[0], p1[1]), pk2(p1[2], p1[3]), pk2(p1[4], p1[5]), pk2(p1[6], p1[7])};
        else pw = (u32x4){pk2(p1[8], p1[9]), pk2(p1[10], p1[11]), pk2(p1[12], p1[13]), pk2(p1[14], p1[15])};
        const bf16x8 pa = __builtin_bit_cast(bf16x8, pw);
#pragma unroll
        for (int db = 0; db < 2; ++db) {
            const bf16x8 vb = *(const LAS bf16x8*)(Vts + (32 * db + r32) * (VP * 2) + (16 * ks + 8 * hi) * 2);
            o[db] = MFMA32(pa, vb, o[db]);
        }
    }
}
__device__ __forceinline__ void attn_finish(f32x16 (&o)[2], float l_run, bf16_t* y, size_t row0, int ldy, int col0, LAS float* sc, int r32, int hi) {
    float lt = l_run;
    { auto rr = __builtin_amdgcn_permlane32_swap(__float_as_uint(lt), __float_as_uint(lt), false, false); lt = __uint_as_float(rr[0]) + __uint_as_float(rr[1]); }
    if (hi == 0) sc[r32] = 1.0f / lt;
    LDS_WAIT();
#pragma unroll
    for (int g4 = 0; g4 < 4; ++g4) { const f32x4 a = *(const LAS f32x4*)(sc + 8 * g4 + 4 * hi);
#pragma unroll
        for (int e = 0; e < 4; ++e) { const int r = 4 * g4 + e; GAS bf16_t* yp = (GAS bf16_t*)(y + (row0 + crow(r, hi)) * ldy + col0 + r32);
            yp[0] = f2bf(o[0][r] * a[e]); yp[32] = f2bf(o[1][r] * a[e]); } }
    LDS_WAIT();
}

#define SBAR() __builtin_amdgcn_sched_barrier(0)
template <int KP>
__device__ __forceinline__ void qk_pair6(const LAS unsigned char* Ka, const LAS unsigned char* Kb, const bf16x8 (&qf)[6], const f32x16& negm, f32x16& a0, f32x16& a1, f32x16& b0, f32x16& b1, int r32, int hi) {
    const LAS unsigned char* pa = Ka + r32 * (KP * 2) + 16 * hi; const LAS unsigned char* pb = Kb + r32 * (KP * 2) + 16 * hi;
    bf16x8 g0[6], g1[6];
#define LDG(dst, base, d0s) do { _Pragma("unroll") for (int j = 0; j < 3; ++j) { dst[2 * j] = *(const LAS bf16x8*)((base) + 32 * ((d0s) + j)); dst[2 * j + 1] = *(const LAS bf16x8*)((base) + 32 * (KP * 2) + 32 * ((d0s) + j)); } } while (0)
    LDG(g0, pa, 0); LDG(g1, pa, 3);
    SBAR(); __builtin_amdgcn_s_setprio(1);
    a0 = MFMA32(g0[0], qf[0], negm); a1 = MFMA32(g0[1], qf[0], negm); a0 = MFMA32(g0[2], qf[1], a0); a1 = MFMA32(g0[3], qf[1], a1); a0 = MFMA32(g0[4], qf[2], a0); a1 = MFMA32(g0[5], qf[2], a1);
    SBAR();
    LDG(g0, pb, 0);
    SBAR();
    a0 = MFMA32(g1[0], qf[3], a0); a1 = MFMA32(g1[1], qf[3], a1); a0 = MFMA32(g1[2], qf[4], a0); a1 = MFMA32(g1[3], qf[4], a1); a0 = MFMA32(g1[4], qf[5], a0); a1 = MFMA32(g1[5], qf[5], a1);
    SBAR();
    LDG(g1, pb, 3);
    SBAR();
    b0 = MFMA32(g0[0], qf[0], negm); b1 = MFMA32(g0[1], qf[0], negm); b0 = MFMA32(g0[2], qf[1], b0); b1 = MFMA32(g0[3], qf[1], b1); b0 = MFMA32(g0[4], qf[2], b0); b1 = MFMA32(g0[5], qf[2], b1);
    SBAR();
    b0 = MFMA32(g1[0], qf[3], b0); b1 = MFMA32(g1[1], qf[3], b1); b0 = MFMA32(g1[2], qf[4], b0); b1 = MFMA32(g1[3], qf[4], b1); b0 = MFMA32(g1[4], qf[5], b0); b1 = MFMA32(g1[5], qf[5], b1);
    __builtin_amdgcn_s_setprio(0); SBAR();
#undef LDG
}
__device__ __forceinline__ void softmax_pv2(f32x16& a0, f32x16& a1, f32x16& b0, f32x16& b1, f32x16 (&o)[2], float& m_run, float& l_run, f32x16& negm, bool first,
                                            const LAS unsigned char* Va, const LAS unsigned char* Vb, LAS float* sc, int r32, int hi) {
    float x = max3f(a0[0], a0[1], a1[0]), y = max3f(a0[2], a0[3], a1[1]); x = max3f(x, a1[2], a1[3]);
    float u = max3f(b0[0], b0[1], b1[0]), v = max3f(b0[2], b0[3], b1[1]); u = max3f(u, b1[2], b1[3]);
#pragma unroll
    for (int r = 4; r < 16; r += 4) { x = max3f(x, a0[r], a0[r + 1]); y = max3f(y, a0[r + 2], a0[r + 3]); x = max3f(x, a1[r], a1[r + 1]); y = max3f(y, a1[r + 2], a1[r + 3]);
        u = max3f(u, b0[r], b0[r + 1]); v = max3f(v, b0[r + 2], b0[r + 3]); u = max3f(u, b1[r], b1[r + 1]); v = max3f(v, b1[r + 2], b1[r + 3]); }
    float mx = __builtin_fmaxf(__builtin_fmaxf(x, y), __builtin_fmaxf(u, v));
    { auto rr = __builtin_amdgcn_permlane32_swap(__float_as_uint(mx), __float_as_uint(mx), false, false); mx = __builtin_fmaxf(__uint_as_float(rr[0]), __uint_as_float(rr[1])); }
    if (first || __any(mx > 8.0f)) {
        const float dl = first ? mx : __builtin_fmaxf(mx, 0.f);
        m_run += dl;
#pragma unroll
        for (int r = 0; r < 16; ++r) { a0[r] -= dl; a1[r] -= dl; b0[r] -= dl; b1[r] -= dl; negm[r] = -m_run; }
        if (!first) {
            const float al = ex2(-dl); l_run *= al;
            if (hi == 0) sc[r32] = al;
            LDS_WAIT();
#pragma unroll
            for (int g4 = 0; g4 < 4; ++g4) { const f32x4 av = *(const LAS f32x4*)(sc + 8 * g4 + 4 * hi);
#pragma unroll
                for (int e = 0; e < 4; ++e) { o[0][4 * g4 + e] *= av[e]; o[1][4 * g4 + e] *= av[e]; } }
            LDS_WAIT();
        }
    }
    float s = 0.f, t = 0.f;
#pragma unroll
    for (int r = 0; r < 16; ++r) { a0[r] = ex2(a0[r]); a1[r] = ex2(a1[r]); s += a0[r] + a1[r]; }
#pragma unroll
    for (int r = 0; r < 16; ++r) { b0[r] = ex2(b0[r]); b1[r] = ex2(b1[r]); t += b0[r] + b1[r]; }
    l_run += s + t;
#pragma unroll
    for (int half = 0; half < 2; ++half) {
        const f32x16& p0 = half ? b0 : a0; const f32x16& p1 = half ? b1 : a1; const LAS unsigned char* Vts = half ? Vb : Va;
#pragma unroll
        for (int ks = 0; ks < 4; ++ks) {
            u32x4 pw;
            if (ks == 0) pw = (u32x4){pk2(p0[0], p0[1]), pk2(p0[2], p0[3]), pk2(p0[4], p0[5]), pk2(p0[6], p0[7])};
            else if (ks == 1) pw = (u32x4){pk2(p0[8], p0[9]), pk2(p0[10], p0[11]), pk2(p0[12], p0[13]), pk2(p0[14], p0[15])};
            else if (ks == 2) pw = (u32x4){pk2(p1[0], p1[1]), pk2(p1[2], p1[3]), pk2(p1[4], p1[5]), pk2(p1[6], p1[7])};
            else pw = (u32x4){pk2(p1[8], p1[9]), pk2(p1[10], p1[11]), pk2(p1[12], p1[13]), pk2(p1[14], p1[15])};
            const bf16x8 pa = __builtin_bit_cast(bf16x8, pw);
#pragma unroll
            for (int db = 0; db < 2; ++db) {
                const bf16x8 vb = *(const LAS bf16x8*)(Vts + (32 * db + r32) * (VP * 2) + (16 * ks + 8 * hi) * 2);
                o[db] = MFMA32(pa, vb, o[db]);
            }
        }
    }
}

__device__ __forceinline__ void mla_unit(const bf16_t* Q, const bf16_t* KN, const bf16_t* KR, const bf16_t* VT, const float* CS, bf16_t* Y, int bl, int h, int qb, LAS unsigned char* lds, int wv_) {
    OPAQUE_TID(tid);
    constexpr int KP = 104, KBUF = 64 * KP * 2, VBUF = 64 * VP * 2, OFF_V = 4 * KBUF, OFF_SC = OFF_V + 4 * VBUF;
    const int lane = tid & 63, w = __builtin_amdgcn_readfirstlane(tid >> 6), r32 = lane & 31, hi = lane >> 5;
    const size_t rb = (size_t)bl * SEQ;
    LAS float* sc = (LAS float*)(lds + OFF_SC) + w * 32;
    const float QS = 0.10206207261596577f * LOG2E;
    bf16x8 qf[6];
    { const size_t qrow = rb + (size_t)qb * 256 + 32 * w + r32;
      const bf16_t* qp = Q + qrow * 768 + h * 96;
#pragma unroll
      for (int d0 = 0; d0 < 4; ++d0) { const u32x4 raw = *(const GAS u32x4*)(qp + 16 * d0 + 8 * hi);
          u32x4 t; t.x = pk2(bflo(raw.x) * QS, bfhi(raw.x) * QS); t.y = pk2(bflo(raw.y) * QS, bfhi(raw.y) * QS); t.z = pk2(bflo(raw.z) * QS, bfhi(raw.z) * QS); t.w = pk2(bflo(raw.w) * QS, bfhi(raw.w) * QS);
          qf[d0] = __builtin_bit_cast(bf16x8, t); }
      const u32x4 r1 = *(const GAS u32x4*)(qp + 64 + 8 * hi), r2 = *(const GAS u32x4*)(qp + 80 + 8 * hi);
      const f32x4 c0 = *(const GAS f32x4*)(CS + qrow * 32 + 8 * hi), c1 = *(const GAS f32x4*)(CS + qrow * 32 + 8 * hi + 4);
      const f32x4 s0 = *(const GAS f32x4*)(CS + qrow * 32 + 16 + 8 * hi), s1 = *(const GAS f32x4*)(CS + qrow * 32 + 16 + 8 * hi + 4);
      const float x1[8] = {bflo(r1.x), bfhi(r1.x), bflo(r1.y), bfhi(r1.y), bflo(r1.z), bfhi(r1.z), bflo(r1.w), bfhi(r1.w)};
      const float x2[8] = {bflo(r2.x), bfhi(r2.x), bflo(r2.y), bfhi(r2.y), bflo(r2.z), bfhi(r2.z), bflo(r2.w), bfhi(r2.w)};
      const float cc[8] = {c0.x, c0.y, c0.z, c0.w, c1.x, c1.y, c1.z, c1.w}, ss[8] = {s0.x, s0.y, s0.z, s0.w, s1.x, s1.y, s1.z, s1.w};
      float o1[8], o2[8];
#pragma unroll
      for (int i = 0; i < 8; ++i) { o1[i] = (x1[i] * cc[i] - x2[i] * ss[i]) * QS; o2[i] = (x2[i] * cc[i] + x1[i] * ss[i]) * QS; }
      u32x4 t1 = (u32x4){pk2(o1[0], o1[1]), pk2(o1[2], o1[3]), pk2(o1[4], o1[5]), pk2(o1[6], o1[7])}, t2 = (u32x4){pk2(o2[0], o2[1]), pk2(o2[2], o2[3]), pk2(o2[4], o2[5]), pk2(o2[6], o2[7])};
      qf[4] = __builtin_bit_cast(bf16x8, t1); qf[5] = __builtin_bit_cast(bf16x8, t2); }
    const int T = 4 * qb + 4;
    const int tlast = 4 * qb + (w >> 1);
    const int krow = tid >> 3, kch = tid & 7;
    const int rrow = (tid & 255) >> 2, rch = tid & 3;
    const bf16_t* knp = KN + (rb + krow) * 512 + h * 64 + 8 * kch;
    const bf16_t* krp = KR + (rb + rrow) * 4096 + 8 * rch;
    const bf16_t* vtp = VT + (size_t)(h * 64 + krow) * MH + rb + 8 * kch;
    const int vpos = 16 * (kch >> 1) + ((kch & 1) ? 4 : 0);
    u32x4 gk0, gr0 = (u32x4){0u, 0u, 0u, 0u}, gv0, gk1, gr1 = (u32x4){0u, 0u, 0u, 0u}, gv1;
#define MLA_LOAD1(S, t) do { gk##S = *(const GAS u32x4*)(knp + (size_t)(t) * 64 * 512); if (tid < 256) gr##S = *(const GAS u32x4*)(krp + (size_t)(t) * 64 * 4096); gv##S = *(const GAS u32x4*)(vtp + (size_t)(t) * 64); } while (0)
#define MLA_STORE1(S, slot) do { *(LAS u32x4*)(lds + (slot) * KBUF + krow * (KP * 2) + kch * 16) = gk##S; if (tid < 256) *(LAS u32x4*)(lds + (slot) * KBUF + rrow * (KP * 2) + 128 + rch * 16) = gr##S; \
        LAS unsigned char* vd_ = lds + OFF_V + (slot) * VBUF + krow * (VP * 2) + vpos * 2; *(LAS u32x2*)vd_ = (u32x2){gv##S.x, gv##S.y}; *(LAS u32x2*)(vd_ + 16) = (u32x2){gv##S.z, gv##S.w}; } while (0)
    f32x16 o[2], negm, a0, a1, b0, b1;
#pragma unroll
    for (int r = 0; r < 16; ++r) { o[0][r] = 0.f; o[1][r] = 0.f; negm[r] = 0.f; }
    float m_run = 0.f, l_run = 0.f;
    bool first = true;
    MLA_LOAD1(0, 0); MLA_LOAD1(1, 1); MLA_STORE1(0, 0); MLA_STORE1(1, 1);
    __syncthreads();
#pragma unroll 1
    for (int tp = 0, st = 0; tp < T; tp += 2, st ^= 1) {
        if (tp + 2 < T) { MLA_LOAD1(0, tp + 2); MLA_LOAD1(1, tp + 3); }
        const LAS unsigned char* Ka = lds + (2 * st) * KBUF; const LAS unsigned char* Va = lds + OFF_V + (2 * st) * VBUF;
        if (tp + 1 <= tlast) {
            qk_pair6<KP>(Ka, Ka + KBUF, qf, negm, a0, a1, b0, b1, r32, hi);
            softmax_pv2(a0, a1, b0, b1, o, m_run, l_run, negm, first, Va, Va + VBUF, sc, r32, hi); first = false;
        } else if (tp <= tlast) {
            qk_tile<6, KP>(Ka, qf, negm, a0, a1, r32, hi);
            softmax_pv(a0, a1, o, m_run, l_run, negm, first, Va, sc, r32, hi); first = false;
        }
        if (tp + 2 < T) { MLA_STORE1(0, 2 * (st ^ 1)); MLA_STORE1(1, 2 * (st ^ 1) + 1); }
        __syncthreads();
    }
#undef MLA_LOAD1
#undef MLA_STORE1
    attn_finish(o, l_run, Y, rb + (size_t)qb * 256 + 32 * w, 1536, 1024 + h * 64, sc, r32, hi);
    __syncthreads();
}

__device__ __forceinline__ void bandattn_unit(const bf16_t* P, const float* relb  , bf16_t* Y, int bl, int h, int grp, LAS unsigned char* lds, int wv_) {
    OPAQUE_TID(tid);
    constexpr int KP = 72, KBUF = 64 * KP * 2, VBUF = 64 * VP * 2, OFF_V = 2 * KBUF, OFF_SC = OFF_V + 3 * VBUF, OFF_TB = OFF_SC + 8 * 128;
    const int lane = tid & 63, w = __builtin_amdgcn_readfirstlane(tid >> 6), r32 = lane & 31, hi = lane >> 5;
    const size_t rb = (size_t)bl * SEQ;
    LAS float* sc = (LAS float*)(lds + OFF_SC) + w * 32;
    LAS float* tb = (LAS float*)(lds + OFF_TB);
    if (tid < 257) tb[tid] = ((const GAS float*)relb)[tid] * LOG2E;
    const float QS = 0.125f * LOG2E;
    bf16x8 qf[4];
    { const size_t qrow = rb + (size_t)grp * 256 + 32 * w + r32;
      const bf16_t* qp = P + qrow * 4096 + h * 64;
#pragma unroll
      for (int d0 = 0; d0 < 4; ++d0) { const u32x4 raw = *(const GAS u32x4*)(qp + 16 * d0 + 8 * hi);
          u32x4 t; t.x = pk2(bflo(raw.x) * QS, bfhi(raw.x) * QS); t.y = pk2(bflo(raw.y) * QS, bfhi(raw.y) * QS); t.z = pk2(bflo(raw.z) * QS, bfhi(raw.z) * QS); t.w = pk2(bflo(raw.w) * QS, bfhi(raw.w) * QS);
          qf[d0] = __builtin_bit_cast(bf16x8, t); } }
    const int c = 4 * grp + (w >> 1);
    const int wg = w & 1;
    const int kc0 = (4 * grp - 8) > 0 ? (4 * grp - 8) : 0, kc1 = 4 * grp + 3;
    const int krow = tid >> 3, kch = tid & 7;
    const int vkv = tid & 63, vch = tid >> 6;
    const int vpos = (vkv & ~12) | ((vkv & 4) << 1) | ((vkv & 8) >> 1);
    const bf16_t* kp = P + (rb + krow) * 4096 + 512 + h * 64 + 8 * kch;
    const bf16_t* vp = P + (rb + vkv) * 4096 + 1024 + h * 64 + 8 * vch;
    u32x4 gk0, gv0, gk1, gv1;
#define BA_LOAD(S, kc) do { gk##S = *(const GAS u32x4*)(kp + (size_t)(kc) * 64 * 4096); gv##S = *(const GAS u32x4*)(vp + (size_t)(kc) * 64 * 4096); } while (0)
#define BA_STORE(S, kb, vb) do { *(LAS u32x4*)(lds + (kb) * KBUF + krow * (KP * 2) + kch * 16) = gk##S; \
        LAS bf16_t* vd = (LAS bf16_t*)(lds + OFF_V + (vb) * VBUF) + (8 * vch) * VP + vpos; \
        vd[0 * VP] = (bf16_t)(gv##S.x & 0xffffu); vd[1 * VP] = (bf16_t)(gv##S.x >> 16); vd[2 * VP] = (bf16_t)(gv##S.y & 0xffffu); vd[3 * VP] = (bf16_t)(gv##S.y >> 16); \
        vd[4 * VP] = (bf16_t)(gv##S.z & 0xffffu); vd[5 * VP] = (bf16_t)(gv##S.z >> 16); vd[6 * VP] = (bf16_t)(gv##S.w & 0xffffu); vd[7 * VP] = (bf16_t)(gv##S.w >> 16); } while (0)
    f32x16 o[2], negm, p0, p1;
#pragma unroll
    for (int r = 0; r < 16; ++r) { o[0][r] = 0.f; o[1][r] = 0.f; negm[r] = 0.f; p0[r] = 0.f; p1[r] = 0.f; }
    float m_run = 0.f, l_run = 0.f;
    bool first = true;
    BA_LOAD(0, kc0); BA_LOAD(1, kc0 + 1); BA_STORE(0, 0, 0);
    __syncthreads();
    const int qpos = 64 * c + 32 * (w & 1) + r32;
#define BA_QK(kc, kb) do { qk_tile<4, KP>(lds + (kb) * KBUF, qf, negm, p0, p1, r32, hi); \
        if (c - (kc) >= 3) { const float bb = tb[256]; _Pragma("unroll") for (int r = 0; r < 16; ++r) { p0[r] += bb; p1[r] += bb; } } \
        else { _Pragma("unroll") for (int r = 0; r < 16; ++r) { const int d0 = qpos - (64 * (kc) + crow(r, hi)); \
            const int i0 = d0 < -128 ? -128 : (d0 > 128 ? 128 : d0), i1 = (d0 - 32) < -128 ? -128 : ((d0 - 32) > 128 ? 128 : (d0 - 32)); \
            p0[r] += tb[i0 + 128]; p1[r] += tb[i1 + 128]; } } } while (0)
    int vcur = 0, vprev = 2, vnext = 1;
#define BA_STEP(kc, it, SL, SS) do { \
        if ((kc) + 2 <= kc1) BA_LOAD(SL, (kc) + 2); \
        if (wg == 1 && (it) >= 1 && (kc) - 1 >= c - 8 && (kc) - 1 <= c) { softmax_pv(p0, p1, o, m_run, l_run, negm, first, lds + OFF_V + vprev * VBUF, sc, r32, hi); first = false; } \
        if ((kc) >= c - 8 && (kc) <= c) BA_QK(kc, (it) & 1); \
        if (wg == 0 && (kc) >= c - 8 && (kc) <= c) { softmax_pv(p0, p1, o, m_run, l_run, negm, first, lds + OFF_V + vcur * VBUF, sc, r32, hi); first = false; } \
        if ((kc) + 1 <= kc1) BA_STORE(SS, ((it) + 1) & 1, vnext); \
        __syncthreads(); \
        { const int tmp = vprev; vprev = vcur; vcur = vnext; vnext = tmp; } } while (0)
#pragma unroll 1
    for (int kc = kc0, it = 0; kc <= kc1; kc += 2, it += 2) { BA_STEP(kc, it, 0, 1); BA_STEP(kc + 1, it + 1, 1, 0); }
    if (wg == 1 && kc1 <= c) softmax_pv(p0, p1, o, m_run, l_run, negm, first, lds + OFF_V + vprev * VBUF, sc, r32, hi);
#undef BA_LOAD
#undef BA_STORE
#undef BA_QK
#undef BA_STEP
    attn_finish(o, l_run, Y, rb + (size_t)grp * 256 + 32 * w, 1536, h * 64, sc, r32, hi);
    __syncthreads();
}

__device__ __forceinline__ void hgrn_x_unit(bf16_t* P, const float* lbl, float* DLg, int layer, int bl, int h, int cp, LAS unsigned char* ldsb, int wv_, const u32x4 (&rqa)[2], const u32x4 (&rfa)[2], const u32x4 (&ria)[2]) {
    OPAQUE_TID(tid);
    constexpr int RP = 144;
    constexpr int O_LF = 0, O_SEG = 16384, O_QT = 18432, O_KT = 27648, O_KH = 36864, O_VT = 46080, XCH = 55296;
    const int lane = tid & 63, w = __builtin_amdgcn_readfirstlane(tid >> 6), r32 = lane & 31, hi = lane >> 5;
    const int j = tid >> 3, c8 = tid & 7;
    const size_t rb0 = (size_t)bl * SEQ + (size_t)cp * 128;
    float kka[2][8];
#pragma unroll
    for (int ch = 0; ch < 2; ++ch) { LAS unsigned char* lds = ldsb + ch * XCH; const size_t rb = rb0 + ch * 64; const int c = 2 * cp + ch; (void)c; (void)rb;
      LAS float* LF = (LAS float*)(lds + O_LF); LAS float* SEG = (LAS float*)(lds + O_SEG); (void)SEG; (void)LF;
      bf16_t* base = P + (rb + j) * 4096 + h * 64 + 8 * c8; (void)base;
      const u32x4 rq = rqa[ch], rf = rfa[ch], ri = ria[ch]; (void)rq; (void)rf; (void)ri;
      float (&kk)[8] = kka[ch];
    { const float z[8] = {bflo(rf.x), bfhi(rf.x), bflo(rf.y), bfhi(rf.y), bflo(rf.z), bfhi(rf.z), bflo(rf.w), bfhi(rf.w)};
      float lf[8];
#pragma unroll
      for (int i = 0; i < 8; ++i) { const int d = h * 64 + 8 * c8 + i; const GAS float* lblg = (const GAS float*)lbl; const float lb = (layer == 0) ? 0.f : sigm(lblg[512 + d] - lblg[d]);
          const float sg = sigm(z[i]); const float f = lb + (1.0f - lb) * sg; lf[i] = fmaxf(__builtin_amdgcn_logf(f), -80.0f); kk[i] = (1.0f - lb) * (1.0f - sg); }
      *(LAS f32x4*)(LF + j * 64 + 8 * c8) = (f32x4){lf[0], lf[1], lf[2], lf[3]}; *(LAS f32x4*)(LF + j * 64 + 8 * c8 + 4) = (f32x4){lf[4], lf[5], lf[6], lf[7]}; }
    }
    __syncthreads();
#pragma unroll
    for (int ch = 0; ch < 2; ++ch) { LAS unsigned char* lds = ldsb + ch * XCH; const size_t rb = rb0 + ch * 64; const int c = 2 * cp + ch; (void)c; (void)rb;
      LAS float* LF = (LAS float*)(lds + O_LF); LAS float* SEG = (LAS float*)(lds + O_SEG); (void)SEG; (void)LF;
      bf16_t* base = P + (rb + j) * 4096 + h * 64 + 8 * c8; (void)base;
      const u32x4 rq = rqa[ch], rf = rfa[ch], ri = ria[ch]; (void)rq; (void)rf; (void)ri;
      float (&kk)[8] = kka[ch];
    { const int d = tid & 63, sg = tid >> 6; float v[8];
#pragma unroll
      for (int k = 0; k < 8; ++k) v[k] = LF[(8 * sg + k) * 64 + d];
#pragma unroll
      for (int k = 1; k < 8; ++k) v[k] += v[k - 1];
#pragma unroll
      for (int k = 0; k < 8; ++k) LF[(8 * sg + k) * 64 + d] = v[k];
      SEG[sg * 64 + d] = v[7]; }
    }
    __syncthreads();
#pragma unroll
    for (int ch = 0; ch < 2; ++ch) { LAS unsigned char* lds = ldsb + ch * XCH; const size_t rb = rb0 + ch * 64; const int c = 2 * cp + ch; (void)c; (void)rb;
      LAS float* LF = (LAS float*)(lds + O_LF); LAS float* SEG = (LAS float*)(lds + O_SEG); (void)SEG; (void)LF;
      bf16_t* base = P + (rb + j) * 4096 + h * 64 + 8 * c8; (void)base;
      const u32x4 rq = rqa[ch], rf = rfa[ch], ri = ria[ch]; (void)rq; (void)rf; (void)ri;
      float (&kk)[8] = kka[ch];
    { const int sg = j >> 3;
      float off[8], tot[8], mid[8];
#pragma unroll
      for (int i = 0; i < 8; ++i) { off[i] = 0.f; tot[i] = 0.f; mid[i] = 0.f; }
#pragma unroll
      for (int s2 = 0; s2 < 8; ++s2) { const f32x4 a = *(const LAS f32x4*)(SEG + s2 * 64 + 8 * c8), b = *(const LAS f32x4*)(SEG + s2 * 64 + 8 * c8 + 4);
          const float v8[8] = {a.x, a.y, a.z, a.w, b.x, b.y, b.z, b.w};
#pragma unroll
          for (int i = 0; i < 8; ++i) { if (s2 < sg) off[i] += v8[i]; tot[i] += v8[i]; if (s2 == 3) mid[i] = tot[i]; } }
      const f32x4 ca = *(const LAS f32x4*)(LF + j * 64 + 8 * c8), cb = *(const LAS f32x4*)(LF + j * 64 + 8 * c8 + 4);
      const float cl[8] = {ca.x, ca.y, ca.z, ca.w, cb.x, cb.y, cb.z, cb.w};
      const float qr[8] = {bflo(rq.x), bfhi(rq.x), bflo(rq.y), bfhi(rq.y), bflo(rq.z), bfhi(rq.z), bflo(rq.w), bfhi(rq.w)};
      float qt[8], kt[8], qh[8], kh[8];
#pragma unroll
      for (int i = 0; i < 8; ++i) { const float cum = cl[i] + off[i]; const float qs = qr[i] * sigm(qr[i]);
          qt[i] = qs * ex2(cum - mid[i]); kt[i] = kk[i] * ex2(mid[i] - cum); qh[i] = qs * ex2(cum); kh[i] = kk[i] * ex2(tot[i] - cum); }
      *(LAS u32x4*)(lds + O_QT + j * RP + c8 * 16) = (u32x4){pk2(qt[0], qt[1]), pk2(qt[2], qt[3]), pk2(qt[4], qt[5]), pk2(qt[6], qt[7])};
      *(LAS u32x4*)(lds + O_KT + j * RP + c8 * 16) = (u32x4){pk2(kt[0], kt[1]), pk2(kt[2], kt[3]), pk2(kt[4], kt[5]), pk2(kt[6], kt[7])};
      *(GAS u32x4*)(base + 1536) = (u32x4){pk2(qh[0], qh[1]), pk2(qh[2], qh[3]), pk2(qh[4], qh[5]), pk2(qh[6], qh[7])};
      LAS bf16_t* khp = (LAS bf16_t*)(lds + O_KH) + (8 * c8) * 72 + j;
      LAS bf16_t* vtp = (LAS bf16_t*)(lds + O_VT) + (8 * c8) * 72 + j;
      const unsigned vw[4] = {ri.x, ri.y, ri.z, ri.w};
#pragma unroll
      for (int i = 0; i < 8; ++i) { khp[i * 72] = f2bf(kh[i]); vtp[i * 72] = (bf16_t)((i & 1) ? (vw[i >> 1] >> 16) : (vw[i >> 1] & 0xffffu)); }
      if (j == 0) { float* dlp = DLg + ((size_t)((bl * 8 + h) * 128 + c)) * 64 + 8 * c8;
          *(GAS f32x4*)dlp = (f32x4){ex2(tot[0]), ex2(tot[1]), ex2(tot[2]), ex2(tot[3])}; *(GAS f32x4*)(dlp + 4) = (f32x4){ex2(tot[4]), ex2(tot[5]), ex2(tot[6]), ex2(tot[7])}; } }
    }
    __syncthreads();
#pragma unroll
    for (int ch = 0; ch < 2; ++ch) { LAS unsigned char* lds = ldsb + ch * XCH; const size_t rb = rb0 + ch * 64; const int c = 2 * cp + ch; (void)c; (void)rb;
      LAS float* LF = (LAS float*)(lds + O_LF); LAS float* SEG = (LAS float*)(lds + O_SEG); (void)SEG; (void)LF;
      bf16_t* base = P + (rb + j) * 4096 + h * 64 + 8 * c8; (void)base;
      const u32x4 rq = rqa[ch], rf = rfa[ch], ri = ria[ch]; (void)rq; (void)rf; (void)ri;
      float (&kk)[8] = kka[ch];
    if (w < 4) {
        const int I = w >> 1, DV = w & 1;
        f32x16 o;
#pragma unroll
        for (int r = 0; r < 16; ++r) o[r] = 0.f;
        for (int J = 0; J <= I; ++J) {
            f32x16 p;
#pragma unroll
            for (int r = 0; r < 16; ++r) p[r] = 0.f;
#pragma unroll
            for (int ks = 0; ks < 4; ++ks) { const bf16x8 a = *(const LAS bf16x8*)(lds + O_KT + (32 * J + r32) * RP + (16 * ks + 8 * hi) * 2);
                const bf16x8 b = *(const LAS bf16x8*)(lds + O_QT + (32 * I + r32) * RP + (16 * ks + 8 * hi) * 2); p = MFMA32(a, b, p); }
            if (J == I) {
#pragma unroll
                for (int r = 0; r < 16; ++r) if (crow(r, hi) > r32) p[r] = 0.f;
            }
#pragma unroll
            for (int k2 = 0; k2 < 2; ++k2) {
                u32x4 pw;
                if (k2 == 0) pw = (u32x4){pk2(p[0], p[1]), pk2(p[2], p[3]), pk2(p[4], p[5]), pk2(p[6], p[7])};
                else pw = (u32x4){pk2(p[8], p[9]), pk2(p[10], p[11]), pk2(p[12], p[13]), pk2(p[14], p[15])};
                const LAS unsigned char* vp = lds + O_VT + (32 * DV + r32) * RP + (32 * J + 16 * k2 + 4 * hi) * 2;
                const u32x2 lo = *(const LAS u32x2*)vp, h2 = *(const LAS u32x2*)(vp + 16);
                const u32x4 vw4 = (u32x4){lo.x, lo.y, h2.x, h2.y};
                o = MFMA32(__builtin_bit_cast(bf16x8, pw), __builtin_bit_cast(bf16x8, vw4), o);
            }
        }
        GAS bf16_t* op = (GAS bf16_t*)(P + (rb + 32 * I) * 4096 + 2048 + h * 64 + 32 * DV + r32);
#pragma unroll
        for (int r = 0; r < 16; ++r) op[(size_t)crow(r, hi) * 4096] = f2bf(o[r]);
    } else {
        const int ww = w - 4, Dt = ww >> 1, DV = ww & 1;
        f32x16 zt;
#pragma unroll
        for (int r = 0; r < 16; ++r) zt[r] = 0.f;
#pragma unroll
        for (int ks = 0; ks < 4; ++ks) { const bf16x8 a = *(const LAS bf16x8*)(lds + O_VT + (32 * DV + r32) * RP + (16 * ks + 8 * hi) * 2);
            const bf16x8 b = *(const LAS bf16x8*)(lds + O_KH + (32 * Dt + r32) * RP + (16 * ks + 8 * hi) * 2); zt = MFMA32(a, b, zt); }
        GAS bf16_t* zp = (GAS bf16_t*)(P + (rb + 32 * DV) * 4096 + 2560 + h * 64 + 32 * Dt + r32);
#pragma unroll
        for (int r = 0; r < 16; ++r) zp[(size_t)crow(r, hi) * 4096] = f2bf(zt[r]);
    }
    }
    __syncthreads();
}
__device__ __forceinline__ void hgrn_scan(bf16_t* P, const float* DLg, int slice, int wv_) {
    OPAQUE_TID(tid);
    const int chain = slice >> 3, bl = chain >> 3, h = chain & 7, dv = 8 * (slice & 7) + (tid >> 6), d = tid & 63;
    GAS bf16_t* p = (GAS bf16_t*)(P + ((size_t)bl * SEQ + dv) * 4096 + 2560 + h * 64 + d);
    const GAS float* dl = (const GAS float*)(DLg + (size_t)chain * 128 * 64 + d);
    float s = 0.f;
#pragma unroll 1
    for (int c0 = 0; c0 < 128; c0 += 16) {
        bf16_t z[16]; float e[16];
#pragma unroll
        for (int k = 0; k < 16; ++k) { z[k] = p[(size_t)(c0 + k) * 64 * 4096]; e[k] = dl[(c0 + k) * 64]; }
#pragma unroll
        for (int k = 0; k < 16; ++k) { s = e[k] * s + __uint_as_float((unsigned)z[k] << 16); p[(size_t)(c0 + k) * 64 * 4096] = f2bf(s); }
    }
}
__device__ __forceinline__ void hgrn_z_unit(const bf16_t* P, const float* ng, bf16_t* Y, int bl, int h, int cp, LAS unsigned char* lds, int wv_) {
    OPAQUE_TID(tid);
    const int lane = tid & 63, w = __builtin_amdgcn_readfirstlane(tid >> 6), r32 = lane & 31, hi = lane >> 5;
    const size_t rb = (size_t)bl * SEQ;
    LAS float* OB = (LAS float*)lds;
    { const int cw = 2 * cp + (w >> 2), I = (w >> 1) & 1, DV = w & 1;
      f32x16 o;
#pragma unroll
      for (int r = 0; r < 16; ++r) o[r] = 0.f;
      if (cw > 0) {
          const bf16_t* ap = P + (rb + (size_t)cw * 64 + 32 * I + r32) * 4096 + 1536 + h * 64 + 8 * hi;
          const bf16_t* bp = P + (rb + (size_t)(cw - 1) * 64 + 32 * DV + r32) * 4096 + 2560 + h * 64 + 8 * hi;
#pragma unroll
          for (int ks = 0; ks < 4; ++ks) { const bf16x8 a = *(const GAS bf16x8*)(ap + 16 * ks), b = *(const GAS bf16x8*)(bp + 16 * ks); o = MFMA32(a, b, o); }
      }
#pragma unroll
      for (int r = 0; r < 16; ++r) OB[((w >> 2) * 64 + 32 * I + crow(r, hi)) * 68 + 32 * DV + r32] = o[r]; }
    __syncthreads();
    const int c8 = tid & 7;
    float ngv[8];
#pragma unroll
    for (int i = 0; i < 8; ++i) ngv[i] = ((const GAS float*)ng)[8 * c8 + i];
#pragma unroll
    for (int it = 0; it < 2; ++it) {
        const int row = it * 64 + (tid >> 3);
        const bf16_t* pr = P + (rb + (size_t)cp * 128 + row) * 4096 + h * 64 + 8 * c8;
        const u32x4 oi = *(const GAS u32x4*)(pr + 2048), rg = *(const GAS u32x4*)(pr + 3072);
        const f32x4 a = *(const LAS f32x4*)(OB + row * 68 + 8 * c8), b = *(const LAS f32x4*)(OB + row * 68 + 8 * c8 + 4);
        const float ov[8] = {a.x + bflo(oi.x), a.y + bfhi(oi.x), a.z + bflo(oi.y), a.w + bfhi(oi.y), b.x + bflo(oi.z), b.y + bfhi(oi.z), b.z + bflo(oi.w), b.w + bfhi(oi.w)};
        float ss = 0.f;
#pragma unroll
        for (int i = 0; i < 8; ++i) ss += ov[i] * ov[i];
        ss += shx(ss, 1, lane); ss += shx(ss, 2, lane); ss += shx(ss, 4, lane);
        const float r = 1.0f / sqrtf(ss * (1.0f / 64.0f) + EPS);
        const float gr[8] = {bflo(rg.x), bfhi(rg.x), bflo(rg.y), bfhi(rg.y), bflo(rg.z), bfhi(rg.z), bflo(rg.w), bfhi(rg.w)};
        float ou[8];
#pragma unroll
        for (int i = 0; i < 8; ++i) ou[i] = ov[i] * r * ngv[i] * (gr[i] * sigm(gr[i]));
        *(GAS u32x4*)(Y + (rb + (size_t)cp * 128 + row) * 1536 + 512 + h * 64 + 8 * c8) = (u32x4){pk2(ou[0], ou[1]), pk2(ou[2], ou[3]), pk2(ou[4], ou[5]), pk2(ou[6], ou[7])};
    }
    __syncthreads();
}

__device__ __forceinline__ void tr_item(const float* W, int ldw, int k0, int nsrc0, bf16_t* WT, int ldt, int nrow0, LAS float* scr, int lane, bool zero, const float* gk = nullptr) {
    if (!zero) {
        float wvv[32];
#pragma unroll
        for (int i = 0; i < 32; ++i) { const int kk = 2 * i + (lane >> 5); wvv[i] = ((const GAS float*)W)[(size_t)(k0 + kk) * ldw + nsrc0 + (lane & 31)]; }
        if (gk) {
#pragma unroll
            for (int i = 0; i < 32; ++i) wvv[i] *= ((const GAS float*)gk)[k0 + 2 * i + (lane >> 5)];
        }
#pragma unroll
        for (int i = 0; i < 32; ++i) scr[(2 * i + (lane >> 5)) * 33 + (lane & 31)] = wvv[i];
    }
    LDS_WAIT();
    const int c = lane & 7;
#pragma unroll
    for (int jj = 0; jj < 4; ++jj) { const int n = (lane >> 3) + 8 * jj; const LAS float* s = scr + (8 * c) * 33 + n;
        u32x4 o = (u32x4){0u, 0u, 0u, 0u};
        if (!zero) { o.x = pk2(s[0 * 33], s[1 * 33]); o.y = pk2(s[2 * 33], s[3 * 33]); o.z = pk2(s[4 * 33], s[5 * 33]); o.w = pk2(s[6 * 33], s[7 * 33]); }
        *(GAS u32x4*)(WT + (size_t)(nrow0 + n) * ldt + k0 + 8 * c) = o; }
    LDS_WAIT();
}

#define XB_TMO      128
#define XB_XCNT(j)  (256  + 64 * (j))
#define XB_XSUB(j)  (1280 + 64 * (j))
#define XB_XGEN(j)  (2304 + 64 * (j))
#define XB_TOP      3328
#define XB_TOPGEN   3392
#define XCD_BAR_WORDS 3456
#define XB_SPIN_CAP (1u << 18)
__device__ __forceinline__ unsigned xb_ld(unsigned* p)              { return __hip_atomic_load(p, __ATOMIC_RELAXED, __HIP_MEMORY_SCOPE_AGENT); }
__device__ __forceinline__ unsigned xb_add(unsigned* p, unsigned v) { return __hip_atomic_fetch_add(p, v, __ATOMIC_RELAXED, __HIP_MEMORY_SCOPE_AGENT); }
__device__ __forceinline__ unsigned xb_xcc_id() { return (unsigned)__builtin_amdgcn_s_getreg((3 << 11) | 20) & 0xFu; }
#define XB_SPIN(cond, bar) do { unsigned _sp = 0; while (cond) { __builtin_amdgcn_s_sleep(1); \
    if ((++_sp & 255u) == 0u) { if (xb_ld(&(bar)[XB_TMO])) break; if (_sp > XB_SPIN_CAP) { atomicAdd(&(bar)[XB_TMO], 1u); break; } } } } while (0)
struct XcdBarrier { unsigned* bar; unsigned x; volatile LAS unsigned* st; };
__device__ __forceinline__ void xcd_barrier_complete(unsigned* bar, unsigned x, unsigned& nloc, unsigned& nx) {
    const unsigned G = gridDim.x * gridDim.y * gridDim.z;
    unsigned sum, cnt, mine, sp = 0u;
    for (;;) {
        sum = 0u; cnt = 0u; mine = 0u;
#pragma unroll
        for (unsigned j = 0; j < 16; ++j) { const unsigned c = xb_ld(&bar[XB_XCNT(j)]); sum += c; cnt += (c > 0u) ? 1u : 0u; mine = (j == x) ? c : mine; }
        if (sum == G) break;
        __builtin_amdgcn_s_sleep(1);
        if ((++sp & 255u) == 0u) { if (xb_ld(&bar[XB_TMO])) break; if (sp > XB_SPIN_CAP) { atomicAdd(&bar[XB_TMO], 1u); break; } }
    }
    nloc = mine > 0u ? mine : 1u; nx = cnt > 0u ? cnt : 1u;
}
__device__ __forceinline__ void xcd_barrier(const XcdBarrier& b, int wv_) {
    asm volatile("s_waitcnt vmcnt(0)" ::: "memory");
    __syncthreads();
    OPAQUE_TID(xtid);
    if (xtid == 0) {
        unsigned* bar = b.bar;
        __builtin_amdgcn_s_waitcnt(0);
        unsigned nloc = b.st[0], nx = b.st[1];
        if (nloc == 0u) { xcd_barrier_complete(bar, b.x, nloc, nx); b.st[0] = nloc; b.st[1] = nx; }
        const unsigned old = xb_add(&bar[XB_XSUB(b.x)], 1u);
        const unsigned gen = old / nloc;
        if (old + 1u == (gen + 1u) * nloc) {
            __builtin_amdgcn_fence(__ATOMIC_RELEASE, "agent");
            asm volatile("s_waitcnt vmcnt(0)" ::: "memory");
            const unsigned og = xb_add(&bar[XB_TOP], 1u);
            const unsigned tg = og / nx;
            if (og + 1u == (tg + 1u) * nx) xb_add(&bar[XB_TOPGEN], 1u);
            else XB_SPIN(xb_ld(&bar[XB_TOPGEN]) == tg, bar);
            __builtin_amdgcn_fence(__ATOMIC_ACQUIRE, "agent");
            xb_add(&bar[XB_XGEN(b.x)], 1u);
            asm volatile("s_waitcnt vmcnt(0)" ::: "memory");
        } else {
            XB_SPIN(xb_ld(&bar[XB_XGEN(b.x)]) == gen, bar);
            __builtin_amdgcn_fence(__ATOMIC_ACQUIRE, "agent");
            asm volatile("s_waitcnt vmcnt(0)" ::: "memory");
        }
    }
    __syncthreads();
}

#ifndef PROBE_TS
#define PROBE_TS 0
#endif
#if PROBE_TS
#define STAMP(ty) do { OPAQUE_TID(ts_tid_); if (blockIdx.x == 0 && ts_tid_ == 0) { LAS unsigned long long* tsl = (LAS unsigned long long*)(lds + 131088); const unsigned long long now_ = __builtin_amdgcn_s_memrealtime(); \
        if ((PROBE_TS >> (ty)) & 1) tsl[1] += now_ - tsl[0]; tsl[0] = now_; } } while (0)
#else
#define STAMP(ty) do {} while (0)
#endif
struct Args { const float* in[17]; float* out; unsigned char* ws; };

__global__ void __launch_bounds__(512, 2) fwd_kernel(Args a) {
    extern __shared__ __attribute__((aligned(16))) unsigned char lds_raw[];
    cg::grid_group grid = cg::this_grid();
    LAS unsigned char* lds = (LAS unsigned char*)lds_raw;
    const int G = gridDim.x, NGW = G * 8;
    const int wv_ = __builtin_amdgcn_readfirstlane((int)threadIdx.x >> 6);
#if PROBE_TS
    { OPAQUE_TID(t0_); if (blockIdx.x == 0 && t0_ == 0) { LAS unsigned long long* tsl = (LAS unsigned long long*)(lds + 131088); tsl[0] = __builtin_amdgcn_s_memrealtime(); tsl[1] = 0ull; } }
#endif
    typedef const __attribute__((address_space(4))) Args* KArgs;
#define KARGS(name) KArgs name = (KArgs)__builtin_amdgcn_kernarg_segment_ptr(); asm volatile("" : "+s"(name))
    XcdBarrier xb;
    { KARGS(kb); OPAQUE_TID(t0b); volatile LAS unsigned* st = (volatile LAS unsigned*)(lds + 131136);
      if (t0b == 0) { st[0] = 0u; st[1] = 0u; }
      __syncthreads();
      xb.bar = (unsigned*)(GAS unsigned*)(as_global(kb->ws) + WS_CTL) + 8192; xb.x = xb_xcc_id(); xb.st = st;
      if (blockIdx.x == 0) { GAS unsigned* cw = (GAS unsigned*)(as_global(kb->ws) + WS_CTL); for (int i = t0b; i < 16384; i += 512) cw[i] = 0u; } }
#define GSYNC() xcd_barrier(xb, wv_)
    {
        KARGS(ka);
        unsigned char* ws = as_global(ka->ws);
        OPAQUE_TID(tid); const int lane = tid & 63, wave = __builtin_amdgcn_readfirstlane(tid >> 6), gw = blockIdx.x * 8 + wave;
        LAS float* scr = (LAS float*)(lds + wave * 16384);
        constexpr int I_IN = 16 * 224, I_BR = 768, I_OUT = 512, I_F1 = 2048, I_F2 = 2048, I_L = I_IN + I_BR + I_OUT + I_F1 + I_F2;
        for (int it = gw; it < 2 * I_L; it += NGW) {
            const int l = it / I_L; int r = it % I_L;
            unsigned char* wl = ws + WS_W + (size_t)l * W_LAYER_REAL;
            if (r < I_IN) { const int kb = r / 224, nb = r % 224, n0 = 32 * nb; const bool zero = (n0 >= 4000 && n0 < 4096); const int ns = n0 < 4000 ? n0 : n0 - 96;
                tr_item(as_global(ka->in[3]) + (size_t)l * 1024 * 7072, 7072, 64 * kb, zero ? 0 : ns, (bf16_t*)(wl + WO_IN), 1024, n0, scr, lane, zero, as_global(ka->in[2]) + l * 1024); continue; }
            r -= I_IN;
            if (r < I_BR) { const int z = r / 256, rr = r % 256, kb = rr / 32, nb = rr % 32;
                tr_item(as_global(ka->in[11]) + ((size_t)l * 3 + z) * 512 * 1024, 1024, 64 * kb, 32 * nb, (bf16_t*)(wl + WO_BR) + (size_t)z * 1024 * 512, 512, 32 * nb, scr, lane, false); continue; }
            r -= I_BR;
            if (r < I_OUT) { const int kb = r / 32, nb = r % 32; tr_item(as_global(ka->in[12]) + (size_t)l * 1024 * 1024, 1024, 64 * kb, 32 * nb, (bf16_t*)(wl + WO_OUT), 1024, 32 * nb, scr, lane, false); continue; }
            r -= I_OUT;
            if (r < I_F1) { const int kb = r / 128, nb = r % 128; tr_item(as_global(ka->in[14]) + (size_t)l * 1024 * 4096, 4096, 64 * kb, 32 * nb, (bf16_t*)(wl + WO_F1), 1024, 32 * nb, scr, lane, false, as_global(ka->in[13]) + l * 1024); continue; }
            r -= I_F1;
            { const int kb = r / 32, nb = r % 32; tr_item(as_global(ka->in[15]) + (size_t)l * 4096 * 1024, 1024, 64 * kb, 32 * nb, (bf16_t*)(wl + WO_F2), 4096, 32 * nb, scr, lane, false); }
        }
        rows_bf16_ssq(as_global(ka->in[0]), (bf16_t*)(ws + WS_XN), (float*)(ws + WS_SS), MTOT, NGW, wv_);
        for (int i = blockIdx.x * 512 + tid; i < 4 * MTOT; i += G * 512) ((GAS float*)(ws + WS_SS))[MTOT + i] = 0.f;
        const int gt = blockIdx.x * 512 + tid, GT_ = G * 512;
        for (int idx = gt; idx < 2 * 86016; idx += GT_) {
            const int l = idx / 86016; int r = idx % 86016;
            unsigned char* wl = ws + WS_W + (size_t)l * W_LAYER_REAL;
            const GAS float* wuq = (const GAS float*)(ka->in[9] + (size_t)l * 256 * 768); const GAS float* wukv = (const GAS float*)(ka->in[10] + (size_t)l * 128 * 1024);
            float v[8]; bf16_t* dst;
            if (r < 61440) { const int n = r % 1280, kc = r / 1280; dst = (bf16_t*)(wl + WO_QK) + (size_t)n * 384 + 8 * kc;
#pragma unroll
                for (int i = 0; i < 8; ++i) { const int k = 8 * kc + i;
                    v[i] = (n < 768) ? (k < 256 ? wuq[(size_t)k * 768 + n] : 0.f) : (k >= 256 ? wukv[(size_t)(k - 256) * 1024 + ((n - 768) >> 6) * 128 + ((n - 768) & 63)] : 0.f); }
            } else { r -= 61440; const int n = r % 512, kc = r / 512; dst = (bf16_t*)(wl + WO_V) + (size_t)n * 384 + 8 * kc;
#pragma unroll
                for (int i = 0; i < 8; ++i) { const int k = 8 * kc + i; v[i] = (k >= 256) ? wukv[(size_t)(k - 256) * 1024 + (n >> 6) * 128 + 64 + (n & 63)] : 0.f; }
            }
            *(GAS u32x4*)dst = (u32x4){pk2(v[0], v[1]), pk2(v[2], v[3]), pk2(v[4], v[5]), pk2(v[6], v[7])};
        }
    }
    grid.sync(); STAMP(10);
    { OPAQUE_TID(t0c); if (t0c == 0) (void)xb_add(&xb.bar[XB_XCNT(xb.x)], 1u); }

#pragma unroll 1
    for (int l = 0; l < 2; ++l) {
#define WPTR(base, off) ((const bf16_t*)((base) + WS_W + (size_t)l * W_LAYER_REAL + (off)))
#pragma unroll 1
        for (int hf = 0; hf < 2; ++hf) {
            const size_t R0 = (size_t)hf * MH;
            KARGS(ka);
            unsigned char* wsq_ = ka->ws; asm volatile("" : "+s"(wsq_)); unsigned char* wsq = as_global(wsq_);
#define ctl ((unsigned*)(wsq + WS_CTL))
#define XN ((bf16_t*)(wsq + WS_XN))
#define SSQ(i) ((float*)(wsq + WS_SS) + (size_t)(i) * MTOT)
#define CS ((float*)(wsq + WS_CS))
#define P ((bf16_t*)(wsq + WS_P))
#define GT ((bf16_t*)(wsq + WS_G))
#define Q ((bf16_t*)(wsq + WS_Q))
#define KN ((bf16_t*)(wsq + WS_KN))
#define VT ((bf16_t*)(wsq + WS_VT))
#define Y ((bf16_t*)(wsq + WS_Y))
#define MG ((bf16_t*)(wsq + WS_MG))
            { pg8::Gemm g{XN + R0 * DM, WPTR(wsq, WO_IN), MH, NIN, DM, DM, DM, 0, 0}; pg8::StaticOrder S; S.init(MH, NIN, G, (int)blockIdx.x);
              pg8::EpiSplit<0, 1> E{P, 4096, 16, GT, 3072, SSQ(2 * l) + R0};
              pg8::gemm_phase(lds, g, S, E, wv_); }
            GSYNC(); STAMP(1);
            mla_prep(P, (const int*)as_global(ka->in[1]) + R0, as_global(ka->in[7]) + l * 256, as_global(ka->in[8]) + l * 128, CS, NGW, wv_);
            { OPAQUE_TID(xt);
#define XLOAD(u_, q_, f_, i_) do { _Pragma("unroll") for (int ch_ = 0; ch_ < 2; ++ch_) { const bf16_t* xb_ = P + ((size_t)((u_) >> 9) * SEQ + (size_t)((u_) & 63) * 128 + ch_ * 64 + (xt >> 3)) * 4096 + (((u_) >> 6) & 7) * 64 + 8 * (xt & 7); \
                q_[ch_] = *(const GAS u32x4*)(xb_ + 1536); f_[ch_] = *(const GAS u32x4*)(xb_ + 2048); i_[ch_] = *(const GAS u32x4*)(xb_ + 2560); } } while (0)
              u32x4 nq[2], nf[2], ni[2];
#pragma unroll
              for (int ch_ = 0; ch_ < 2; ++ch_) { nq[ch_] = (u32x4){0u, 0u, 0u, 0u}; nf[ch_] = nq[ch_]; ni[ch_] = nq[ch_]; }
              if ((int)blockIdx.x < 1024) XLOAD((int)blockIdx.x, nq, nf, ni);
              for (int u = blockIdx.x; u < 1024; u += G) {
                  const u32x4 cq[2] = {nq[0], nq[1]}, cf[2] = {nf[0], nf[1]}, ci[2] = {ni[0], ni[1]};
                  if (u + G < 1024) XLOAD(u + G, nq, nf, ni);
                  hgrn_x_unit(P, as_global(ka->in[5]), (float*)(wsq + WS_DL), l, u >> 9, (u >> 6) & 7, u & 63, lds, wv_, cq, cf, ci);
              }
#undef XLOAD
            }
            GSYNC(); STAMP(2);
            { pg8::Gemm g{P + 3584, WPTR(wsq, WO_QK), MH, 1280, 384, 4096, 384, 0, 0}; pg8::StaticOrder S; S.init(MH, 1280, G, (int)blockIdx.x);
              pg8::EpiSplit<0, 0> E{Q, 768, 3, KN, 512, nullptr};
              pg8::gemm_phase(lds, g, S, E, wv_); }
            { pg8::Gemm g{WPTR(wsq, WO_V), P + 3584, 512, MH, 384, 384, 4096, 0, 0}; pg8::StaticOrder S; S.init(512, MH, G, (int)blockIdx.x);
              pg8::EpiSplit<0, 0> E{VT, MH, 1 << 30, VT, MH, nullptr};
              pg8::gemm_phase(lds, g, S, E, wv_); }
            for (int sl = G - 1 - (int)blockIdx.x; sl < 128; sl += G) hgrn_scan(P, (const float*)(wsq + WS_DL), sl, wv_);
            GSYNC(); STAMP(3);
#ifndef PROBE_RUN
#define PROBE_RUN 0
#endif
#define PH4_BODY(RUN, CTR) { \
                OPAQUE_TID(tid); \
                LAS int* slot = (LAS int*)(lds + 131072); \
                for (int qi = 0; qi < 8; ++qi) { \
                    const int q = ((int)blockIdx.x + qi) & 7;            \
                    unsigned* ctr = (CTR) + 64 * q; \
                    for (;;) { \
                        if (tid == 0) slot[0] = (int)__hip_atomic_fetch_add((GAS unsigned*)ctr, 1u, __ATOMIC_RELAXED, __HIP_MEMORY_SCOPE_AGENT); \
                        __syncthreads(); \
                        const int item = __builtin_amdgcn_readfirstlane(slot[0]); \
                        __syncthreads(); \
                        if (item >= 256) break; \
                        const int bh = 2 * q + (item & 1), kq = (item & 63) >> 1; \
                        if (item < 64) { if ((RUN) & 2) mla_unit(Q, KN, P + 3968, VT, CS, Y, bh >> 3, bh & 7, 31 - kq, lds, wv_); } \
                        else if (item < 128) { if ((RUN) & 4) bandattn_unit(P, as_global(ka->in[4]) + ((size_t)l * 8 + (bh & 7)) * 257, Y, bh >> 3, bh & 7, kq, lds, wv_); } \
                        else { if ((RUN) & 1) hgrn_z_unit(P, as_global(ka->in[6]) + l * 64, Y, bh >> 3, bh & 7, (item - 128) >> 1, lds, wv_); } \
                    } \
                } \
                GSYNC(); STAMP(4); }
            PH4_BODY(7, ctl + 1024 * (l * 2 + hf))
#if PROBE_RUN
            PH4_BODY(PROBE_RUN, ctl + 1024 * (l * 2 + hf) + 512)
#endif
            { pg8::Gemm g{Y, WPTR(wsq, WO_BR), MH, 1024, 512, 1536, 512, (size_t)512 * 2, (size_t)1024 * 512 * 2}; pg8::BranchOrder S{G, (int)blockIdx.x};
              pg8::EpiBranch E{GT, MG};
              pg8::gemm_phase(lds, g, S, E, wv_); }
            GSYNC(); STAMP(5);
            { pg8::Gemm g{MG, WPTR(wsq, WO_OUT), MH, DM, DM, DM, DM, 0, 0}; pg8::StaticOrder S; S.init(MH, DM, G, (int)blockIdx.x);
              pg8::EpiResid E{((l == 0) ? as_global(ka->in[0]) : as_global(ka->out)) + R0 * DM, as_global(ka->out) + R0 * DM, XN + R0 * DM, SSQ(2 * l + 1) + R0};
              pg8::gemm_phase(lds, g, S, E, wv_); }
            GSYNC(); STAMP(6);
        }
#undef ctl
#undef XN
#undef SSQ
#undef CS
#undef P
#undef GT
#undef Q
#undef KN
#undef VT
#undef Y
#undef MG
        KARGS(kf); { KArgs ka = kf;
        unsigned char* wsf_ = ka->ws; asm volatile("" : "+s"(wsf_)); unsigned char* wsf = as_global(wsf_);
        bf16_t* XN = (bf16_t*)(wsf + WS_XN); bf16_t* HB = (bf16_t*)(wsf + WS_H);
        { pg8::Gemm g{XN, WPTR(wsf, WO_F1), MTOT, FF, DM, DM, DM, 0, 0}; pg8::StaticOrder S; S.init(MTOT, FF, G, (int)blockIdx.x);
          pg8::EpiSplit<2, 2> E{HB, FF, 1 << 30, HB, FF, (const float*)(wsf + WS_SS) + (size_t)(2 * l + 1) * MTOT};
          pg8::gemm_phase(lds, g, S, E, wv_); }
        GSYNC(); STAMP(8);
        { pg8::Gemm g{HB, WPTR(wsf, WO_F2), MTOT, DM, FF, FF, FF, 0, 0}; pg8::StaticOrder S; S.init(MTOT, DM, G, (int)blockIdx.x);
          pg8::EpiResid E{as_global(ka->out), as_global(ka->out), XN, (float*)(wsf + WS_SS) + (size_t)(2 * l + 2) * MTOT};
          pg8::gemm_phase(lds, g, S, E, wv_); }
        GSYNC(); STAMP(9); }
    }
#ifdef PROBE_SYNCS
#pragma unroll 1
    for (int i_ = 0; i_ < PROBE_SYNCS; ++i_) GSYNC();
#endif
    KARGS(kz);
    final_norm(as_global(kz->out), as_global(kz->in[16]), (const float*)(as_global(kz->ws) + WS_SS) + (size_t)4 * MTOT, G, wv_);
#if PROBE_TS
    { OPAQUE_TID(t1_); if (blockIdx.x == 0 && t1_ == 0) { LAS unsigned long long* tsl = (LAS unsigned long long*)(lds + 131088); unsigned long long now_ = __builtin_amdgcn_s_memrealtime(); if ((PROBE_TS >> 11) & 1) tsl[1] += now_ - tsl[0];
        const unsigned long long until = now_ + tsl[1]; while (__builtin_amdgcn_s_memrealtime() < until) __builtin_amdgcn_s_sleep(8); } }
#endif
}

extern "C" void kernel_launch(void* const* d_in, const int* in_sizes, int n_in, void* d_out, int out_size, void* d_ws, size_t ws_size, hipStream_t stream) {
    static int grid = 0;
    if (grid == 0) {
        int dev = 0, cus = 0, per_cu = 0;
        (void)hipGetDevice(&dev);
        (void)hipDeviceGetAttribute(&cus, hipDeviceAttributeMultiprocessorCount, dev);
        (void)hipFuncSetAttribute((const void*)fwd_kernel, hipFuncAttributeMaxDynamicSharedMemorySize, LDS_BYTES);
        (void)hipOccupancyMaxActiveBlocksPerMultiprocessor(&per_cu, (const void*)fwd_kernel, 512, LDS_BYTES);
        if (per_cu < 1) per_cu = 1;
        grid = cus * per_cu;
        if (ws_size < (size_t)504 * MiB) fprintf(stderr, "kernel_launch: workspace too small (%zu)\n", ws_size);
    }
    Args a{};
    for (int i = 0; i < 17; ++i) a.in[i] = (const float*)d_in[i];
    a.out = (float*)d_out; a.ws = (unsigned char*)d_ws;
    void* args[] = {&a};
    hipError_t e = hipLaunchCooperativeKernel((void*)fwd_kernel, dim3(grid), dim3(512), args, LDS_BYTES, stream);
    if (e != hipSuccess) fprintf(stderr, "cooperative launch failed: %s (grid %d)\n", hipGetErrorString(e), grid);
}
```

```cpp
#include <hip/hip_runtime.h>
#include <hip/hip_cooperative_groups.h>
#include <cstdio>
#include <cstdint>
namespace cg = cooperative_groups;

#define LAS __attribute__((address_space(3)))
#define GAS __attribute__((address_space(1)))
typedef unsigned short bf16_t;
typedef short bf16x8 __attribute__((ext_vector_type(8)));
typedef float f32x4 __attribute__((ext_vector_type(4)));
typedef float f32x16 __attribute__((ext_vector_type(16)));
typedef unsigned u32x4 __attribute__((ext_vector_type(4)));
typedef unsigned u32x2 __attribute__((ext_vector_type(2)));
typedef float f32x2_t __attribute__((ext_vector_type(2)));
typedef __bf16 bf16x2_t __attribute__((ext_vector_type(2)));

__device__ __forceinline__ unsigned pk2(float lo, float hi) { f32x2_t v = {lo, hi}; bf16x2_t b = __builtin_convertvector(v, bf16x2_t); return __builtin_bit_cast(unsigned, b); }
__device__ __forceinline__ bf16_t f2bf(float f) { return (bf16_t)(pk2(f, 0.f) & 0xffffu); }
__device__ __forceinline__ float bflo(unsigned w) { return __uint_as_float(w << 16); }
__device__ __forceinline__ float bfhi(unsigned w) { return __uint_as_float(w & 0xffff0000u); }
__device__ __forceinline__ float ex2(float x) { return __builtin_amdgcn_exp2f(x); }
__device__ __forceinline__ float sigm(float x) { return __builtin_amdgcn_rcpf(1.0f + ex2(-1.4426950408889634f * x)); }
__device__ __forceinline__ int crow(int r, int hi) { return (r & 3) + 8 * (r >> 2) + 4 * hi; }
__device__ __forceinline__ float shx(float v, int mask, int lane) { return __int_as_float(__builtin_amdgcn_ds_bpermute((lane ^ mask) << 2, __float_as_int(v))); }
__device__ __forceinline__ float wave_sum(float v, int lane) {
#pragma unroll
    for (int o = 1; o < 64; o <<= 1) v += shx(v, o, lane);
    return v;
}
template <class T> __device__ __forceinline__ T* as_global(T* p) { return (T*)(__attribute__((address_space(1))) T*)p; }
#define OPAQUE_TID(t) int t; asm volatile("v_mbcnt_lo_u32_b32 %0, -1, 0\n\tv_mbcnt_hi_u32_b32 %0, -1, %0\n\tv_lshl_add_u32 %0, %1, 6, %0" : "=&v"(t) : "s"(wv_))
#define LDS_WAIT() asm volatile("s_waitcnt lgkmcnt(0)" ::: "memory")
#define MFMA32(a, b, c) __builtin_amdgcn_mfma_f32_32x32x16_bf16((a), (b), (c), 0, 0, 0)

namespace pg8 {
constexpr int BM = 256, BK = 64, HALF = 128, HTB = HALF * BK * 2, STAGE_BYTES = 8 * HTB, NXCD = 8, WGM = 8;
__host__ __device__ __forceinline__ int lds_byte(int r, int c) { const int st = (r >> 4) * 2 + (c >> 5), rr = r & 15, cc = c & 31, ob = rr * 64 + cc * 2; return st * 1024 + (ob ^ (((ob >> 9) & 1) << 5)); }
__host__ __device__ __forceinline__ void stage_rc(int b, int& R, int& C) { const int st = b / 1024, sb = b % 1024, swz = sb ^ (((sb >> 9) & 1) << 5); R = (st >> 1) * 16 + swz / 64; C = (st & 1) * 32 + (swz % 64) / 2; }
__host__ __device__ __forceinline__ int perm32(int rho) { const int n = rho >> 4, i = rho & 15; return 8 * (i >> 2) + 4 * n + (i & 3); }

struct Unit { int pm, pn, z; };
struct Gemm { const bf16_t* A; const bf16_t* Bt; int M, N, K, lda, ldb; size_t za, zb; };

struct StaticOrder {
    int nM, nN, nwg, G, c;
    __device__ void init(int M, int N, int G_, int c_) { nM = M / BM; nN = N / BM; nwg = nM * nN; G = G_; c = c_; }
    __device__ bool next(int i, Unit& u) const {
        const long L = (long)i * G + c; if (L >= nwg) return false;
        int wgid = (int)L; { const int q = nwg / NXCD, r = nwg % NXCD, xcd = wgid % NXCD, off = wgid / NXCD; wgid = (xcd < r ? xcd * (q + 1) : r * (q + 1) + (xcd - r) * q) + off; }
        const int nig = WGM * nN, gid = wgid / nig, fm = gid * WGM, gsz = (nM - fm) < WGM ? (nM - fm) : WGM;
        u.pm = fm + ((wgid % nig) % gsz); u.pn = (wgid % nig) / gsz; u.z = 0; return true;
    }
};
struct BranchOrder {
    int G, c;
    __device__ bool next(int i, Unit& u) const {
        const int p = (i / 3) * G + c; if (p >= 256) return false;
        const int xcd = p & 7, off = p >> 3; u.pm = xcd * 8 + (off >> 2); u.pn = off & 3; u.z = i % 3; return true;
    }
};

template <int ACT0, int ACT1> struct EpiSplit {
    static constexpr bool PERM = true;
    bf16_t* O0; int ld0; int nsplit; bf16_t* O1; int ld1; const float* ss;
    __device__ __forceinline__ void operator()(const f32x4 (&acc)[2][2][4][2], const Unit& u, int wr, int wc, int fr, int fq) const {
        const bool first = u.pn < nsplit;
        bf16_t* base = first ? O0 : O1; const int ldc = first ? ld0 : ld1; const int colt = (first ? u.pn : u.pn - nsplit) * BM;
        const int act = first ? ACT0 : ACT1;
        const int row0 = u.pm * BM + wr * 64 + fr, col0 = colt + wc * 32 + 8 * fq;
#pragma unroll
        for (int ai = 0; ai < 2; ++ai)
#pragma unroll
            for (int m = 0; m < 4; ++m) { bf16_t* rowp = base + (size_t)(row0 + ai * HALF + m * 16) * ldc + col0;
                float rs = 1.0f; if (ss) rs = 1.0f / sqrtf(((const GAS float*)ss)[row0 + ai * HALF + m * 16] * (1.0f / 1024.0f) + 1e-6f);
#pragma unroll
                for (int bj = 0; bj < 2; ++bj) { f32x4 v0 = acc[ai][bj][m][0] * rs, v1 = acc[ai][bj][m][1] * rs;
                    if (act == 1) {
#pragma unroll
                        for (int e = 0; e < 4; ++e) { v0[e] = sigm(v0[e]); v1[e] = sigm(v1[e]); }
                    } else if (act == 2) {
#pragma unroll
                        for (int e = 0; e < 4; ++e) { const float a = fmaxf(v0[e], 0.f), b = fmaxf(v1[e], 0.f); v0[e] = a * a; v1[e] = b * b; }
                    }
                    u32x4 w; w.x = pk2(v0[0], v0[1]); w.y = pk2(v0[2], v0[3]); w.z = pk2(v1[0], v1[1]); w.w = pk2(v1[2], v1[3]);
                    *(GAS u32x4*)(rowp + bj * HALF) = w; } }
    }
};
struct EpiBranch {
    static constexpr bool PERM = true;
    const bf16_t* Gt; bf16_t* Mg;
    __device__ __forceinline__ void operator()(const f32x4 (&acc)[2][2][4][2], const Unit& u, int wr, int wc, int fr, int fq) const {
        const int row0 = u.pm * BM + wr * 64 + fr, col0 = u.pn * BM + wc * 32 + 8 * fq;
#pragma unroll
        for (int ai = 0; ai < 2; ++ai) {
            u32x4 g[2][4], pv[2][4];
#pragma unroll
            for (int bj = 0; bj < 2; ++bj)
#pragma unroll
                for (int m = 0; m < 4; ++m) { const size_t row = (size_t)(row0 + ai * HALF + m * 16);
                    g[bj][m] = *(const GAS u32x4*)(Gt + row * 3072 + u.z * 1024 + col0 + bj * HALF);
                    pv[bj][m] = (u32x4){0u, 0u, 0u, 0u}; if (u.z > 0) pv[bj][m] = *(const GAS u32x4*)(Mg + row * 1024 + col0 + bj * HALF); }
#pragma unroll
            for (int bj = 0; bj < 2; ++bj)
#pragma unroll
                for (int m = 0; m < 4; ++m) { const size_t row = (size_t)(row0 + ai * HALF + m * 16);
                    const f32x4 v0 = acc[ai][bj][m][0], v1 = acc[ai][bj][m][1]; const u32x4 gg = g[bj][m], pp = pv[bj][m];
                    float o[8];
                    o[0] = bflo(pp.x) + bflo(gg.x) * v0[0]; o[1] = bfhi(pp.x) + bfhi(gg.x) * v0[1]; o[2] = bflo(pp.y) + bflo(gg.y) * v0[2]; o[3] = bfhi(pp.y) + bfhi(gg.y) * v0[3];
                    o[4] = bflo(pp.z) + bflo(gg.z) * v1[0]; o[5] = bfhi(pp.z) + bfhi(gg.z) * v1[1]; o[6] = bflo(pp.w) + bflo(gg.w) * v1[2]; o[7] = bfhi(pp.w) + bfhi(gg.w) * v1[3];
                    u32x4 w; w.x = pk2(o[0], o[1]); w.y = pk2(o[2], o[3]); w.z = pk2(o[4], o[5]); w.w = pk2(o[6], o[7]);
                    *(GAS u32x4*)(Mg + row * 1024 + col0 + bj * HALF) = w; }
        }
    }
};
struct EpiResid {
    static constexpr bool PERM = true;
    const float* base; float* out; bf16_t* xb; float* ssq;
    __device__ __forceinline__ void operator()(const f32x4 (&acc)[2][2][4][2], const Unit& u, int wr, int wc, int fr, int fq) const {
        const int row0 = u.pm * BM + wr * 64 + fr, col0 = u.pn * BM + wc * 32 + 8 * fq, lane = fr + 16 * fq;
#pragma unroll
        for (int ai = 0; ai < 2; ++ai) {
            f32x4 b[4][2][2];
#pragma unroll
            for (int m = 0; m < 4; ++m) { const size_t off = (size_t)(row0 + ai * HALF + m * 16) * 1024 + col0;
#pragma unroll
                for (int bj = 0; bj < 2; ++bj) { b[m][bj][0] = *(const GAS f32x4*)(base + off + bj * HALF); b[m][bj][1] = *(const GAS f32x4*)(base + off + bj * HALF + 4); } }
#pragma unroll
            for (int m = 0; m < 4; ++m) { const int row = row0 + ai * HALF + m * 16; const size_t off = (size_t)row * 1024 + col0;
                float sq = 0.f;
#pragma unroll
                for (int bj = 0; bj < 2; ++bj) { const f32x4 o0 = b[m][bj][0] + acc[ai][bj][m][0], o1 = b[m][bj][1] + acc[ai][bj][m][1];
                    *(GAS f32x4*)(out + off + bj * HALF) = o0; *(GAS f32x4*)(out + off + bj * HALF + 4) = o1;
                    *(GAS u32x4*)(xb + off + bj * HALF) = (u32x4){pk2(o0[0], o0[1]), pk2(o0[2], o0[3]), pk2(o1[0], o1[1]), pk2(o1[2], o1[3])};
                    sq += (o0[0] * o0[0] + o0[1] * o0[1]) + (o0[2] * o0[2] + o0[3] * o0[3]) + (o1[0] * o1[0] + o1[1] * o1[1]) + (o1[2] * o1[2] + o1[3] * o1[3]); }
                sq += shx(sq, 16, lane); sq += shx(sq, 32, lane);
                if (fq == 0) __hip_atomic_fetch_add((GAS float*)(ssq + row), sq, __ATOMIC_RELAXED, __HIP_MEMORY_SCOPE_AGENT); }
        }
    }
};

template <class Epi, class Sched>
__device__ __forceinline__ void gemm_phase(LAS unsigned char* lds, const Gemm g, const Sched& S, const Epi& E, int wv_) {
    OPAQUE_TID(tid);
    const int wid = __builtin_amdgcn_readfirstlane(tid >> 6), lane = tid & 63, wr = wid >> 2, wc = wid & 3, fr = lane & 15, fq = lane >> 4;
    const int K = g.K, nt = K / BK;
    unsigned voffA[2], voffB[2];
#pragma unroll
    for (int i = 0; i < 2; ++i) { int R, C; stage_rc(tid * 16 + i * 8192, R, C); const int Rb = Epi::PERM ? ((R & ~31) + perm32(R & 31)) : R;
        voffA[i] = (unsigned)(R * g.lda + C) * 2u; voffB[i] = (unsigned)(Rb * g.ldb + C) * 2u; }
    const size_t kstep = (size_t)(BK * 2);
    const size_t hstepA = (size_t)HALF * g.lda * 2, hstepB = (size_t)HALF * g.ldb * 2;
    const size_t tstepA = 2 * hstepA, tstepB = 2 * hstepB;
    const unsigned ldsw = (unsigned)wid * 1024u;
    const int aoff = lds_byte(wr * 64 + fr, fq * 8), boff = lds_byte(wc * 32 + fr, fq * 8);
#define PG8_SA(b, h) (((b) * 2 + (h)) * HTB)
#define PG8_SB(b, h) ((4 + (b) * 2 + (h)) * HTB)
#define PG8_STAGE(bufoff, gbase, voff) do { _Pragma("unroll") for (int _i = 0; _i < 2; ++_i) { unsigned vo_ = (voff)[_i]; asm volatile("" : "+v"(vo_));     \
        __builtin_amdgcn_global_load_lds((const unsigned*)((const char*)(gbase) + vo_), (LAS unsigned*)(lds + (bufoff) + ldsw + _i * 8192), 16, 0, 0); } } while (0)
#define PG8_LDA(dst, b, h) do { _Pragma("unroll") for (int m = 0; m < 4; ++m) _Pragma("unroll") for (int k = 0; k < 2; ++k) dst[m][k] = *(const LAS bf16x8*)(lds + PG8_SA(b, h) + aoff + m * 2048 + k * 1024); } while (0)
#define PG8_LDB(dst, b, h) do { _Pragma("unroll") for (int n = 0; n < 2; ++n) _Pragma("unroll") for (int k = 0; k < 2; ++k) dst[n][k] = *(const LAS bf16x8*)(lds + PG8_SB(b, h) + boff + n * 2048 + k * 1024); } while (0)
#define PG8_MMA(ai, bj, At, Bt) do { __builtin_amdgcn_s_setprio(1); _Pragma("unroll") for (int m = 0; m < 4; ++m) _Pragma("unroll") for (int n = 0; n < 2; ++n) _Pragma("unroll") for (int k = 0; k < 2; ++k) \
        acc[ai][bj][m][n] = __builtin_amdgcn_mfma_f32_16x16x32_bf16(Bt[n][k], At[m][k], acc[ai][bj][m][n], 0, 0, 0); __builtin_amdgcn_s_setprio(0); } while (0)
#define PG8_WAIT_V(n) asm volatile("s_waitcnt vmcnt(" #n ")" ::: "memory")
#define PG8_WAIT_L(n) asm volatile("s_waitcnt lgkmcnt(" #n ")" ::: "memory")
#define PG8_BAR __builtin_amdgcn_s_barrier()
#define PG8_SCHED __builtin_amdgcn_sched_barrier(0)
    Unit cur, nxt; int ui = 0;
    if (!S.next(0, cur)) return;
    f32x4 acc[2][2][4][2];
#pragma unroll
    for (int a = 0; a < 2; ++a)
#pragma unroll
        for (int b = 0; b < 2; ++b)
#pragma unroll
            for (int m = 0; m < 4; ++m)
#pragma unroll
                for (int n = 0; n < 2; ++n) acc[a][b][m][n] = (f32x4){0.f, 0.f, 0.f, 0.f};
    bf16x8 At[4][2], B0[2][2], B1[2][2];
    const char* cA = (const char*)g.A + (size_t)cur.pm * tstepA + (size_t)cur.z * g.za; const char* cB = (const char*)g.Bt + (size_t)cur.pn * tstepB + (size_t)cur.z * g.zb;
    PG8_STAGE(PG8_SB(0, 0), cB, voffB); PG8_STAGE(PG8_SB(0, 1), cB + hstepB, voffB); PG8_STAGE(PG8_SA(0, 0), cA, voffA); PG8_STAGE(PG8_SA(0, 1), cA + hstepA, voffA);
    if (wr == 1) PG8_BAR;
    PG8_WAIT_V(2); PG8_BAR;
    PG8_STAGE(PG8_SB(1, 0), cB + kstep, voffB); PG8_STAGE(PG8_SA(1, 0), cA + kstep, voffA); PG8_STAGE(PG8_SB(1, 1), cB + hstepB + kstep, voffB);
    PG8_WAIT_V(6); PG8_BAR;
    for (;;) {
        const bool has_next = S.next(ui + 1, nxt);
        const char* nA = has_next ? (const char*)g.A + (size_t)nxt.pm * tstepA + (size_t)nxt.z * g.za : cA; const char* nB = has_next ? (const char*)g.Bt + (size_t)nxt.pn * tstepB + (size_t)nxt.z * g.zb : cB;
        for (int t = 0; t < nt; t += 2) {
            const bool last = (t == nt - 2);
            const char* a1 = cA + (size_t)(t + 1) * kstep;
            const char* a2 = last ? nA : cA + (size_t)(t + 2) * kstep; const char* b2 = last ? nB : cB + (size_t)(t + 2) * kstep;
            const char* a3 = a2 + kstep; const char* b3 = b2 + kstep;
            PG8_LDB(B0, 0, 0); PG8_LDB(B1, 0, 1); PG8_SCHED; PG8_LDA(At, 0, 0); PG8_STAGE(PG8_SA(1, 1), a1 + hstepA, voffA);
            PG8_WAIT_V(8); PG8_WAIT_L(0); PG8_BAR; PG8_MMA(0, 0, At, B0); PG8_MMA(0, 1, At, B1); PG8_BAR; PG8_SCHED;
            PG8_LDA(At, 0, 1); PG8_STAGE(PG8_SB(0, 0), b2, voffB); PG8_STAGE(PG8_SB(0, 1), b2 + hstepB, voffB); PG8_STAGE(PG8_SA(0, 0), a2, voffA);
            PG8_WAIT_V(8); PG8_WAIT_L(0); PG8_BAR; PG8_MMA(1, 0, At, B0); PG8_MMA(1, 1, At, B1); PG8_BAR; PG8_SCHED;
            PG8_LDB(B0, 1, 0); PG8_LDB(B1, 1, 1); PG8_SCHED; PG8_LDA(At, 1, 0); PG8_STAGE(PG8_SA(0, 1), a2 + hstepA, voffA);
            PG8_WAIT_V(8); PG8_WAIT_L(0); PG8_BAR; PG8_MMA(0, 0, At, B0); PG8_MMA(0, 1, At, B1); PG8_BAR; PG8_SCHED;
            PG8_LDA(At, 1, 1); PG8_STAGE(PG8_SB(1, 0), b3, voffB); PG8_STAGE(PG8_SB(1, 1), b3 + hstepB, voffB); PG8_STAGE(PG8_SA(1, 0), a3, voffA);
            PG8_WAIT_V(8); PG8_WAIT_L(0); PG8_BAR; PG8_MMA(1, 0, At, B0); PG8_MMA(1, 1, At, B1); PG8_BAR; PG8_SCHED;
        }
        if (wr == 0) PG8_BAR;
        { OPAQUE_TID(t2_); E(acc, cur, wr, wc, t2_ & 15, (t2_ >> 4) & 3); }
        if (!has_next) break;
#pragma unroll
        for (int a = 0; a < 2; ++a)
#pragma unroll
            for (int b = 0; b < 2; ++b)
#pragma unroll
                for (int m = 0; m < 4; ++m)
#pragma unroll
                    for (int n = 0; n < 2; ++n) acc[a][b][m][n] = (f32x4){0.f, 0.f, 0.f, 0.f};
        cur = nxt; cA = nA; cB = nB; ++ui;
        if (wr == 1) PG8_BAR;
    }
    PG8_WAIT_V(0);
    PG8_BAR;
#undef PG8_SA
#undef PG8_SB
#undef PG8_STAGE
#undef PG8_LDA
#undef PG8_LDB
#undef PG8_MMA
#undef PG8_WAIT_V
#undef PG8_WAIT_L
#undef PG8_BAR
#undef PG8_SCHED
}
}

constexpr int DM = 1024, SEQ = 8192, MTOT = 32768, MH = 16384, NIN = 7168, FF = 4096;
constexpr float EPS = 1e-6f, LOG2E = 1.4426950408889634f;
constexpr int LDS_BYTES = 147456;
constexpr size_t MiB = 1u << 20;
constexpr size_t WS_CTL = 0;
constexpr size_t WS_W = 1 * MiB, W_LAYER = 36 * MiB;
constexpr size_t WO_IN = 0, WO_QK = 14 * MiB, WO_V = 15 * MiB, WO_BR = 16 * MiB, WO_OUT = 19 * MiB, WO_F1 = 21 * MiB, WO_F2 = 29 * MiB;
constexpr size_t W_LAYER_REAL = 37 * MiB;
constexpr size_t WS_DL = 75 * MiB;
constexpr size_t WS_XN = 80 * MiB;
constexpr size_t WS_CS = 75 * MiB + 512 * 1024;
constexpr size_t WS_SS = 78 * MiB;
constexpr size_t WS_P = 144 * MiB;
constexpr size_t WS_G = 272 * MiB;
constexpr size_t WS_Q = 368 * MiB;
constexpr size_t WS_KN = 392 * MiB;
constexpr size_t WS_VT = 408 * MiB;
constexpr size_t WS_Y = 424 * MiB;
constexpr size_t WS_MG = 472 * MiB;
constexpr size_t WS_H = 144 * MiB;
static_assert(WS_W + 2 * W_LAYER_REAL <= WS_XN, "weights fit");

__device__ __forceinline__ void rows_bf16_ssq(const float* x, bf16_t* dst, float* ssq, int rows, int NGW, int wv_) {
    OPAQUE_TID(tid_); const int lane = tid_ & 63, gw = blockIdx.x * 8 + __builtin_amdgcn_readfirstlane(tid_ >> 6);
    for (int m0 = gw * 4; m0 < rows; m0 += NGW * 4) {
        f32x4 v[4][4];
#pragma unroll
        for (int q = 0; q < 4; ++q) { const GAS f32x4* xr = (const GAS f32x4*)(x + (size_t)(m0 + q) * DM) + lane;
#pragma unroll
            for (int j = 0; j < 4; ++j) v[q][j] = xr[64 * j]; }
#pragma unroll
        for (int q = 0; q < 4; ++q) { float s = 0.f;
            GAS unsigned long long* o8 = (GAS unsigned long long*)(dst + (size_t)(m0 + q) * DM) + lane;
#pragma unroll
            for (int j = 0; j < 4; ++j) { const f32x4 t = v[q][j]; s += (t.x * t.x + t.y * t.y) + (t.z * t.z + t.w * t.w);
                o8[64 * j] = (unsigned long long)pk2(t.x, t.y) | ((unsigned long long)pk2(t.z, t.w) << 32); }
            s = wave_sum(s, lane);
            if (lane == 0) ((GAS float*)ssq)[m0 + q] = s; }
    }
}
__device__ __forceinline__ void final_norm(float* x, const float* g, const float* ssq, int G, int wv_) {
    OPAQUE_TID(tid_);
    const size_t n4 = (size_t)MTOT * DM / 4, stride = (size_t)G * 512;
    for (size_t i = (size_t)blockIdx.x * 512 + tid_; i < n4; i += stride) {
        const f32x4 v = ((const GAS f32x4*)x)[i];
        const float r = 1.0f / sqrtf(((const GAS float*)ssq)[i >> 8] * (1.0f / DM) + EPS);
        const f32x4 gg = ((const GAS f32x4*)g)[i & 255];
        ((GAS f32x4*)x)[i] = v * r * gg;
    }
}
__device__ __forceinline__ void mla_prep(bf16_t* P, const int* pos, const float* gq, const float* gkv, float* cs, int NGW, int wv_) {
    OPAQUE_TID(tid_); const int lane = tid_ & 63, gw = blockIdx.x * 8 + __builtin_amdgcn_readfirstlane(tid_ >> 6);
    const f32x4 gg = ((const GAS f32x4*)gq)[lane];
    const float gk0 = ((const GAS float*)gkv)[2 * lane], gk1 = ((const GAS float*)gkv)[2 * lane + 1];
    const float invf = exp2f(-(float)(lane & 15) * 0.83048202372184059f);
    for (int m0 = gw * 4; m0 < MH; m0 += NGW * 4) {
        u32x2 wq[4]; unsigned wk[4]; float x1[4], x2[4]; int ps[4];
#pragma unroll
        for (int q = 0; q < 4; ++q) { GAS bf16_t* prow = (GAS bf16_t*)(P + (size_t)(m0 + q) * 4096 + 3584);
            wq[q] = *(const GAS u32x2*)(prow + 4 * lane); wk[q] = *(const GAS unsigned*)(prow + 256 + 2 * lane);
            x1[q] = __uint_as_float((unsigned)prow[384 + (lane & 15)] << 16); x2[q] = __uint_as_float((unsigned)prow[400 + (lane & 15)] << 16); ps[q] = ((const GAS int*)pos)[m0 + q]; }
#pragma unroll
        for (int q = 0; q < 4; ++q) { GAS bf16_t* prow = (GAS bf16_t*)(P + (size_t)(m0 + q) * 4096 + 3584); const int m = m0 + q;
            { const float a = bflo(wq[q].x), b = bfhi(wq[q].x), c = bflo(wq[q].y), d = bfhi(wq[q].y);
              const float r = 1.0f / sqrtf(wave_sum((a * a + b * b) + (c * c + d * d), lane) * (1.0f / 256.0f) + EPS);
              u32x2 o; o.x = pk2(a * r * gg.x, b * r * gg.y); o.y = pk2(c * r * gg.z, d * r * gg.w);
              *(GAS u32x2*)(prow + 4 * lane) = o; }
            { const float a = bflo(wk[q]), b = bfhi(wk[q]);
              const float r = 1.0f / sqrtf(wave_sum(a * a + b * b, lane) * (1.0f / 128.0f) + EPS);
              *(GAS unsigned*)(prow + 256 + 2 * lane) = pk2(a * r * gk0, b * r * gk1); }
            if (lane < 16) {
                double fr = (double)ps[q] * (double)invf * 0.15915494309189535;
                fr -= rint(fr);
                const float c = __builtin_amdgcn_cosf((float)fr), s = __builtin_amdgcn_sinf((float)fr);
                ((GAS float*)cs)[(size_t)m * 32 + lane] = c; ((GAS float*)cs)[(size_t)m * 32 + 16 + lane] = s;
                prow[384 + lane] = f2bf(x1[q] * c - x2[q] * s); prow[400 + lane] = f2bf(x2[q] * c + x1[q] * s);
            } }
    }
}

constexpr int VP = 72;
__device__ __forceinline__ float max3f(float a, float b, float c) { return __builtin_fmaxf(__builtin_fmaxf(a, b), c); }
template <int ND0, int KP>
__device__ __forceinline__ void qk_tile(const LAS unsigned char* Ks, const bf16x8 (&qf)[ND0], const f32x16& negm, f32x16& p0, f32x16& p1, int r32, int hi) {
#pragma unroll
    for (int d0 = 0; d0 < ND0; ++d0) {
        const bf16x8 a0 = *(const LAS bf16x8*)(Ks + r32 * (KP * 2) + (16 * d0 + 8 * hi) * 2);
        const bf16x8 a1 = *(const LAS bf16x8*)(Ks + (r32 + 32) * (KP * 2) + (16 * d0 + 8 * hi) * 2);
        if (d0 == 0) { p0 = MFMA32(a0, qf[0], negm); p1 = MFMA32(a1, qf[0], negm); }
        else { p0 = MFMA32(a0, qf[d0], p0); p1 = MFMA32(a1, qf[d0], p1); }
    }
}
__device__ __forceinline__ void softmax_pv(f32x16& p0, f32x16& p1, f32x16 (&o)[2], float& m_run, float& l_run, f32x16& negm, bool first, const LAS unsigned char* Vts, LAS float* sc, int r32, int hi) {
    float a = max3f(p0[0], p0[1], p1[0]), b = max3f(p0[2], p0[3], p1[1]); a = max3f(a, p1[2], p1[3]);
#pragma unroll
    for (int r = 4; r < 16; r += 4) { a = max3f(a, p0[r], p0[r + 1]); b = max3f(b, p0[r + 2], p0[r + 3]); a = max3f(a, p1[r], p1[r + 1]); b = max3f(b, p1[r + 2], p1[r + 3]); }
    float mx = __builtin_fmaxf(a, b);
    { auto rr = __builtin_amdgcn_permlane32_swap(__float_as_uint(mx), __float_as_uint(mx), false, false); mx = __builtin_fmaxf(__uint_as_float(rr[0]), __uint_as_float(rr[1])); }
    if (first || __any(mx > 8.0f)) {
        const float dl = first ? mx : __builtin_fmaxf(mx, 0.f);
        m_run += dl;
#pragma unroll
        for (int r = 0; r < 16; ++r) { p0[r] -= dl; p1[r] -= dl; negm[r] = -m_run; }
        if (!first) {
            const float al = ex2(-dl); l_run *= al;
            if (hi == 0) sc[r32] = al;
            LDS_WAIT();
#pragma unroll
            for (int g4 = 0; g4 < 4; ++g4) { const f32x4 av = *(const LAS f32x4*)(sc + 8 * g4 + 4 * hi);
#pragma unroll
                for (int e = 0; e < 4; ++e) { o[0][4 * g4 + e] *= av[e]; o[1][4 * g4 + e] *= av[e]; } }
            LDS_WAIT();
        }
    }
    float s = 0.f;
#pragma unroll
    for (int r = 0; r < 16; ++r) { p0[r] = ex2(p0[r]); p1[r] = ex2(p1[r]); s += p0[r] + p1[r]; }
    l_run += s;
#pragma unroll
    for (int ks = 0; ks < 4; ++ks) {
        u32x4 pw;
        if (ks == 0) pw = (u32x4){pk2(p0[0], p0[1]), pk2(p0[2], p0[3]), pk2(p0[4], p0[5]), pk2(p0[6], p0[7])};
        else if (ks == 1) pw = (u32x4){pk2(p0[8], p0[9]), pk2(p0[10], p0[11]), pk2(p0[12], p0[13]), pk2(p0[14], p0[15])};
        else if (ks == 2) pw = (u32x4){pk2(p1[0], p1[1]), pk2(p1[2], p1[3]), pk2(p1[4], p1[5]), pk2(p1[6], p1[7])};
        else pw = (u32x4){pk2(p1[8], p1[9]), pk2(p1[10], p1[11]), pk2(p1[12], p1[13]), pk2(p1[14], p1[15])};
        const bf16x8 pa = __builtin_bit_cast(bf16x8, pw);
#pragma unroll
        for (int db = 0; db < 2; ++db) {
            const bf16x8 vb = *(const LAS bf16x8*)(Vts + (32 * db + r32) * (VP * 2) + (16 * ks + 8 * hi) * 2);
            o[db] = MFMA32(pa, vb, o[db]);
        }
    }
}
__device__ __forceinline__ void attn_finish(f32x16 (&o)[2], float l_run, bf16_t* y, size_t row0, int ldy, int col0, LAS float* sc, int r32, int hi) {
    float lt = l_run;
    { auto rr = __builtin_amdgcn_permlane32_swap(__float_as_uint(lt), __float_as_uint(lt), false, false); lt = __uint_as_float(rr[0]) + __uint_as_float(rr[1]); }
    if (hi == 0) sc[r32] = 1.0f / lt;
    LDS_WAIT();
#pragma unroll
    for (int g4 = 0; g4 < 4; ++g4) { const f32x4 a = *(const LAS f32x4*)(sc + 8 * g4 + 4 * hi);
#pragma unroll
        for (int e = 0; e < 4; ++e) { const int r = 4 * g4 + e; GAS bf16_t* yp = (GAS bf16_t*)(y + (row0 + crow(r, hi)) * ldy + col0 + r32);
            yp[0] = f2bf(o[0][r] * a[e]); yp[32] = f2bf(o[1][r] * a[e]); } }
    LDS_WAIT();
}

#define SBAR() __builtin_amdgcn_sched_barrier(0)
template <int KP>
__device__ __forceinline__ void qk_pair6(const LAS unsigned char* Ka, const LAS unsigned char* Kb, const bf16x8 (&qf)[6], const f32x16& negm, f32x16& a0, f32x16& a1, f32x16& b0, f32x16& b1, int r32, int hi) {
    const LAS unsigned char* pa = Ka + r32 * (KP * 2) + 16 * hi; const LAS unsigned char* pb = Kb + r32 * (KP * 2) + 16 * hi;
    bf16x8 g0[6], g1[6];
#define LDG(dst, base, d0s) do { _Pragma("unroll") for (int j = 0; j < 3; ++j) { dst[2 * j] = *(const LAS bf16x8*)((base) + 32 * ((d0s) + j)); dst[2 * j + 1] = *(const LAS bf16x8*)((base) + 32 * (KP * 2) + 32 * ((d0s) + j)); } } while (0)
    LDG(g0, pa, 0); LDG(g1, pa, 3);
    SBAR(); __builtin_amdgcn_s_setprio(1);
    a0 = MFMA32(g0[0], qf[0], negm); a1 = MFMA32(g0[1], qf[0], negm); a0 = MFMA32(g0[2], qf[1], a0); a1 = MFMA32(g0[3], qf[1], a1); a0 = MFMA32(g0[4], qf[2], a0); a1 = MFMA32(g0[5], qf[2], a1);
    SBAR();
    LDG(g0, pb, 0);
    SBAR();
    a0 = MFMA32(g1[0], qf[3], a0); a1 = MFMA32(g1[1], qf[3], a1); a0 = MFMA32(g1[2], qf[4], a0); a1 = MFMA32(g1[3], qf[4], a1); a0 = MFMA32(g1[4], qf[5], a0); a1 = MFMA32(g1[5], qf[5], a1);
    SBAR();
    LDG(g1, pb, 3);
    SBAR();
    b0 = MFMA32(g0[0], qf[0], negm); b1 = MFMA32(g0[1], qf[0], negm); b0 = MFMA32(g0[2], qf[1], b0); b1 = MFMA32(g0[3], qf[1], b1); b0 = MFMA32(g0[4], qf[2], b0); b1 = MFMA32(g0[5], qf[2], b1);
    SBAR();
    b0 = MFMA32(g1[0], qf[3], b0); b1 = MFMA32(g1[1], qf[3], b1); b0 = MFMA32(g1[2], qf[4], b0); b1 = MFMA32(g1[3], qf[4], b1); b0 = MFMA32(g1[4], qf[5], b0); b1 = MFMA32(g1[5], qf[5], b1);
    __builtin_amdgcn_s_setprio(0); SBAR();
#undef LDG
}
__device__ __forceinline__ void softmax_pv2(f32x16& a0, f32x16& a1, f32x16& b0, f32x16& b1, f32x16 (&o)[2], float& m_run, float& l_run, f32x16& negm, bool first,
                                            const LAS unsigned char* Va, const LAS unsigned char* Vb, LAS float* sc, int r32, int hi) {
    float x = max3f(a0[0], a0[1], a1[0]), y = max3f(a0[2], a0[3], a1[1]); x = max3f(x, a1[2], a1[3]);
    float u = max3f(b0[0], b0[1], b1[0]), v = max3f(b0[2], b0[3], b1[1]); u = max3f(u, b1[2], b1[3]);
#pragma unroll
    for (int r = 4; r < 16; r += 4) { x = max3f(x, a0[r], a0[r + 1]); y = max3f(y, a0[r + 2], a0[r + 3]); x = max3f(x, a1[r], a1[r + 1]); y = max3f(y, a1[r + 2], a1[r + 3]);
        u = max3f(u, b0[r], b0[r + 1]); v = max3f(v, b0[r + 2], b0[r + 3]); u = max3f(u, b1[r], b1[r + 1]); v = max3f(v, b1[r + 2], b1[r + 3]); }
    float mx = __builtin_fmaxf(__builtin_fmaxf(x, y), __builtin_fmaxf(u, v));
    { auto rr = __builtin_amdgcn_permlane32_swap(__float_as_uint(mx), __float_as_uint(mx), false, false); mx = __builtin_fmaxf(__uint_as_float(rr[0]), __uint_as_float(rr[1])); }
    if (first || __any(mx > 8.0f)) {
        const float dl = first ? mx : __builtin_fmaxf(mx, 0.f);
        m_run += dl;
#pragma unroll
        for (int r = 0; r < 16; ++r) { a0[r] -= dl; a1[r] -= dl; b0[r] -= dl; b1[r] -= dl; negm[r] = -m_run; }
        if (!first) {
            const float al = ex2(-dl); l_run *= al;
            if (hi == 0) sc[r32] = al;
            LDS_WAIT();
#pragma unroll
            for (int g4 = 0; g4 < 4; ++g4) { const f32x4 av = *(const LAS f32x4*)(sc + 8 * g4 + 4 * hi);
#pragma unroll
                for (int e = 0; e < 4; ++e) { o[0][4 * g4 + e] *= av[e]; o[1][4 * g4 + e] *= av[e]; } }
            LDS_WAIT();
        }
    }
    float s = 0.f, t = 0.f;
#pragma unroll
    for (int r = 0; r < 16; ++r) { a0[r] = ex2(a0[r]); a1[r] = ex2(a1[r]); s += a0[r] + a1[r]; }
#pragma unroll
    for (int r = 0; r < 16; ++r) { b0[r] = ex2(b0[r]); b1[r] = ex2(b1[r]); t += b0[r] + b1[r]; }
    l_run += s + t;
#pragma unroll
    for (int half = 0; half < 2; ++half) {
        const f32x16& p0 = half ? b0 : a0; const f32x16& p1 = half ? b1 : a1; const LAS unsigned char* Vts = half ? Vb : Va;
#pragma unroll
        for (int ks = 0; ks < 4; ++ks) {
            u32x4 pw;
            if (ks == 0) pw = (u32x4){pk2(p0[0], p0[1]), pk2(p0[2], p0[3]), pk2(p0[4], p0[5]), pk2(p0[6], p0[7])};
            else if (ks == 1) pw = (u32x4){pk2(p0[8], p0[9]), pk2(p0[10], p0[11]), pk2(p0[12], p0[13]), pk2(p0[14], p0[15])};
            else if (ks == 2) pw = (u32x4){pk2(p1[0], p1[1]), pk2(p1[2], p1[3]), pk2(p1[4], p1[5]), pk2(p1[6], p1[7])};
            else pw = (u32x4){pk2(p1[8], p1[9]), pk2(p1[10], p1[11]), pk2(p1[12], p1[13]), pk2(p1[14], p1[15])};
            const bf16x8 pa = __builtin_bit_cast(bf16x8, pw);
#pragma unroll
            for (int db = 0; db < 2; ++db) {
                const bf16x8 vb = *(const LAS bf16x8*)(Vts + (32 * db + r32) * (VP * 2) + (16 * ks + 8 * hi) * 2);
                o[db] = MFMA32(pa, vb, o[db]);
            }
        }
    }
}

__device__ __forceinline__ void mla_unit(const bf16_t* Q, const bf16_t* KN, const bf16_t* KR, const bf16_t* VT, const float* CS, bf16_t* Y, int bl, int h, int qb, LAS unsigned char* lds, int wv_) {
    OPAQUE_TID(tid);
    constexpr int KP = 104, KBUF = 64 * KP * 2, VBUF = 64 * VP * 2, OFF_V = 4 * KBUF, OFF_SC = OFF_V + 4 * VBUF;
    const int lane = tid & 63, w = __builtin_amdgcn_readfirstlane(tid >> 6), r32 = lane & 31, hi = lane >> 5;
    const size_t rb = (size_t)bl * SEQ;
    LAS float* sc = (LAS float*)(lds + OFF_SC) + w * 32;
    const float QS = 0.10206207261596577f * LOG2E;
    bf16x8 qf[6];
    { const size_t qrow = rb + (size_t)qb * 256 + 32 * w + r32;
      const bf16_t* qp = Q + qrow * 768 + h * 96;
#pragma unroll
      for (int d0 = 0; d0 < 4; ++d0) { const u32x4 raw = *(const GAS u32x4*)(qp + 16 * d0 + 8 * hi);
          u32x4 t; t.x = pk2(bflo(raw.x) * QS, bfhi(raw.x) * QS); t.y = pk2(bflo(raw.y) * QS, bfhi(raw.y) * QS); t.z = pk2(bflo(raw.z) * QS, bfhi(raw.z) * QS); t.w = pk2(bflo(raw.w) * QS, bfhi(raw.w) * QS);
          qf[d0] = __builtin_bit_cast(bf16x8, t); }
      const u32x4 r1 = *(const GAS u32x4*)(qp + 64 + 8 * hi), r2 = *(const GAS u32x4*)(qp + 80 + 8 * hi);
      const f32x4 c0 = *(const GAS f32x4*)(CS + qrow * 32 + 8 * hi), c1 = *(const GAS f32x4*)(CS + qrow * 32 + 8 * hi + 4);
      const f32x4 s0 = *(const GAS f32x4*)(CS + qrow * 32 + 16 + 8 * hi), s1 = *(const GAS f32x4*)(CS + qrow * 32 + 16 + 8 * hi + 4);
      const float x1[8] = {bflo(r1.x), bfhi(r1.x), bflo(r1.y), bfhi(r1.y), bflo(r1.z), bfhi(r1.z), bflo(r1.w), bfhi(r1.w)};
      const float x2[8] = {bflo(r2.x), bfhi(r2.x), bflo(r2.y), bfhi(r2.y), bflo(r2.z), bfhi(r2.z), bflo(r2.w), bfhi(r2.w)};
      const float cc[8] = {c0.x, c0.y, c0.z, c0.w, c1.x, c1.y, c1.z, c1.w}, ss[8] = {s0.x, s0.y, s0.z, s0.w, s1.x, s1.y, s1.z, s1.w};
      float o1[8], o2[8];
#pragma unroll
      for (int i = 0; i < 8; ++i) { o1[i] = (x1[i] * cc[i] - x2[i] * ss[i]) * QS; o2[i] = (x2[i] * cc[i] + x1[i] * ss[i]) * QS; }
      u32x4 t1 = (u32x4){pk2(o1[0], o1[1]), pk2(o1[2], o1[3]), pk2(o1[4], o1[5]), pk2(o1[6], o1[7])}, t2 = (u32x4){pk2(o2[0], o2[1]), pk2(o2[2], o2[3]), pk2(o2[4], o2[5]), pk2(o2[6], o2[7])};
      qf[4] = __builtin_bit_cast(bf16x8, t1); qf[5] = __builtin_bit_cast(bf16x8, t2); }
    const int T = 4 * qb + 4;
    const int tlast = 4 * qb + (w >> 1);
    const int krow = tid >> 3, kch = tid & 7;
    const int rrow = (tid & 255) >> 2, rch = tid & 3;
    const bf16_t* knp = KN + (rb + krow) * 512 + h * 64 + 8 * kch;
    const bf16_t* krp = KR + (rb + rrow) * 4096 + 8 * rch;
    const bf16_t* vtp = VT + (size_t)(h * 64 + krow) * MH + rb + 8 * kch;
    const int vpos = 16 * (kch >> 1) + ((kch & 1) ? 4 : 0);
    u32x4 gk0, gr0 = (u32x4){0u, 0u, 0u, 0u}, gv0, gk1, gr1 = (u32x4){0u, 0u, 0u, 0u}, gv1;
#define MLA_LOAD1(S, t) do { gk##S = *(const GAS u32x4*)(knp + (size_t)(t) * 64 * 512); if (tid < 256) gr##S = *(const GAS u32x4*)(krp + (size_t)(t) * 64 * 4096); gv##S = *(const GAS u32x4*)(vtp + (size_t)(t) * 64); } while (0)
#define MLA_STORE1(S, slot) do { *(LAS u32x4*)(lds + (slot) * KBUF + krow * (KP * 2) + kch * 16) = gk##S; if (tid < 256) *(LAS u32x4*)(lds + (slot) * KBUF + rrow * (KP * 2) + 128 + rch * 16) = gr##S; \
        LAS unsigned char* vd_ = lds + OFF_V + (slot) * VBUF + krow * (VP * 2) + vpos * 2; *(LAS u32x2*)vd_ = (u32x2){gv##S.x, gv##S.y}; *(LAS u32x2*)(vd_ + 16) = (u32x2){gv##S.z, gv##S.w}; } while (0)
    f32x16 o[2], negm, a0, a1, b0, b1;
#pragma unroll
    for (int r = 0; r < 16; ++r) { o[0][r] = 0.f; o[1][r] = 0.f; negm[r] = 0.f; }
    float m_run = 0.f, l_run = 0.f;
    bool first = true;
    MLA_LOAD1(0, 0); MLA_LOAD1(1, 1); MLA_STORE1(0, 0); MLA_STORE1(1, 1);
    __syncthreads();
#pragma unroll 1
    for (int tp = 0, st = 0; tp < T; tp += 2, st ^= 1) {
        if (tp + 2 < T) { MLA_LOAD1(0, tp + 2); MLA_LOAD1(1, tp + 3); }
        const LAS unsigned char* Ka = lds + (2 * st) * KBUF; const LAS unsigned char* Va = lds + OFF_V + (2 * st) * VBUF;
        if (tp + 1 <= tlast) {
            qk_pair6<KP>(Ka, Ka + KBUF, qf, negm, a0, a1, b0, b1, r32, hi);
            softmax_pv2(a0, a1, b0, b1, o, m_run, l_run, negm, first, Va, Va + VBUF, sc, r32, hi); first = false;
        } else if (tp <= tlast) {
            qk_tile<6, KP>(Ka, qf, negm, a0, a1, r32, hi);
            softmax_pv(a0, a1, o, m_run, l_run, negm, first, Va, sc, r32, hi); first = false;
        }
        if (tp + 2 < T) { MLA_STORE1(0, 2 * (st ^ 1)); MLA_STORE1(1, 2 * (st ^ 1) + 1); }
        __syncthreads();
    }
#undef MLA_LOAD1
#undef MLA_STORE1
    attn_finish(o, l_run, Y, rb + (size_t)qb * 256 + 32 * w, 1536, 1024 + h * 64, sc, r32, hi);
    __syncthreads();
}

__device__ __forceinline__ void bandattn_unit(const bf16_t* P, const float* relb  , bf16_t* Y, int bl, int h, int grp, LAS unsigned char* lds, int wv_) {
    OPAQUE_TID(tid);
    constexpr int KP = 72, KBUF = 64 * KP * 2, VBUF = 64 * VP * 2, OFF_V = 2 * KBUF, OFF_SC = OFF_V + 3 * VBUF, OFF_TB = OFF_SC + 8 * 128;
    const int lane = tid & 63, w = __builtin_amdgcn_readfirstlane(tid >> 6), r32 = lane & 31, hi = lane >> 5;
    const size_t rb = (size_t)bl * SEQ;
    LAS float* sc = (LAS float*)(lds + OFF_SC) + w * 32;
    LAS float* tb = (LAS float*)(lds + OFF_TB);
    if (tid < 257) tb[tid] = ((const GAS float*)relb)[tid] * LOG2E;
    const float QS = 0.125f * LOG2E;
    bf16x8 qf[4];
    { const size_t qrow = rb + (size_t)grp * 256 + 32 * w + r32;
      const bf16_t* qp = P + qrow * 4096 + h * 64;
#pragma unroll
      for (int d0 = 0; d0 < 4; ++d0) { const u32x4 raw = *(const GAS u32x4*)(qp + 16 * d0 + 8 * hi);
          u32x4 t; t.x = pk2(bflo(raw.x) * QS, bfhi(raw.x) * QS); t.y = pk2(bflo(raw.y) * QS, bfhi(raw.y) * QS); t.z = pk2(bflo(raw.z) * QS, bfhi(raw.z) * QS); t.w = pk2(bflo(raw.w) * QS, bfhi(raw.w) * QS);
          qf[d0] = __builtin_bit_cast(bf16x8, t); } }
    const int c = 4 * grp + (w >> 1);
    const int wg = w & 1;
    const int kc0 = (4 * grp - 8) > 0 ? (4 * grp - 8) : 0, kc1 = 4 * grp + 3;
    const int krow = tid >> 3, kch = tid & 7;
    const int vkv = tid & 63, vch = tid >> 6;
    const int vpos = (vkv & ~12) | ((vkv & 4) << 1) | ((vkv & 8) >> 1);
    const bf16_t* kp = P + (rb + krow) * 4096 + 512 + h * 64 + 8 * kch;
    const bf16_t* vp = P + (rb + vkv) * 4096 + 1024 + h * 64 + 8 * vch;
    u32x4 gk0, gv0, gk1, gv1;
#define BA_LOAD(S, kc) do { gk##S = *(const GAS u32x4*)(kp + (size_t)(kc) * 64 * 4096); gv##S = *(const GAS u32x4*)(vp + (size_t)(kc) * 64 * 4096); } while (0)
#define BA_STORE(S, kb, vb) do { *(LAS u32x4*)(lds + (kb) * KBUF + krow * (KP * 2) + kch * 16) = gk##S; \
        LAS bf16_t* vd = (LAS bf16_t*)(lds + OFF_V + (vb) * VBUF) + (8 * vch) * VP + vpos; \
        vd[0 * VP] = (bf16_t)(gv##S.x & 0xffffu); vd[1 * VP] = (bf16_t)(gv##S.x >> 16); vd[2 * VP] = (bf16_t)(gv##S.y & 0xffffu); vd[3 * VP] = (bf16_t)(gv##S.y >> 16); \
        vd[4 * VP] = (bf16_t)(gv##S.z & 0xffffu); vd[5 * VP] = (bf16_t)(gv##S.z >> 16); vd[6 * VP] = (bf16_t)(gv##S.w & 0xffffu); vd[7 * VP] = (bf16_t)(gv##S.w >> 16); } while (0)
    f32x16 o[2], negm, p0, p1;
#pragma unroll
    for (int r = 0; r < 16; ++r) { o[0][r] = 0.f; o[1][r] = 0.f; negm[r] = 0.f; p0[r] = 0.f; p1[r] = 0.f; }
    float m_run = 0.f, l_run = 0.f;
    bool first = true;
    BA_LOAD(0, kc0); BA_LOAD(1, kc0 + 1); BA_STORE(0, 0, 0);
    __syncthreads();
    const int qpos = 64 * c + 32 * (w & 1) + r32;
#define BA_QK(kc, kb) do { qk_tile<4, KP>(lds + (kb) * KBUF, qf, negm, p0, p1, r32, hi); \
        if (c - (kc) >= 3) { const float bb = tb[256]; _Pragma("unroll") for (int r = 0; r < 16; ++r) { p0[r] += bb; p1[r] += bb; } } \
        else { _Pragma("unroll") for (int r = 0; r < 16; ++r) { const int d0 = qpos - (64 * (kc) + crow(r, hi)); \
            const int i0 = d0 < -128 ? -128 : (d0 > 128 ? 128 : d0), i1 = (d0 - 32) < -128 ? -128 : ((d0 - 32) > 128 ? 128 : (d0 - 32)); \
            p0[r] += tb[i0 + 128]; p1[r] += tb[i1 + 128]; } } } while (0)
    int vcur = 0, vprev = 2, vnext = 1;
#define BA_STEP(kc, it, SL, SS) do { \
        if ((kc) + 2 <= kc1) BA_LOAD(SL, (kc) + 2); \
        if (wg == 1 && (it) >= 1 && (kc) - 1 >= c - 8 && (kc) - 1 <= c) { softmax_pv(p0, p1, o, m_run, l_run, negm, first, lds + OFF_V + vprev * VBUF, sc, r32, hi); first = false; } \
        if ((kc) >= c - 8 && (kc) <= c) BA_QK(kc, (it) & 1); \
        if (wg == 0 && (kc) >= c - 8 && (kc) <= c) { softmax_pv(p0, p1, o, m_run, l_run, negm, first, lds + OFF_V + vcur * VBUF, sc, r32, hi); first = false; } \
        if ((kc) + 1 <= kc1) BA_STORE(SS, ((it) + 1) & 1, vnext); \
        __syncthreads(); \
        { const int tmp = vprev; vprev = vcur; vcur = vnext; vnext = tmp; } } while (0)
#pragma unroll 1
    for (int kc = kc0, it = 0; kc <= kc1; kc += 2, it += 2) { BA_STEP(kc, it, 0, 1); BA_STEP(kc + 1, it + 1, 1, 0); }
    if (wg == 1 && kc1 <= c) softmax_pv(p0, p1, o, m_run, l_run, negm, first, lds + OFF_V + vprev * VBUF, sc, r32, hi);
#undef BA_LOAD
#undef BA_STORE
#undef BA_QK
#undef BA_STEP
    attn_finish(o, l_run, Y, rb + (size_t)grp * 256 + 32 * w, 1536, h * 64, sc, r32, hi);
    __syncthreads();
}

__device__ __forceinline__ void hgrn_x_unit(bf16_t* P, const float* lbl, float* DLg, int layer, int bl, int h, int cp, LAS unsigned char* ldsb, int wv_, const u32x4 (&rqa)[2], const u32x4 (&rfa)[2], const u32x4 (&ria)[2]) {
    OPAQUE_TID(tid);
    constexpr int RP = 144;
    constexpr int O_LF = 0, O_SEG = 16384, O_QT = 18432, O_KT = 27648, O_KH = 36864, O_VT = 46080, XCH = 55296;
    const int lane = tid & 63, w = __builtin_amdgcn_readfirstlane(tid >> 6), r32 = lane & 31, hi = lane >> 5;
    const int j = tid >> 3, c8 = tid & 7;
    const size_t rb0 = (size_t)bl * SEQ + (size_t)cp * 128;
    float kka[2][8];
#pragma unroll
    for (int ch = 0; ch < 2; ++ch) { LAS unsigned char* lds = ldsb + ch * XCH; const size_t rb = rb0 + ch * 64; const int c = 2 * cp + ch; (void)c; (void)rb;
      LAS float* LF = (LAS float*)(lds + O_LF); LAS float* SEG = (LAS float*)(lds + O_SEG); (void)SEG; (void)LF;
      bf16_t* base = P + (rb + j) * 4096 + h * 64 + 8 * c8; (void)base;
      const u32x4 rq = rqa[ch], rf = rfa[ch], ri = ria[ch]; (void)rq; (void)rf; (void)ri;
      float (&kk)[8] = kka[ch];
    { const float z[8] = {bflo(rf.x), bfhi(rf.x), bflo(rf.y), bfhi(rf.y), bflo(rf.z), bfhi(rf.z), bflo(rf.w), bfhi(rf.w)};
      float lf[8];
#pragma unroll
      for (int i = 0; i < 8; ++i) { const int d = h * 64 + 8 * c8 + i; const GAS float* lblg = (const GAS float*)lbl; const float lb = (layer == 0) ? 0.f : sigm(lblg[512 + d] - lblg[d]);
          const float sg = sigm(z[i]); const float f = lb + (1.0f - lb) * sg; lf[i] = fmaxf(__builtin_amdgcn_logf(f), -80.0f); kk[i] = (1.0f - lb) * (1.0f - sg); }
      *(LAS f32x4*)(LF + j * 64 + 8 * c8) = (f32x4){lf[0], lf[1], lf[2], lf[3]}; *(LAS f32x4*)(LF + j * 64 + 8 * c8 + 4) = (f32x4){lf[4], lf[5], lf[6], lf[7]}; }
    }
    __syncthreads();
#pragma unroll
    for (int ch = 0; ch < 2; ++ch) { LAS unsigned char* lds = ldsb + ch * XCH; const size_t rb = rb0 + ch * 64; const int c = 2 * cp + ch; (void)c; (void)rb;
      LAS float* LF = (LAS float*)(lds + O_LF); LAS float* SEG = (LAS float*)(lds + O_SEG); (void)SEG; (void)LF;
      bf16_t* base = P + (rb + j) * 4096 + h * 64 + 8 * c8; (void)base;
      const u32x4 rq = rqa[ch], rf = rfa[ch], ri = ria[ch]; (void)rq; (void)rf; (void)ri;
      float (&kk)[8] = kka[ch];
    { const int d = tid & 63, sg = tid >> 6; float v[8];
#pragma unroll
      for (int k = 0; k < 8; ++k) v[k] = LF[(8 * sg + k) * 64 + d];
#pragma unroll
      for (int k = 1; k < 8; ++k) v[k] += v[k - 1];
#pragma unroll
      for (int k = 0; k < 8; ++k) LF[(8 * sg + k) * 64 + d] = v[k];
      SEG[sg * 64 + d] = v[7]; }
    }
    __syncthreads();
#pragma unroll
    for (int ch = 0; ch < 2; ++ch) { LAS unsigned char* lds = ldsb + ch * XCH; const size_t rb = rb0 + ch * 64; const int c = 2 * cp + ch; (void)c; (void)rb;
      LAS float* LF = (LAS float*)(lds + O_LF); LAS float* SEG = (LAS float*)(lds + O_SEG); (void)SEG; (void)LF;
      bf16_t* base = P + (rb + j) * 4096 + h * 64 + 8 * c8; (void)base;
      const u32x4 rq = rqa[ch], rf = rfa[ch], ri = ria[ch]; (void)rq; (void)rf; (void)ri;
      float (&kk)[8] = kka[ch];
    { const int sg = j >> 3;
      float off[8], tot[8], mid[8];
#pragma unroll
      for (int i = 0; i < 8; ++i) { off[i] = 0.f; tot[i] = 0.f; mid[i] = 0.f; }
#pragma unroll
      for (int s2 = 0; s2 < 8; ++s2) { const f32x4 a = *(const LAS f32x4*)(SEG + s2 * 64 + 8 * c8), b = *(const LAS f32x4*)(SEG + s2 * 64 + 8 * c8 + 4);
          const float v8[8] = {a.x, a.y, a.z, a.w, b.x, b.y, b.z, b.w};
#pragma unroll
          for (int i = 0; i < 8; ++i) { if (s2 < sg) off[i] += v8[i]; tot[i] += v8[i]; if (s2 == 3) mid[i] = tot[i]; } }
      const f32x4 ca = *(const LAS f32x4*)(LF + j * 64 + 8 * c8), cb = *(const LAS f32x4*)(LF + j * 64 + 8 * c8 + 4);
      const float cl[8] = {ca.x, ca.y, ca.z, ca.w, cb.x, cb.y, cb.z, cb.w};
      const float qr[8] = {bflo(rq.x), bfhi(rq.x), bflo(rq.y), bfhi(rq.y), bflo(rq.z), bfhi(rq.z), bflo(rq.w), bfhi(rq.w)};
      float qt[8], kt[8], qh[8], kh[8];
#pragma unroll
      for (int i = 0; i < 8; ++i) { const float cum = cl[i] + off[i]; const float qs = qr[i] * sigm(qr[i]);
          qt[i] = qs * ex2(cum - mid[i]); kt[i] = kk[i] * ex2(mid[i] - cum); qh[i] = qs * ex2(cum); kh[i] = kk[i] * ex2(tot[i] - cum); }
      *(LAS u32x4*)(lds + O_QT + j * RP + c8 * 16) = (u32x4){pk2(qt[0], qt[1]), pk2(qt[2], qt[3]), pk2(qt[4], qt[5]), pk2(qt[6], qt[7])};
      *(LAS u32x4*)(lds + O_KT + j * RP + c8 * 16) = (u32x4){pk2(kt[0], kt[1]), pk2(kt[2], kt[3]), pk2(kt[4], kt[5]), pk2(kt[6], kt[7])};
      *(GAS u32x4*)(base + 1536) = (u32x4){pk2(qh[0], qh[1]), pk2(qh[2], qh[3]), pk2(qh[4], qh[5]), pk2(qh[6], qh[7])};
      LAS bf16_t* khp = (LAS bf16_t*)(lds + O_KH) + (8 * c8) * 72 + j;
      LAS bf16_t* vtp = (LAS bf16_t*)(lds + O_VT) + (8 * c8) * 72 + j;
      const unsigned vw[4] = {ri.x, ri.y, ri.z, ri.w};
#pragma unroll
      for (int i = 0; i < 8; ++i) { khp[i * 72] = f2bf(kh[i]); vtp[i * 72] = (bf16_t)((i & 1) ? (vw[i >> 1] >> 16) : (vw[i >> 1] & 0xffffu)); }
      if (j == 0) { float* dlp = DLg + ((size_t)((bl * 8 + h) * 128 + c)) * 64 + 8 * c8;
          *(GAS f32x4*)dlp = (f32x4){ex2(tot[0]), ex2(tot[1]), ex2(tot[2]), ex2(tot[3])}; *(GAS f32x4*)(dlp + 4) = (f32x4){ex2(tot[4]), ex2(tot[5]), ex2(tot[6]), ex2(tot[7])}; } }
    }
    __syncthreads();
#pragma unroll
    for (int ch = 0; ch < 2; ++ch) { LAS unsigned char* lds = ldsb + ch * XCH; const size_t rb = rb0 + ch * 64; const int c = 2 * cp + ch; (void)c; (void)rb;
      LAS float* LF = (LAS float*)(lds + O_LF); LAS float* SEG = (LAS float*)(lds + O_SEG); (void)SEG; (void)LF;
      bf16_t* base = P + (rb + j) * 4096 + h * 64 + 8 * c8; (void)base;
      const u32x4 rq = rqa[ch], rf = rfa[ch], ri = ria[ch]; (void)rq; (void)rf; (void)ri;
      float (&kk)[8] = kka[ch];
    if (w < 4) {
        const int I = w >> 1, DV = w & 1;
        f32x16 o;
#pragma unroll
        for (int r = 0; r < 16; ++r) o[r] = 0.f;
        for (int J = 0; J <= I; ++J) {
            f32x16 p;
#pragma unroll
            for (int r = 0; r < 16; ++r) p[r] = 0.f;
#pragma unroll
            for (int ks = 0; ks < 4; ++ks) { const bf16x8 a = *(const LAS bf16x8*)(lds + O_KT + (32 * J + r32) * RP + (16 * ks + 8 * hi) * 2);
                const bf16x8 b = *(const LAS bf16x8*)(lds + O_QT + (32 * I + r32) * RP + (16 * ks + 8 * hi) * 2); p = MFMA32(a, b, p); }
            if (J == I) {
#pragma unroll
                for (int r = 0; r < 16; ++r) if (crow(r, hi) > r32) p[r] = 0.f;
            }
#pragma unroll
            for (int k2 = 0; k2 < 2; ++k2) {
                u32x4 pw;
                if (k2 == 0) pw = (u32x4){pk2(p[0], p[1]), pk2(p[2], p[3]), pk2(p[4], p[5]), pk2(p[6], p[7])};
                else pw = (u32x4){pk2(p[8], p[9]), pk2(p[10], p[11]), pk2(p[12], p[13]), pk2(p[14], p[15])};
                const LAS unsigned char* vp = lds + O_VT + (32 * DV + r32) * RP + (32 * J + 16 * k2 + 4 * hi) * 2;
                const u32x2 lo = *(const LAS u32x2*)vp, h2 = *(const LAS u32x2*)(vp + 16);
                const u32x4 vw4 = (u32x4){lo.x, lo.y, h2.x, h2.y};
                o = MFMA32(__builtin_bit_cast(bf16x8, pw), __builtin_bit_cast(bf16x8, vw4), o);
            }
        }
        GAS bf16_t* op = (GAS bf16_t*)(P + (rb + 32 * I) * 4096 + 2048 + h * 64 + 32 * DV + r32);
#pragma unroll
        for (int r = 0; r < 16; ++r) op[(size_t)crow(r, hi) * 4096] = f2bf(o[r]);
    } else {
        const int ww = w - 4, Dt = ww >> 1, DV = ww & 1;
        f32x16 zt;
#pragma unroll
        for (int r = 0; r < 16; ++r) zt[r] = 0.f;
#pragma unroll
        for (int ks = 0; ks < 4; ++ks) { const bf16x8 a = *(const LAS bf16x8*)(lds + O_VT + (32 * DV + r32) * RP + (16 * ks + 8 * hi) * 2);
            const bf16x8 b = *(const LAS bf16x8*)(lds + O_KH + (32 * Dt + r32) * RP + (16 * ks + 8 * hi) * 2); zt = MFMA32(a, b, zt); }
        GAS bf16_t* zp = (GAS bf16_t*)(P + (rb + 32 * DV) * 4096 + 2560 + h * 64 + 32 * Dt + r32);
#pragma unroll
        for (int r = 0; r < 16; ++r) zp[(size_t)crow(r, hi) * 4096] = f2bf(zt[r]);
    }
    }
    __syncthreads();
}
__device__ __forceinline__ void hgrn_scan(bf16_t* P, const float* DLg, int slice, int wv_) {
    OPAQUE_TID(tid);
    const int chain = slice >> 3, bl = chain >> 3, h = chain & 7, dv = 8 * (slice & 7) + (tid >> 6), d = tid & 63;
    GAS bf16_t* p = (GAS bf16_t*)(P + ((size_t)bl * SEQ + dv) * 4096 + 2560 + h * 64 + d);
    const GAS float* dl = (const GAS float*)(DLg + (size_t)chain * 128 * 64 + d);
    float s = 0.f;
#pragma unroll 1
    for (int c0 = 0; c0 < 128; c0 += 16) {
        bf16_t z[16]; float e[16];
#pragma unroll
        for (int k = 0; k < 16; ++k) { z[k] = p[(size_t)(c0 + k) * 64 * 4096]; e[k] = dl[(c0 + k) * 64]; }
#pragma unroll
        for (int k = 0; k < 16; ++k) { s = e[k] * s + __uint_as_float((unsigned)z[k] << 16); p[(size_t)(c0 + k) * 64 * 4096] = f2bf(s); }
    }
}
__device__ __forceinline__ void hgrn_z_unit(const bf16_t* P, const float* ng, bf16_t* Y, int bl, int h, int cp, LAS unsigned char* lds, int wv_) {
    OPAQUE_TID(tid);
    const int lane = tid & 63, w = __builtin_amdgcn_readfirstlane(tid >> 6), r32 = lane & 31, hi = lane >> 5;
    const size_t rb = (size_t)bl * SEQ;
    LAS float* OB = (LAS float*)lds;
    { const int cw = 2 * cp + (w >> 2), I = (w >> 1) & 1, DV = w & 1;
      f32x16 o;
#pragma unroll
      for (int r = 0; r < 16; ++r) o[r] = 0.f;
      if (cw > 0) {
          const bf16_t* ap = P + (rb + (size_t)cw * 64 + 32 * I + r32) * 4096 + 1536 + h * 64 + 8 * hi;
          const bf16_t* bp = P + (rb + (size_t)(cw - 1) * 64 + 32 * DV + r32) * 4096 + 2560 + h * 64 + 8 * hi;
#pragma unroll
          for (int ks = 0; ks < 4; ++ks) { const bf16x8 a = *(const GAS bf16x8*)(ap + 16 * ks), b = *(const GAS bf16x8*)(bp + 16 * ks); o = MFMA32(a, b, o); }
      }
#pragma unroll
      for (int r = 0; r < 16; ++r) OB[((w >> 2) * 64 + 32 * I + crow(r, hi)) * 68 + 32 * DV + r32] = o[r]; }
    __syncthreads();
    const int c8 = tid & 7;
    float ngv[8];
#pragma unroll
    for (int i = 0; i < 8; ++i) ngv[i] = ((const GAS float*)ng)[8 * c8 + i];
#pragma unroll
    for (int it = 0; it < 2; ++it) {
        const int row = it * 64 + (tid >> 3);
        const bf16_t* pr = P + (rb + (size_t)cp * 128 + row) * 4096 + h * 64 + 8 * c8;
        const u32x4 oi = *(const GAS u32x4*)(pr + 2048), rg = *(const GAS u32x4*)(pr + 3072);
        const f32x4 a = *(const LAS f32x4*)(OB + row * 68 + 8 * c8), b = *(const LAS f32x4*)(OB + row * 68 + 8 * c8 + 4);
        const float ov[8] = {a.x + bflo(oi.x), a.y + bfhi(oi.x), a.z + bflo(oi.y), a.w + bfhi(oi.y), b.x + bflo(oi.z), b.y + bfhi(oi.z), b.z + bflo(oi.w), b.w + bfhi(oi.w)};
        float ss = 0.f;
#pragma unroll
        for (int i = 0; i < 8; ++i) ss += ov[i] * ov[i];
        ss += shx(ss, 1, lane); ss += shx(ss, 2, lane); ss += shx(ss, 4, lane);
        const float r = 1.0f / sqrtf(ss * (1.0f / 64.0f) + EPS);
        const float gr[8] = {bflo(rg.x), bfhi(rg.x), bflo(rg.y), bfhi(rg.y), bflo(rg.z), bfhi(rg.z), bflo(rg.w), bfhi(rg.w)};
        float ou[8];
#pragma unroll
        for (int i = 0; i < 8; ++i) ou[i] = ov[i] * r * ngv[i] * (gr[i] * sigm(gr[i]));
        *(GAS u32x4*)(Y + (rb + (size_t)cp * 128 + row) * 1536 + 512 + h * 64 + 8 * c8) = (u32x4){pk2(ou[0], ou[1]), pk2(ou[2], ou[3]), pk2(ou[4], ou[5]), pk2(ou[6], ou[7])};
    }
    __syncthreads();
}

__device__ __forceinline__ void tr_item(const float* W, int ldw, int k0, int nsrc0, bf16_t* WT, int ldt, int nrow0, LAS float* scr, int lane, bool zero, const float* gk = nullptr) {
    if (!zero) {
        float wvv[32];
#pragma unroll
        for (int i = 0; i < 32; ++i) { const int kk = 2 * i + (lane >> 5); wvv[i] = ((const GAS float*)W)[(size_t)(k0 + kk) * ldw + nsrc0 + (lane & 31)]; }
        if (gk) {
#pragma unroll
            for (int i = 0; i < 32; ++i) wvv[i] *= ((const GAS float*)gk)[k0 + 2 * i + (lane >> 5)];
        }
#pragma unroll
        for (int i = 0; i < 32; ++i) scr[(2 * i + (lane >> 5)) * 33 + (lane & 31)] = wvv[i];
    }
    LDS_WAIT();
    const int c = lane & 7;
#pragma unroll
    for (int jj = 0; jj < 4; ++jj) { const int n = (lane >> 3) + 8 * jj; const LAS float* s = scr + (8 * c) * 33 + n;
        u32x4 o = (u32x4){0u, 0u, 0u, 0u};
        if (!zero) { o.x = pk2(s[0 * 33], s[1 * 33]); o.y = pk2(s[2 * 33], s[3 * 33]); o.z = pk2(s[4 * 33], s[5 * 33]); o.w = pk2(s[6 * 33], s[7 * 33]); }
        *(GAS u32x4*)(WT + (size_t)(nrow0 + n) * ldt + k0 + 8 * c) = o; }
    LDS_WAIT();
}

#define XB_TMO      128
#define XB_XCNT(j)  (256  + 64 * (j))
#define XB_XSUB(j)  (1280 + 64 * (j))
#define XB_XGEN(j)  (2304 + 64 * (j))
#define XB_TOP      3328
#define XB_TOPGEN   3392
#define XCD_BAR_WORDS 3456
#define XB_SPIN_CAP (1u << 18)
__device__ __forceinline__ unsigned xb_ld(unsigned* p)              { return __hip_atomic_load(p, __ATOMIC_RELAXED, __HIP_MEMORY_SCOPE_AGENT); }
__device__ __forceinline__ unsigned xb_add(unsigned* p, unsigned v) { return __hip_atomic_fetch_add(p, v, __ATOMIC_RELAXED, __HIP_MEMORY_SCOPE_AGENT); }
__device__ __forceinline__ unsigned xb_xcc_id() { return (unsigned)__builtin_amdgcn_s_getreg((3 << 11) | 20) & 0xFu; }
#define XB_SPIN(cond, bar) do { unsigned _sp = 0; while (cond) { __builtin_amdgcn_s_sleep(1); \
    if ((++_sp & 255u) == 0u) { if (xb_ld(&(bar)[XB_TMO])) break; if (_sp > XB_SPIN_CAP) { atomicAdd(&(bar)[XB_TMO], 1u); break; } } } } while (0)
struct XcdBarrier { unsigned* bar; unsigned x; volatile LAS unsigned* st; };
__device__ __forceinline__ void xcd_barrier_complete(unsigned* bar, unsigned x, unsigned& nloc, unsigned& nx) {
    const unsigned G = gridDim.x * gridDim.y * gridDim.z;
    unsigned sum, cnt, mine, sp = 0u;
    for (;;) {
        sum = 0u; cnt = 0u; mine = 0u;
#pragma unroll
        for (unsigned j = 0; j < 16; ++j) { const unsigned c = xb_ld(&bar[XB_XCNT(j)]); sum += c; cnt += (c > 0u) ? 1u : 0u; mine = (j == x) ? c : mine; }
        if (sum == G) break;
        __builtin_amdgcn_s_sleep(1);
        if ((++sp & 255u) == 0u) { if (xb_ld(&bar[XB_TMO])) break; if (sp > XB_SPIN_CAP) { atomicAdd(&bar[XB_TMO], 1u); break; } }
    }
    nloc = mine > 0u ? mine : 1u; nx = cnt > 0u ? cnt : 1u;
}
__device__ __forceinline__ void xcd_barrier(const XcdBarrier& b, int wv_) {
    asm volatile("s_waitcnt vmcnt(0)" ::: "memory");
    __syncthreads();
    OPAQUE_TID(xtid);
    if (xtid == 0) {
        unsigned* bar = b.bar;
        __builtin_amdgcn_s_waitcnt(0);
        unsigned nloc = b.st[0], nx = b.st[1];
        if (nloc == 0u) { xcd_barrier_complete(bar, b.x, nloc, nx); b.st[0] = nloc; b.st[1] = nx; }
        const unsigned old = xb_add(&bar[XB_XSUB(b.x)], 1u);
        const unsigned gen = old / nloc;
        if (old + 1u == (gen + 1u) * nloc) {
            __builtin_amdgcn_fence(__ATOMIC_RELEASE, "agent");
            asm volatile("s_waitcnt vmcnt(0)" ::: "memory");
            const unsigned og = xb_add(&bar[XB_TOP], 1u);
            const unsigned tg = og / nx;
            if (og + 1u == (tg + 1u) * nx) xb_add(&bar[XB_TOPGEN], 1u);
            else XB_SPIN(xb_ld(&bar[XB_TOPGEN]) == tg, bar);
            __builtin_amdgcn_fence(__ATOMIC_ACQUIRE, "agent");
            xb_add(&bar[XB_XGEN(b.x)], 1u);
            asm volatile("s_waitcnt vmcnt(0)" ::: "memory");
        } else {
            XB_SPIN(xb_ld(&bar[XB_XGEN(b.x)]) == gen, bar);
            __builtin_amdgcn_fence(__ATOMIC_ACQUIRE, "agent");
            asm volatile("s_waitcnt vmcnt(0)" ::: "memory");
        }
    }
    __syncthreads();
}

#ifndef PROBE_TS
#define PROBE_TS 0
#endif
#if PROBE_TS
#define STAMP(ty) do { OPAQUE_TID(ts_tid_); if (blockIdx.x == 0 && ts_tid_ == 0) { LAS unsigned long long* tsl = (LAS unsigned long long*)(lds + 131088); const unsigned long long now_ = __builtin_amdgcn_s_memrealtime(); \
        if ((PROBE_TS >> (ty)) & 1) tsl[1] += now_ - tsl[0]; tsl[0] = now_; } } while (0)
#else
#define STAMP(ty) do {} while (0)
#endif
struct Args { const float* in[17]; float* out; unsigned char* ws; };

__global__ void __launch_bounds__(512, 2) fwd_kernel(Args a) {
    extern __shared__ __attribute__((aligned(16))) unsigned char lds_raw[];
    cg::grid_group grid = cg::this_grid();
    LAS unsigned char* lds = (LAS unsigned char*)lds_raw;
    const int G = gridDim.x, NGW = G * 8;
    const int wv_ = __builtin_amdgcn_readfirstlane((int)threadIdx.x >> 6);
#if PROBE_TS
    { OPAQUE_TID(t0_); if (blockIdx.x == 0 && t0_ == 0) { LAS unsigned long long* tsl = (LAS unsigned long long*)(lds + 131088); tsl[0] = __builtin_amdgcn_s_memrealtime(); tsl[1] = 0ull; } }
#endif
    typedef const __attribute__((address_space(4))) Args* KArgs;
#define KARGS(name) KArgs name = (KArgs)__builtin_amdgcn_kernarg_segment_ptr(); asm volatile("" : "+s"(name))
    XcdBarrier xb;
    { KARGS(kb); OPAQUE_TID(t0b); volatile LAS unsigned* st = (volatile LAS unsigned*)(lds + 131136);
      if (t0b == 0) { st[0] = 0u; st[1] = 0u; }
      __syncthreads();
      xb.bar = (unsigned*)(GAS unsigned*)(as_global(kb->ws) + WS_CTL) + 8192; xb.x = xb_xcc_id(); xb.st = st;
      if (t0b == 0) (void)xb_add(&xb.bar[XB_XCNT(xb.x)], 1u); }
#define GSYNC() xcd_barrier(xb, wv_)
    {
        KARGS(ka);
        unsigned char* ws = as_global(ka->ws);
        OPAQUE_TID(tid); const int lane = tid & 63, wave = __builtin_amdgcn_readfirstlane(tid >> 6), gw = blockIdx.x * 8 + wave;
        LAS float* scr = (LAS float*)(lds + wave * 16384);
        constexpr int I_IN = 16 * 224, I_BR = 768, I_OUT = 512, I_F1 = 2048, I_F2 = 2048, I_L = I_IN + I_BR + I_OUT + I_F1 + I_F2;
        for (int it = gw; it < 2 * I_L; it += NGW) {
            const int l = it / I_L; int r = it % I_L;
            unsigned char* wl = ws + WS_W + (size_t)l * W_LAYER_REAL;
            if (r < I_IN) { const int kb = r / 224, nb = r % 224, n0 = 32 * nb; const bool zero = (n0 >= 4000 && n0 < 4096); const int ns = n0 < 4000 ? n0 : n0 - 96;
                tr_item(as_global(ka->in[3]) + (size_t)l * 1024 * 7072, 7072, 64 * kb, zero ? 0 : ns, (bf16_t*)(wl + WO_IN), 1024, n0, scr, lane, zero, as_global(ka->in[2]) + l * 1024); continue; }
            r -= I_IN;
            if (r < I_BR) { const int z = r / 256, rr = r % 256, kb = rr / 32, nb = rr % 32;
                tr_item(as_global(ka->in[11]) + ((size_t)l * 3 + z) * 512 * 1024, 1024, 64 * kb, 32 * nb, (bf16_t*)(wl + WO_BR) + (size_t)z * 1024 * 512, 512, 32 * nb, scr, lane, false); continue; }
            r -= I_BR;
            if (r < I_OUT) { const int kb = r / 32, nb = r % 32; tr_item(as_global(ka->in[12]) + (size_t)l * 1024 * 1024, 1024, 64 * kb, 32 * nb, (bf16_t*)(wl + WO_OUT), 1024, 32 * nb, scr, lane, false); continue; }
            r -= I_OUT;
            if (r < I_F1) { const int kb = r / 128, nb = r % 128; tr_item(as_global(ka->in[14]) + (size_t)l * 1024 * 4096, 4096, 64 * kb, 32 * nb, (bf16_t*)(wl + WO_F1), 1024, 32 * nb, scr, lane, false, as_global(ka->in[13]) + l * 1024); continue; }
            r -= I_F1;
            { const int kb = r / 32, nb = r % 32; tr_item(as_global(ka->in[15]) + (size_t)l * 4096 * 1024, 1024, 64 * kb, 32 * nb, (bf16_t*)(wl + WO_F2), 4096, 32 * nb, scr, lane, false); }
        }
        rows_bf16_ssq(as_global(ka->in[0]), (bf16_t*)(ws + WS_XN), (float*)(ws + WS_SS), MTOT, NGW, wv_);
        for (int i = blockIdx.x * 512 + tid; i < 4 * MTOT; i += G * 512) ((GAS float*)(ws + WS_SS))[MTOT + i] = 0.f;
        const int gt = blockIdx.x * 512 + tid, GT_ = G * 512;
        for (int idx = gt; idx < 2 * 86016; idx += GT_) {
            const int l = idx / 86016; int r = idx % 86016;
            unsigned char* wl = ws + WS_W + (size_t)l * W_LAYER_REAL;
            const GAS float* wuq = (const GAS float*)(ka->in[9] + (size_t)l * 256 * 768); const GAS float* wukv = (const GAS float*)(ka->in[10] + (size_t)l * 128 * 1024);
            float v[8]; bf16_t* dst;
            if (r < 61440) { const int n = r % 1280, kc = r / 1280; dst = (bf16_t*)(wl + WO_QK) + (size_t)n * 384 + 8 * kc;
#pragma unroll
                for (int i = 0; i < 8; ++i) { const int k = 8 * kc + i;
                    v[i] = (n < 768) ? (k < 256 ? wuq[(size_t)k * 768 + n] : 0.f) : (k >= 256 ? wukv[(size_t)(k - 256) * 1024 + ((n - 768) >> 6) * 128 + ((n - 768) & 63)] : 0.f); }
            } else { r -= 61440; const int n = r % 512, kc = r / 512; dst = (bf16_t*)(wl + WO_V) + (size_t)n * 384 + 8 * kc;
#pragma unroll
                for (int i = 0; i < 8; ++i) { const int k = 8 * kc + i; v[i] = (k >= 256) ? wukv[(size_t)(k - 256) * 1024 + (n >> 6) * 128 + 64 + (n & 63)] : 0.f; }
            }
            *(GAS u32x4*)dst = (u32x4){pk2(v[0], v[1]), pk2(v[2], v[3]), pk2(v[4], v[5]), pk2(v[6], v[7])};
        }
    }
    grid.sync(); STAMP(10);

#pragma unroll 1
    for (int l = 0; l < 2; ++l) {
#define WPTR(base, off) ((const bf16_t*)((base) + WS_W + (size_t)l * W_LAYER_REAL + (off)))
#pragma unroll 1
        for (int hf = 0; hf < 2; ++hf) {
            const size_t R0 = (size_t)hf * MH;
            KARGS(ka);
            unsigned char* wsq_ = ka->ws; asm volatile("" : "+s"(wsq_)); unsigned char* wsq = as_global(wsq_);
#define ctl ((unsigned*)(wsq + WS_CTL))
#define XN ((bf16_t*)(wsq + WS_XN))
#define SSQ(i) ((float*)(wsq + WS_SS) + (size_t)(i) * MTOT)
#define CS ((float*)(wsq + WS_CS))
#define P ((bf16_t*)(wsq + WS_P))
#define GT ((bf16_t*)(wsq + WS_G))
#define Q ((bf16_t*)(wsq + WS_Q))
#define KN ((bf16_t*)(wsq + WS_KN))
#define VT ((bf16_t*)(wsq + WS_VT))
#define Y ((bf16_t*)(wsq + WS_Y))
#define MG ((bf16_t*)(wsq + WS_MG))
            { pg8::Gemm g{XN + R0 * DM, WPTR(wsq, WO_IN), MH, NIN, DM, DM, DM, 0, 0}; pg8::StaticOrder S; S.init(MH, NIN, G, (int)blockIdx.x);
              pg8::EpiSplit<0, 1> E{P, 4096, 16, GT, 3072, SSQ(2 * l) + R0};
              pg8::gemm_phase(lds, g, S, E, wv_); }
            GSYNC(); STAMP(1);
            mla_prep(P, (const int*)as_global(ka->in[1]) + R0, as_global(ka->in[7]) + l * 256, as_global(ka->in[8]) + l * 128, CS, NGW, wv_);
            { OPAQUE_TID(xt);
#define XLOAD(u_, q_, f_, i_) do { _Pragma("unroll") for (int ch_ = 0; ch_ < 2; ++ch_) { const bf16_t* xb_ = P + ((size_t)((u_) >> 9) * SEQ + (size_t)((u_) & 63) * 128 + ch_ * 64 + (xt >> 3)) * 4096 + (((u_) >> 6) & 7) * 64 + 8 * (xt & 7); \
                q_[ch_] = *(const GAS u32x4*)(xb_ + 1536); f_[ch_] = *(const GAS u32x4*)(xb_ + 2048); i_[ch_] = *(const GAS u32x4*)(xb_ + 2560); } } while (0)
              u32x4 nq[2], nf[2], ni[2];
#pragma unroll
              for (int ch_ = 0; ch_ < 2; ++ch_) { nq[ch_] = (u32x4){0u, 0u, 0u, 0u}; nf[ch_] = nq[ch_]; ni[ch_] = nq[ch_]; }
              if ((int)blockIdx.x < 1024) XLOAD((int)blockIdx.x, nq, nf, ni);
              for (int u = blockIdx.x; u < 1024; u += G) {
                  const u32x4 cq[2] = {nq[0], nq[1]}, cf[2] = {nf[0], nf[1]}, ci[2] = {ni[0], ni[1]};
                  if (u + G < 1024) XLOAD(u + G, nq, nf, ni);
                  hgrn_x_unit(P, as_global(ka->in[5]), (float*)(wsq + WS_DL), l, u >> 9, (u >> 6) & 7, u & 63, lds, wv_, cq, cf, ci);
              }
#undef XLOAD
            }
            GSYNC(); STAMP(2);
            { pg8::Gemm g{P + 3584, WPTR(wsq, WO_QK), MH, 1280, 384, 4096, 384, 0, 0}; pg8::StaticOrder S; S.init(MH, 1280, G, (int)blockIdx.x);
              pg8::EpiSplit<0, 0> E{Q, 768, 3, KN, 512, nullptr};
              pg8::gemm_phase(lds, g, S, E, wv_); }
            { pg8::Gemm g{WPTR(wsq, WO_V), P + 3584, 512, MH, 384, 384, 4096, 0, 0}; pg8::StaticOrder S; S.init(512, MH, G, (int)blockIdx.x);
              pg8::EpiSplit<0, 0> E{VT, MH, 1 << 30, VT, MH, nullptr};
              pg8::gemm_phase(lds, g, S, E, wv_); }
            for (int sl = G - 1 - (int)blockIdx.x; sl < 128; sl += G) hgrn_scan(P, (const float*)(wsq + WS_DL), sl, wv_);
            GSYNC(); STAMP(3);
#ifndef PROBE_RUN
#define PROBE_RUN 0
#endif
#define PH4_BODY(RUN, CTR) { \
                OPAQUE_TID(tid); \
                LAS int* slot = (LAS int*)(lds + 131072); \
                for (int qi = 0; qi < 8; ++qi) { \
                    const int q = ((int)blockIdx.x + qi) & 7;            \
                    unsigned* ctr = (CTR) + 64 * q; \
                    for (;;) { \
                        if (tid == 0) slot[0] = (int)__hip_atomic_fetch_add((GAS unsigned*)ctr, 1u, __ATOMIC_RELAXED, __HIP_MEMORY_SCOPE_AGENT); \
                        __syncthreads(); \
                        const int item = __builtin_amdgcn_readfirstlane(slot[0]); \
                        __syncthreads(); \
                        if (item >= 256) break; \
                        const int bh = 2 * q + (item & 1), kq = (item & 63) >> 1; \
                        if (item < 64) { if ((RUN) & 2) mla_unit(Q, KN, P + 3968, VT, CS, Y, bh >> 3, bh & 7, 31 - kq, lds, wv_); } \
                        else if (item < 128) { if ((RUN) & 4) bandattn_unit(P, as_global(ka->in[4]) + ((size_t)l * 8 + (bh & 7)) * 257, Y, bh >> 3, bh & 7, kq, lds, wv_); } \
                        else { if ((RUN) & 1) hgrn_z_unit(P, as_global(ka->in[6]) + l * 64, Y, bh >> 3, bh & 7, (item - 128) >> 1, lds, wv_); } \
                    } \
                } \
                GSYNC(); STAMP(4); }
            PH4_BODY(7, ctl + 1024 * (l * 2 + hf))
#if PROBE_RUN
            PH4_BODY(PROBE_RUN, ctl + 1024 * (l * 2 + hf) + 512)
#endif
            { pg8::Gemm g{Y, WPTR(wsq, WO_BR), MH, 1024, 512, 1536, 512, (size_t)512 * 2, (size_t)1024 * 512 * 2}; pg8::BranchOrder S{G, (int)blockIdx.x};
              pg8::EpiBranch E{GT, MG};
              pg8::gemm_phase(lds, g, S, E, wv_); }
            GSYNC(); STAMP(5);
            { pg8::Gemm g{MG, WPTR(wsq, WO_OUT), MH, DM, DM, DM, DM, 0, 0}; pg8::StaticOrder S; S.init(MH, DM, G, (int)blockIdx.x);
              pg8::EpiResid E{((l == 0) ? as_global(ka->in[0]) : as_global(ka->out)) + R0 * DM, as_global(ka->out) + R0 * DM, XN + R0 * DM, SSQ(2 * l + 1) + R0};
              pg8::gemm_phase(lds, g, S, E, wv_); }
            GSYNC(); STAMP(6);
        }
#undef ctl
#undef XN
#undef SSQ
#undef CS
#undef P
#undef GT
#undef Q
#undef KN
#undef VT
#undef Y
#undef MG
        KARGS(kf); { KArgs ka = kf;
        unsigned char* wsf_ = ka->ws; asm volatile("" : "+s"(wsf_)); unsigned char* wsf = as_global(wsf_);
        bf16_t* XN = (bf16_t*)(wsf + WS_XN); bf16_t* HB = (bf16_t*)(wsf + WS_H);
        { pg8::Gemm g{XN, WPTR(wsf, WO_F1), MTOT, FF, DM, DM, DM, 0, 0}; pg8::StaticOrder S; S.init(MTOT, FF, G, (int)blockIdx.x);
          pg8::EpiSplit<2, 2> E{HB, FF, 1 << 30, HB, FF, (const float*)(wsf + WS_SS) + (size_t)(2 * l + 1) * MTOT};
          pg8::gemm_phase(lds, g, S, E, wv_); }
        GSYNC(); STAMP(8);
        { pg8::Gemm g{HB, WPTR(wsf, WO_F2), MTOT, DM, FF, FF, FF, 0, 0}; pg8::StaticOrder S; S.init(MTOT, DM, G, (int)blockIdx.x);
          pg8::EpiResid E{as_global(ka->out), as_global(ka->out), XN, (float*)(wsf + WS_SS) + (size_t)(2 * l + 2) * MTOT};
          pg8::gemm_phase(lds, g, S, E, wv_); }
        GSYNC(); STAMP(9); }
    }
#ifdef PROBE_SYNCS
#pragma unroll 1
    for (int i_ = 0; i_ < PROBE_SYNCS; ++i_) GSYNC();
#endif
    KARGS(kz);
    final_norm(as_global(kz->out), as_global(kz->in[16]), (const float*)(as_global(kz->ws) + WS_SS) + (size_t)4 * MTOT, G, wv_);
#if PROBE_TS
    { OPAQUE_TID(t1_); if (blockIdx.x == 0 && t1_ == 0) { LAS unsigned long long* tsl = (LAS unsigned long long*)(lds + 131088); unsigned long long now_ = __builtin_amdgcn_s_memrealtime(); if ((PROBE_TS >> 11) & 1) tsl[1] += now_ - tsl[0];
        const unsigned long long until = now_ + tsl[1]; while (__builtin_amdgcn_s_memrealtime() < until) __builtin_amdgcn_s_sleep(8); } }
#endif
}

extern "C" void kernel_launch(void* const* d_in, const int* in_sizes, int n_in, void* d_out, int out_size, void* d_ws, size_t ws_size, hipStream_t stream) {
    static int grid = 0;
    if (grid == 0) {
        int dev = 0, cus = 0, per_cu = 0;
        (void)hipGetDevice(&dev);
        (void)hipDeviceGetAttribute(&cus, hipDeviceAttributeMultiprocessorCount, dev);
        (void)hipFuncSetAttribute((const void*)fwd_kernel, hipFuncAttributeMaxDynamicSharedMemorySize, LDS_BYTES);
        (void)hipOccupancyMaxActiveBlocksPerMultiprocessor(&per_cu, (const void*)fwd_kernel, 512, LDS_BYTES);
        (void)per_cu;
        grid = cus;
        if (ws_size < (size_t)504 * MiB) fprintf(stderr, "kernel_launch: workspace too small (%zu)\n", ws_size);
    }
    (void)hipMemsetAsync((char*)d_ws + WS_CTL, 0, 65536, stream);
    Args a{};
    for (int i = 0; i < 17; ++i) a.in[i] = (const float*)d_in[i];
    a.out = (float*)d_out; a.ws = (unsigned char*)d_ws;
    void* args[] = {&a};
    hipError_t e = hipLaunchCooperativeKernel((void*)fwd_kernel, dim3(grid), dim3(512), args, LDS_BYTES, stream);
    if (e != hipSuccess) fprintf(stderr, "cooperative launch failed: %s (grid %d)\n", hipGetErrorString(e), grid);
}
```

```cpp
#include <hip/hip_runtime.h>
#include <hip/hip_cooperative_groups.h>
#include <cstdio>
#include <cstdint>
namespace cg = cooperative_groups;

#define LAS __attribute__((address_space(3)))
#define GAS __attribute__((address_space(1)))
typedef unsigned short bf16_t;
typedef short bf16x8 __attribute__((ext_vector_type(8)));
typedef float f32x4 __attribute__((ext_vector_type(4)));
typedef float f32x16 __attribute__((ext_vector_type(16)));
typedef unsigned u32x4 __attribute__((ext_vector_type(4)));
typedef unsigned u32x2 __attribute__((ext_vector_type(2)));
typedef float f32x2_t __attribute__((ext_vector_type(2)));
typedef __bf16 bf16x2_t __attribute__((ext_vector_type(2)));

__device__ __forceinline__ unsigned pk2(float lo, float hi) { f32x2_t v = {lo, hi}; bf16x2_t b = __builtin_convertvector(v, bf16x2_t); return __builtin_bit_cast(unsigned, b); }
__device__ __forceinline__ bf16_t f2bf(float f) { return (bf16_t)(pk2(f, 0.f) & 0xffffu); }
__device__ __forceinline__ float bflo(unsigned w) { return __uint_as_float(w << 16); }
__device__ __forceinline__ float bfhi(unsigned w) { return __uint_as_float(w & 0xffff0000u); }
__device__ __forceinline__ float ex2(float x) { return __builtin_amdgcn_exp2f(x); }
__device__ __forceinline__ float sigm(float x) { return __builtin_amdgcn_rcpf(1.0f + ex2(-1.4426950408889634f * x)); }
__device__ __forceinline__ int crow(int r, int hi) { return (r & 3) + 8 * (r >> 2) + 4 * hi; }
__device__ __forceinline__ float shx(float v, int mask, int lane) { return __int_as_float(__builtin_amdgcn_ds_bpermute((lane ^ mask) << 2, __float_as_int(v))); }
__device__ __forceinline__ float wave_sum(float v, int lane) {
#pragma unroll
    for (int o = 1; o < 64; o <<= 1) v += shx(v, o, lane);
    return v;
}
template <class T> __device__ __forceinline__ T* as_global(T* p) { return (T*)(__attribute__((address_space(1))) T*)p; }
#define OPAQUE_TID(t) int t; asm volatile("v_mbcnt_lo_u32_b32 %0, -1, 0\n\tv_mbcnt_hi_u32_b32 %0, -1, %0\n\tv_lshl_add_u32 %0, %1, 6, %0" : "=&v"(t) : "s"(wv_))
#define LDS_WAIT() asm volatile("s_waitcnt lgkmcnt(0)" ::: "memory")
#define MFMA32(a, b, c) __builtin_amdgcn_mfma_f32_32x32x16_bf16((a), (b), (c), 0, 0, 0)

namespace pg8 {
constexpr int BM = 256, BK = 64, HALF = 128, HTB = HALF * BK * 2, STAGE_BYTES = 8 * HTB, NXCD = 8, WGM = 8;
__host__ __device__ __forceinline__ int lds_byte(int r, int c) { const int st = (r >> 4) * 2 + (c >> 5), rr = r & 15, cc = c & 31, ob = rr * 64 + cc * 2; return st * 1024 + (ob ^ (((ob >> 9) & 1) << 5)); }
__host__ __device__ __forceinline__ void stage_rc(int b, int& R, int& C) { const int st = b / 1024, sb = b % 1024, swz = sb ^ (((sb >> 9) & 1) << 5); R = (st >> 1) * 16 + swz / 64; C = (st & 1) * 32 + (swz % 64) / 2; }
__host__ __device__ __forceinline__ int perm32(int rho) { const int n = rho >> 4, i = rho & 15; return 8 * (i >> 2) + 4 * n + (i & 3); }

struct Unit { int pm, pn, z; };
struct Gemm { const bf16_t* A; const bf16_t* Bt; int M, N, K, lda, ldb; size_t za, zb; };

struct StaticOrder {
    int nM, nN, nwg, G, c;
    __device__ void init(int M, int N, int G_, int c_) { nM = M / BM; nN = N / BM; nwg = nM * nN; G = G_; c = c_; }
    __device__ bool next(int i, Unit& u) const {
        const long L = (long)i * G + c; if (L >= nwg) return false;
        int wgid = (int)L; { const int q = nwg / NXCD, r = nwg % NXCD, xcd = wgid % NXCD, off = wgid / NXCD; wgid = (xcd < r ? xcd * (q + 1) : r * (q + 1) + (xcd - r) * q) + off; }
        const int nig = WGM * nN, gid = wgid / nig, fm = gid * WGM, gsz = (nM - fm) < WGM ? (nM - fm) : WGM;
        u.pm = fm + ((wgid % nig) % gsz); u.pn = (wgid % nig) / gsz; u.z = 0; return true;
    }
};
struct BranchOrder {
    int G, c;
    __device__ bool next(int i, Unit& u) const {
        const int p = (i / 3) * G + c; if (p >= 256) return false;
        const int xcd = p & 7, off = p >> 3; u.pm = xcd * 8 + (off >> 2); u.pn = off & 3; u.z = i % 3; return true;
    }
};

template <int ACT0, int ACT1> struct EpiSplit {
    static constexpr bool PERM = true;
    bf16_t* O0; int ld0; int nsplit; bf16_t* O1; int ld1; const float* ss;
    __device__ __forceinline__ void operator()(const f32x4 (&acc)[2][2][4][2], const Unit& u, int wr, int wc, int fr, int fq) const {
        const bool first = u.pn < nsplit;
        bf16_t* base = first ? O0 : O1; const int ldc = first ? ld0 : ld1; const int colt = (first ? u.pn : u.pn - nsplit) * BM;
        const int act = first ? ACT0 : ACT1;
        const int row0 = u.pm * BM + wr * 64 + fr, col0 = colt + wc * 32 + 8 * fq;
#pragma unroll
        for (int ai = 0; ai < 2; ++ai)
#pragma unroll
            for (int m = 0; m < 4; ++m) { bf16_t* rowp = base + (size_t)(row0 + ai * HALF + m * 16) * ldc + col0;
                float rs = 1.0f; if (ss) rs = 1.0f / sqrtf(((const GAS float*)ss)[row0 + ai * HALF + m * 16] * (1.0f / 1024.0f) + 1e-6f);
#pragma unroll
                for (int bj = 0; bj < 2; ++bj) { f32x4 v0 = acc[ai][bj][m][0] * rs, v1 = acc[ai][bj][m][1] * rs;
                    if (act == 1) {
#pragma unroll
                        for (int e = 0; e < 4; ++e) { v0[e] = sigm(v0[e]); v1[e] = sigm(v1[e]); }
                    } else if (act == 2) {
#pragma unroll
                        for (int e = 0; e < 4; ++e) { const float a = fmaxf(v0[e], 0.f), b = fmaxf(v1[e], 0.f); v0[e] = a * a; v1[e] = b * b; }
                    }
                    u32x4 w; w.x = pk2(v0[0], v0[1]); w.y = pk2(v0[2], v0[3]); w.z = pk2(v1[0], v1[1]); w.w = pk2(v1[2], v1[3]);
                    *(GAS u32x4*)(rowp + bj * HALF) = w; } }
    }
};
struct EpiBranch {
    static constexpr bool PERM = true;
    const bf16_t* Gt; bf16_t* Mg;
    __device__ __forceinline__ void operator()(const f32x4 (&acc)[2][2][4][2], const Unit& u, int wr, int wc, int fr, int fq) const {
        const int row0 = u.pm * BM + wr * 64 + fr, col0 = u.pn * BM + wc * 32 + 8 * fq;
#pragma unroll
        for (int ai = 0; ai < 2; ++ai) {
            u32x4 g[2][4], pv[2][4];
#pragma unroll
            for (int bj = 0; bj < 2; ++bj)
#pragma unroll
                for (int m = 0; m < 4; ++m) { const size_t row = (size_t)(row0 + ai * HALF + m * 16);
                    g[bj][m] = *(const GAS u32x4*)(Gt + row * 3072 + u.z * 1024 + col0 + bj * HALF);
                    pv[bj][m] = (u32x4){0u, 0u, 0u, 0u}; if (u.z > 0) pv[bj][m] = *(const GAS u32x4*)(Mg + row * 1024 + col0 + bj * HALF); }
#pragma unroll
            for (int bj = 0; bj < 2; ++bj)
#pragma unroll
                for (int m = 0; m < 4; ++m) { const size_t row = (size_t)(row0 + ai * HALF + m * 16);
                    const f32x4 v0 = acc[ai][bj][m][0], v1 = acc[ai][bj][m][1]; const u32x4 gg = g[bj][m], pp = pv[bj][m];
                    float o[8];
                    o[0] = bflo(pp.x) + bflo(gg.x) * v0[0]; o[1] = bfhi(pp.x) + bfhi(gg.x) * v0[1]; o[2] = bflo(pp.y) + bflo(gg.y) * v0[2]; o[3] = bfhi(pp.y) + bfhi(gg.y) * v0[3];
                    o[4] = bflo(pp.z) + bflo(gg.z) * v1[0]; o[5] = bfhi(pp.z) + bfhi(gg.z) * v1[1]; o[6] = bflo(pp.w) + bflo(gg.w) * v1[2]; o[7] = bfhi(pp.w) + bfhi(gg.w) * v1[3];
                    u32x4 w; w.x = pk2(o[0], o[1]); w.y = pk2(o[2], o[3]); w.z = pk2(o[4], o[5]); w.w = pk2(o[6], o[7]);
                    *(GAS u32x4*)(Mg + row * 1024 + col0 + bj * HALF) = w; }
        }
    }
};
struct EpiResid {
    static constexpr bool PERM = true;
    const float* base; float* out; bf16_t* xb; float* ssq;
    __device__ __forceinline__ void operator()(const f32x4 (&acc)[2][2][4][2], const Unit& u, int wr, int wc, int fr, int fq) const {
        const int row0 = u.pm * BM + wr * 64 + fr, col0 = u.pn * BM + wc * 32 + 8 * fq, lane = fr + 16 * fq;
#pragma unroll
        for (int ai = 0; ai < 2; ++ai) {
            f32x4 b[4][2][2];
#pragma unroll
            for (int m = 0; m < 4; ++m) { const size_t off = (size_t)(row0 + ai * HALF + m * 16) * 1024 + col0;
#pragma unroll
                for (int bj = 0; bj < 2; ++bj) { b[m][bj][0] = *(const GAS f32x4*)(base + off + bj * HALF); b[m][bj][1] = *(const GAS f32x4*)(base + off + bj * HALF + 4); } }
#pragma unroll
            for (int m = 0; m < 4; ++m) { const int row = row0 + ai * HALF + m * 16; const size_t off = (size_t)row * 1024 + col0;
                float sq = 0.f;
#pragma unroll
                for (int bj = 0; bj < 2; ++bj) { const f32x4 o0 = b[m][bj][0] + acc[ai][bj][m][0], o1 = b[m][bj][1] + acc[ai][bj][m][1];
                    *(GAS f32x4*)(out + off + bj * HALF) = o0; *(GAS f32x4*)(out + off + bj * HALF + 4) = o1;
                    *(GAS u32x4*)(xb + off + bj * HALF) = (u32x4){pk2(o0[0], o0[1]), pk2(o0[2], o0[3]), pk2(o1[0], o1[1]), pk2(o1[2], o1[3])};
                    sq += (o0[0] * o0[0] + o0[1] * o0[1]) + (o0[2] * o0[2] + o0[3] * o0[3]) + (o1[0] * o1[0] + o1[1] * o1[1]) + (o1[2] * o1[2] + o1[3] * o1[3]); }
                sq += shx(sq, 16, lane); sq += shx(sq, 32, lane);
                if (fq == 0) __hip_atomic_fetch_add((GAS float*)(ssq + row), sq, __ATOMIC_RELAXED, __HIP_MEMORY_SCOPE_AGENT); }
        }
    }
};

template <class Epi, class Sched>
__device__ __forceinline__ void gemm_phase(LAS unsigned char* lds, const Gemm g, const Sched& S, const Epi& E, int wv_) {
    OPAQUE_TID(tid);
    const int wid = __builtin_amdgcn_readfirstlane(tid >> 6), lane = tid & 63, wr = wid >> 2, wc = wid & 3, fr = lane & 15, fq = lane >> 4;
    const int K = g.K, nt = K / BK;
    unsigned voffA[2], voffB[2];
#pragma unroll
    for (int i = 0; i < 2; ++i) { int R, C; stage_rc(tid * 16 + i * 8192, R, C); const int Rb = Epi::PERM ? ((R & ~31) + perm32(R & 31)) : R;
        voffA[i] = (unsigned)(R * g.lda + C) * 2u; voffB[i] = (unsigned)(Rb * g.ldb + C) * 2u; }
    const size_t kstep = (size_t)(BK * 2);
    const size_t hstepA = (size_t)HALF * g.lda * 2, hstepB = (size_t)HALF * g.ldb * 2;
    const size_t tstepA = 2 * hstepA, tstepB = 2 * hstepB;
    const unsigned ldsw = (unsigned)wid * 1024u;
    const int aoff = lds_byte(wr * 64 + fr, fq * 8), boff = lds_byte(wc * 32 + fr, fq * 8);
#define PG8_SA(b, h) (((b) * 2 + (h)) * HTB)
#define PG8_SB(b, h) ((4 + (b) * 2 + (h)) * HTB)
#define PG8_STAGE(bufoff, gbase, voff) do { _Pragma("unroll") for (int _i = 0; _i < 2; ++_i) { unsigned vo_ = (voff)[_i]; asm volatile("" : "+v"(vo_));     \
        __builtin_amdgcn_global_load_lds((const unsigned*)((const char*)(gbase) + vo_), (LAS unsigned*)(lds + (bufoff) + ldsw + _i * 8192), 16, 0, 0); } } while (0)
#define PG8_LDA(dst, b, h) do { _Pragma("unroll") for (int m = 0; m < 4; ++m) _Pragma("unroll") for (int k = 0; k < 2; ++k) dst[m][k] = *(const LAS bf16x8*)(lds + PG8_SA(b, h) + aoff + m * 2048 + k * 1024); } while (0)
#define PG8_LDB(dst, b, h) do { _Pragma("unroll") for (int n = 0; n < 2; ++n) _Pragma("unroll") for (int k = 0; k < 2; ++k) dst[n][k] = *(const LAS bf16x8*)(lds + PG8_SB(b, h) + boff + n * 2048 + k * 1024); } while (0)
#define PG8_MMA(ai, bj, At, Bt) do { __builtin_amdgcn_s_setprio(1); _Pragma("unroll") for (int m = 0; m < 4; ++m) _Pragma("unroll") for (int n = 0; n < 2; ++n) _Pragma("unroll") for (int k = 0; k < 2; ++k) \
        acc[ai][bj][m][n] = __builtin_amdgcn_mfma_f32_16x16x32_bf16(Bt[n][k], At[m][k], acc[ai][bj][m][n], 0, 0, 0); __builtin_amdgcn_s_setprio(0); } while (0)
#define PG8_WAIT_V(n) asm volatile("s_waitcnt vmcnt(" #n ")" ::: "memory")
#define PG8_WAIT_L(n) asm volatile("s_waitcnt lgkmcnt(" #n ")" ::: "memory")
#define PG8_BAR __builtin_amdgcn_s_barrier()
#define PG8_SCHED __builtin_amdgcn_sched_barrier(0)
    Unit cur, nxt; int ui = 0;
    if (!S.next(0, cur)) return;
    f32x4 acc[2][2][4][2];
#pragma unroll
    for (int a = 0; a < 2; ++a)
#pragma unroll
        for (int b = 0; b < 2; ++b)
#pragma unroll
            for (int m = 0; m < 4; ++m)
#pragma unroll
                for (int n = 0; n < 2; ++n) acc[a][b][m][n] = (f32x4){0.f, 0.f, 0.f, 0.f};
    bf16x8 At[4][2], B0[2][2], B1[2][2];
    const char* cA = (const char*)g.A + (size_t)cur.pm * tstepA + (size_t)cur.z * g.za; const char* cB = (const char*)g.Bt + (size_t)cur.pn * tstepB + (size_t)cur.z * g.zb;
    PG8_STAGE(PG8_SB(0, 0), cB, voffB); PG8_STAGE(PG8_SB(0, 1), cB + hstepB, voffB); PG8_STAGE(PG8_SA(0, 0), cA, voffA); PG8_STAGE(PG8_SA(0, 1), cA + hstepA, voffA);
    if (wr == 1) PG8_BAR;
    PG8_WAIT_V(2); PG8_BAR;
    PG8_STAGE(PG8_SB(1, 0), cB + kstep, voffB); PG8_STAGE(PG8_SA(1, 0), cA + kstep, voffA); PG8_STAGE(PG8_SB(1, 1), cB + hstepB + kstep, voffB);
    PG8_WAIT_V(6); PG8_BAR;
    for (;;) {
        const bool has_next = S.next(ui + 1, nxt);
        const char* nA = has_next ? (const char*)g.A + (size_t)nxt.pm * tstepA + (size_t)nxt.z * g.za : cA; const char* nB = has_next ? (const char*)g.Bt + (size_t)nxt.pn * tstepB + (size_t)nxt.z * g.zb : cB;
        for (int t = 0; t < nt; t += 2) {
            const bool last = (t == nt - 2);
            const char* a1 = cA + (size_t)(t + 1) * kstep;
            const char* a2 = last ? nA : cA + (size_t)(t + 2) * kstep; const char* b2 = last ? nB : cB + (size_t)(t + 2) * kstep;
            const char* a3 = a2 + kstep; const char* b3 = b2 + kstep;
            PG8_LDB(B0, 0, 0); PG8_LDB(B1, 0, 1); PG8_SCHED; PG8_LDA(At, 0, 0); PG8_STAGE(PG8_SA(1, 1), a1 + hstepA, voffA);
            PG8_WAIT_V(8); PG8_WAIT_L(0); PG8_BAR; PG8_MMA(0, 0, At, B0); PG8_MMA(0, 1, At, B1); PG8_BAR; PG8_SCHED;
            PG8_LDA(At, 0, 1); PG8_STAGE(PG8_SB(0, 0), b2, voffB); PG8_STAGE(PG8_SB(0, 1), b2 + hstepB, voffB); PG8_STAGE(PG8_SA(0, 0), a2, voffA);
            PG8_WAIT_V(8); PG8_WAIT_L(0); PG8_BAR; PG8_MMA(1, 0, At, B0); PG8_MMA(1, 1, At, B1); PG8_BAR; PG8_SCHED;
            PG8_LDB(B0, 1, 0); PG8_LDB(B1, 1, 1); PG8_SCHED; PG8_LDA(At, 1, 0); PG8_STAGE(PG8_SA(0, 1), a2 + hstepA, voffA);
            PG8_WAIT_V(8); PG8_WAIT_L(0); PG8_BAR; PG8_MMA(0, 0, At, B0); PG8_MMA(0, 1, At, B1); PG8_BAR; PG8_SCHED;
            PG8_LDA(At, 1, 1); PG8_STAGE(PG8_SB(1, 0), b3, voffB); PG8_STAGE(PG8_SB(1, 1), b3 + hstepB, voffB); PG8_STAGE(PG8_SA(1, 0), a3, voffA);
            PG8_WAIT_V(8); PG8_WAIT_L(0); PG8_BAR; PG8_MMA(1, 0, At, B0); PG8_MMA(1, 1, At, B1); PG8_BAR; PG8_SCHED;
        }
        if (wr == 0) PG8_BAR;
        { OPAQUE_TID(t2_); E(acc, cur, wr, wc, t2_ & 15, (t2_ >> 4) & 3); }
        if (!has_next) break;
#pragma unroll
        for (int a = 0; a < 2; ++a)
#pragma unroll
            for (int b = 0; b < 2; ++b)
#pragma unroll
                for (int m = 0; m < 4; ++m)
#pragma unroll
                    for (int n = 0; n < 2; ++n) acc[a][b][m][n] = (f32x4){0.f, 0.f, 0.f, 0.f};
        cur = nxt; cA = nA; cB = nB; ++ui;
        if (wr == 1) PG8_BAR;
    }
    PG8_WAIT_V(0);
    PG8_BAR;
#undef PG8_SA
#undef PG8_SB
#undef PG8_STAGE
#undef PG8_LDA
#undef PG8_LDB
#undef PG8_MMA
#undef PG8_WAIT_V
#undef PG8_WAIT_L
#undef PG8_BAR
#undef PG8_SCHED
}
}

constexpr int DM = 1024, SEQ = 8192, MTOT = 32768, MH = 16384, NIN = 7168, FF = 4096;
constexpr float EPS = 1e-6f, LOG2E = 1.4426950408889634f;
constexpr int LDS_BYTES = 147456;
constexpr size_t MiB = 1u << 20;
constexpr size_t WS_CTL = 0;
constexpr size_t WS_W = 1 * MiB, W_LAYER = 36 * MiB;
constexpr size_t WO_IN = 0, WO_QK = 14 * MiB, WO_V = 15 * MiB, WO_BR = 16 * MiB, WO_OUT = 19 * MiB, WO_F1 = 21 * MiB, WO_F2 = 29 * MiB;
constexpr size_t W_LAYER_REAL = 37 * MiB;
constexpr size_t WS_DL = 75 * MiB;
constexpr size_t WS_XN = 80 * MiB;
constexpr size_t WS_CS = 75 * MiB + 512 * 1024;
constexpr size_t WS_SS = 78 * MiB;
constexpr size_t WS_P = 144 * MiB;
constexpr size_t WS_G = 272 * MiB;
constexpr size_t WS_Q = 368 * MiB;
constexpr size_t WS_KN = 392 * MiB;
constexpr size_t WS_VT = 408 * MiB;
constexpr size_t WS_Y = 424 * MiB;
constexpr size_t WS_MG = 472 * MiB;
constexpr size_t WS_H = 144 * MiB;
static_assert(WS_W + 2 * W_LAYER_REAL <= WS_XN, "weights fit");

__device__ __forceinline__ void rows_bf16_ssq(const float* x, bf16_t* dst, float* ssq, int rows, int NGW, int wv_) {
    OPAQUE_TID(tid_); const int lane = tid_ & 63, gw = blockIdx.x * 8 + __builtin_amdgcn_readfirstlane(tid_ >> 6);
    for (int m0 = gw * 4; m0 < rows; m0 += NGW * 4) {
        f32x4 v[4][4];
#pragma unroll
        for (int q = 0; q < 4; ++q) { const GAS f32x4* xr = (const GAS f32x4*)(x + (size_t)(m0 + q) * DM) + lane;
#pragma unroll
            for (int j = 0; j < 4; ++j) v[q][j] = xr[64 * j]; }
#pragma unroll
        for (int q = 0; q < 4; ++q) { float s = 0.f;
            GAS unsigned long long* o8 = (GAS unsigned long long*)(dst + (size_t)(m0 + q) * DM) + lane;
#pragma unroll
            for (int j = 0; j < 4; ++j) { const f32x4 t = v[q][j]; s += (t.x * t.x + t.y * t.y) + (t.z * t.z + t.w * t.w);
                o8[64 * j] = (unsigned long long)pk2(t.x, t.y) | ((unsigned long long)pk2(t.z, t.w) << 32); }
            s = wave_sum(s, lane);
            if (lane == 0) ((GAS float*)ssq)[m0 + q] = s; }
    }
}
__device__ __forceinline__ void final_norm(float* x, const float* g, const float* ssq, int G, int wv_) {
    OPAQUE_TID(tid_);
    const size_t n4 = (size_t)MTOT * DM / 4, stride = (size_t)G * 512;
    for (size_t i = (size_t)blockIdx.x * 512 + tid_; i < n4; i += stride) {
        const f32x4 v = ((const GAS f32x4*)x)[i];
        const float r = 1.0f / sqrtf(((const GAS float*)ssq)[i >> 8] * (1.0f / DM) + EPS);
        const f32x4 gg = ((const GAS f32x4*)g)[i & 255];
        ((GAS f32x4*)x)[i] = v * r * gg;
    }
}
__device__ __forceinline__ void mla_prep(bf16_t* P, const int* pos, const float* gq, const float* gkv, float* cs, int NGW, int wv_) {
    OPAQUE_TID(tid_); const int lane = tid_ & 63, gw = blockIdx.x * 8 + __builtin_amdgcn_readfirstlane(tid_ >> 6);
    const f32x4 gg = ((const GAS f32x4*)gq)[lane];
    const float gk0 = ((const GAS float*)gkv)[2 * lane], gk1 = ((const GAS float*)gkv)[2 * lane + 1];
    const float invf = exp2f(-(float)(lane & 15) * 0.83048202372184059f);
    for (int m0 = gw * 4; m0 < MH; m0 += NGW * 4) {
        u32x2 wq[4]; unsigned wk[4]; float x1[4], x2[4]; int ps[4];
#pragma unroll
        for (int q = 0; q < 4; ++q) { GAS bf16_t* prow = (GAS bf16_t*)(P + (size_t)(m0 + q) * 4096 + 3584);
            wq[q] = *(const GAS u32x2*)(prow + 4 * lane); wk[q] = *(const GAS unsigned*)(prow + 256 + 2 * lane);
            x1[q] = __uint_as_float((unsigned)prow[384 + (lane & 15)] << 16); x2[q] = __uint_as_float((unsigned)prow[400 + (lane & 15)] << 16); ps[q] = ((const GAS int*)pos)[m0 + q]; }
#pragma unroll
        for (int q = 0; q < 4; ++q) { GAS bf16_t* prow = (GAS bf16_t*)(P + (size_t)(m0 + q) * 4096 + 3584); const int m = m0 + q;
            { const float a = bflo(wq[q].x), b = bfhi(wq[q].x), c = bflo(wq[q].y), d = bfhi(wq[q].y);
              const float r = 1.0f / sqrtf(wave_sum((a * a + b * b) + (c * c + d * d), lane) * (1.0f / 256.0f) + EPS);
              u32x2 o; o.x = pk2(a * r * gg.x, b * r * gg.y); o.y = pk2(c * r * gg.z, d * r * gg.w);
              *(GAS u32x2*)(prow + 4 * lane) = o; }
            { const float a = bflo(wk[q]), b = bfhi(wk[q]);
              const float r = 1.0f / sqrtf(wave_sum(a * a + b * b, lane) * (1.0f / 128.0f) + EPS);
              *(GAS unsigned*)(prow + 256 + 2 * lane) = pk2(a * r * gk0, b * r * gk1); }
            if (lane < 16) {
                double fr = (double)ps[q] * (double)invf * 0.15915494309189535;
                fr -= rint(fr);
                const float c = __builtin_amdgcn_cosf((float)fr), s = __builtin_amdgcn_sinf((float)fr);
                ((GAS float*)cs)[(size_t)m * 32 + lane] = c; ((GAS float*)cs)[(size_t)m * 32 + 16 + lane] = s;
                prow[384 + lane] = f2bf(x1[q] * c - x2[q] * s); prow[400 + lane] = f2bf(x2[q] * c + x1[q] * s);
            } }
    }
}

constexpr int VP = 72;
__device__ __forceinline__ float max3f(float a, float b, float c) { return __builtin_fmaxf(__builtin_fmaxf(a, b), c); }
template <int ND0, int KP>
__device__ __forceinline__ void qk_tile(const LAS unsigned char* Ks, const bf16x8 (&qf)[ND0], const f32x16& negm, f32x16& p0, f32x16& p1, int r32, int hi) {
#pragma unroll
    for (int d0 = 0; d0 < ND0; ++d0) {
        const bf16x8 a0 = *(const LAS bf16x8*)(Ks + r32 * (KP * 2) + (16 * d0 + 8 * hi) * 2);
        const bf16x8 a1 = *(const LAS bf16x8*)(Ks + (r32 + 32) * (KP * 2) + (16 * d0 + 8 * hi) * 2);
        if (d0 == 0) { p0 = MFMA32(a0, qf[0], negm); p1 = MFMA32(a1, qf[0], negm); }
        else { p0 = MFMA32(a0, qf[d0], p0); p1 = MFMA32(a1, qf[d0], p1); }
    }
}
__device__ __forceinline__ void softmax_pv(f32x16& p0, f32x16& p1, f32x16 (&o)[2], float& m_run, float& l_run, f32x16& negm, bool first, const LAS unsigned char* Vts, LAS float* sc, int r32, int hi) {
    float a = max3f(p0[0], p0[1], p1[0]), b = max3f(p0[2], p0[3], p1[1]); a = max3f(a, p1[2], p1[3]);
#pragma unroll
    for (int r = 4; r < 16; r += 4) { a = max3f(a, p0[r], p0[r + 1]); b = max3f(b, p0[r + 2], p0[r + 3]); a = max3f(a, p1[r], p1[r + 1]); b = max3f(b, p1[r + 2], p1[r + 3]); }
    float mx = __builtin_fmaxf(a, b);
    { auto rr = __builtin_amdgcn_permlane32_swap(__float_as_uint(mx), __float_as_uint(mx), false, false); mx = __builtin_fmaxf(__uint_as_float(rr[0]), __uint_as_float(rr[1])); }
    if (first || __any(mx > 8.0f)) {
        const float dl = first ? mx : __builtin_fmaxf(mx, 0.f);
        m_run += dl;
#pragma unroll
        for (int r = 0; r < 16; ++r) { p0[r] -= dl; p1[r] -= dl; negm[r] = -m_run; }
        if (!first) {
            const float al = ex2(-dl); l_run *= al;
            if (hi == 0) sc[r32] = al;
            LDS_WAIT();
#pragma unroll
            for (int g4 = 0; g4 < 4; ++g4) { const f32x4 av = *(const LAS f32x4*)(sc + 8 * g4 + 4 * hi);
#pragma unroll
                for (int e = 0; e < 4; ++e) { o[0][4 * g4 + e] *= av[e]; o[1][4 * g4 + e] *= av[e]; } }
            LDS_WAIT();
        }
    }
    float s = 0.f;
#pragma unroll
    for (int r = 0; r < 16; ++r) { p0[r] = ex2(p0[r]); p1[r] = ex2(p1[r]); s += p0[r] + p1[r]; }
    l_run += s;
#pragma unroll
    for (int ks = 0; ks < 4; ++ks) {
        u32x4 pw;
        if (ks == 0) pw = (u32x4){pk2(p0[0], p0[1]), pk2(p0[2], p0[3]), pk2(p0[4], p0[5]), pk2(p0[6], p0[7])};
        else if (ks == 1) pw = (u32x4){pk2(p0[8], p0[9]), pk2(p0[10], p0[11]), pk2(p0[12], p0[13]), pk2(p0[14], p0[15])};
        else if (ks == 2) pw = (u32x4){pk2(p1[0], p1[1]), pk2(p1[2], p1[3]), pk2(p1[4], p1[5]), pk2(p1[6], p1[7])};
        else pw = (u32x4){pk2(p1[8], p1[9]), pk2(p1[10], p1[11]), pk2(p1[12], p1[13]), pk2(p1[14], p1[15])};
        const bf16x8 pa = __builtin_bit_cast(bf16x8, pw);
#pragma unroll
        for (int db = 0; db < 2; ++db) {
            const bf16x8 vb = *(const LAS bf16x8*)(Vts + (32 * db + r32) * (VP * 2) + (16 * ks + 8 * hi) * 2);
            o[db] = MFMA32(pa, vb, o[db]);
        }
    }
}
__device__ __forceinline__ void attn_finish(f32x16 (&o)[2], float l_run, bf16_t* y, size_t row0, int ldy, int col0, LAS float* sc, int r32, int hi) {
    float lt = l_run;
    { auto rr = __builtin_amdgcn_permlane32_swap(__float_as_uint(lt), __float_as_uint(lt), false, false); lt = __uint_as_float(rr[0]) + __uint_as_float(rr[1]); }
    if (hi == 0) sc[r32] = 1.0f / lt;
    LDS_WAIT();
#pragma unroll
    for (int g4 = 0; g4 < 4; ++g4) { const f32x4 a = *(const LAS f32x4*)(sc + 8 * g4 + 4 * hi);
#pragma unroll
        for (int e = 0; e < 4; ++e) { const int r = 4 * g4 + e; GAS bf16_t* yp = (GAS bf16_t*)(y + (row0 + crow(r, hi)) * ldy + col0 + r32);
            yp[0] = f2bf(o[0][r] * a[e]); yp[32] = f2bf(o[1][r] * a[e]); } }
    LDS_WAIT();
}

#define SBAR() __builtin_amdgcn_sched_barrier(0)
template <int KP>
__device__ __forceinline__ void qk_pair6(const LAS unsigned char* Ka, const LAS unsigned char* Kb, const bf16x8 (&qf)[6], const f32x16& negm, f32x16& a0, f32x16& a1, f32x16& b0, f32x16& b1, int r32, int hi) {
    const LAS unsigned char* pa = Ka + r32 * (KP * 2) + 16 * hi; const LAS unsigned char* pb = Kb + r32 * (KP * 2) + 16 * hi;
    bf16x8 g0[6], g1[6];
#define LDG(dst, base, d0s) do { _Pragma("unroll") for (int j = 0; j < 3; ++j) { dst[2 * j] = *(const LAS bf16x8*)((base) + 32 * ((d0s) + j)); dst[2 * j + 1] = *(const LAS bf16x8*)((base) + 32 * (KP * 2) + 32 * ((d0s) + j)); } } while (0)
    LDG(g0, pa, 0); LDG(g1, pa, 3);
    SBAR(); __builtin_amdgcn_s_setprio(1);
    a0 = MFMA32(g0[0], qf[0], negm); a1 = MFMA32(g0[1], qf[0], negm); a0 = MFMA32(g0[2], qf[1], a0); a1 = MFMA32(g0[3], qf[1], a1); a0 = MFMA32(g0[4], qf[2], a0); a1 = MFMA32(g0[5], qf[2], a1);
    SBAR();
    LDG(g0, pb, 0);
    SBAR();
    a0 = MFMA32(g1[0], qf[3], a0); a1 = MFMA32(g1[1], qf[3], a1); a0 = MFMA32(g1[2], qf[4], a0); a1 = MFMA32(g1[3], qf[4], a1); a0 = MFMA32(g1[4], qf[5], a0); a1 = MFMA32(g1[5], qf[5], a1);
    SBAR();
    LDG(g1, pb, 3);
    SBAR();
    b0 = MFMA32(g0[0], qf[0], negm); b1 = MFMA32(g0[1], qf[0], negm); b0 = MFMA32(g0[2], qf[1], b0); b1 = MFMA32(g0[3], qf[1], b1); b0 = MFMA32(g0[4], qf[2], b0); b1 = MFMA32(g0[5], qf[2], b1);
    SBAR();
    b0 = MFMA32(g1[0], qf[3], b0); b1 = MFMA32(g1[1], qf[3], b1); b0 = MFMA32(g1[2], qf[4], b0); b1 = MFMA32(g1[3], qf[4], b1); b0 = MFMA32(g1[4], qf[5], b0); b1 = MFMA32(g1[5], qf[5], b1);
    __builtin_amdgcn_s_setprio(0); SBAR();
#undef LDG
}
__device__ __forceinline__ void softmax_pv2(f32x16& a0, f32x16& a1, f32x16& b0, f32x16& b1, f32x16 (&o)[2], float& m_run, float& l_run, f32x16& negm, bool first,
                                            const LAS unsigned char* Va, const LAS unsigned char* Vb, LAS float* sc, int r32, int hi) {
    float x = max3f(a0[0], a0[1], a1[0]), y = max3f(a0[2], a0[3], a1[1]); x = max3f(x, a1[2], a1[3]);
    float u = max3f(b0[0], b0[1], b1[0]), v = max3f(b0[2], b0[3], b1[1]); u = max3f(u, b1[2], b1[3]);
#pragma unroll
    for (int r = 4; r < 16; r += 4) { x = max3f(x, a0[r], a0[r + 1]); y = max3f(y, a0[r + 2], a0[r + 3]); x = max3f(x, a1[r], a1[r + 1]); y = max3f(y, a1[r + 2], a1[r + 3]);
        u = max3f(u, b0[r], b0[r + 1]); v = max3f(v, b0[r + 2], b0[r + 3]); u = max3f(u, b1[r], b1[r + 1]); v = max3f(v, b1[r + 2], b1[r + 3]); }
    float mx = __builtin_fmaxf(__builtin_fmaxf(x, y), __builtin_fmaxf(u, v));
    { auto rr = __builtin_amdgcn_permlane32_swap(__float_as_uint(mx), __float_as_uint(mx), false, false); mx = __builtin_fmaxf(__uint_as_float(rr[0]), __uint_as_float(rr[1])); }
    if (first || __any(mx > 8.0f)) {
        const float dl = first ? mx : __builtin_fmaxf(mx, 0.f);
        m_run += dl;
#pragma unroll
        for (int r = 0; r < 16; ++r) { a0[r] -= dl; a1[r] -= dl; b0[r] -= dl; b1[r] -= dl; negm[r] = -m_run; }
        if (!first) {
            const float al = ex2(-dl); l_run *= al;
            if (hi == 0) sc[r32] = al;
            LDS_WAIT();
#pragma unroll
            for (int g4 = 0; g4 < 4; ++g4) { const f32x4 av = *(const LAS f32x4*)(sc + 8 * g4 + 4 * hi);
#pragma unroll
                for (int e = 0; e < 4; ++e) { o[0][4 * g4 + e] *= av[e]; o[1][4 * g4 + e] *= av[e]; } }
            LDS_WAIT();
        }
    }
    float s = 0.f, t = 0.f;
#pragma unroll
    for (int r = 0; r < 16; ++r) { a0[r] = ex2(a0[r]); a1[r] = ex2(a1[r]); s += a0[r] + a1[r]; }
#pragma unroll
    for (int r = 0; r < 16; ++r) { b0[r] = ex2(b0[r]); b1[r] = ex2(b1[r]); t += b0[r] + b1[r]; }
    l_run += s + t;
#pragma unroll
    for (int half = 0; half < 2; ++half) {
        const f32x16& p0 = half ? b0 : a0; const f32x16& p1 = half ? b1 : a1; const LAS unsigned char* Vts = half ? Vb : Va;
#pragma unroll
        for (int ks = 0; ks < 4; ++ks) {
            u32x4 pw;
            if (ks == 0) pw = (u32x4){pk2(p0[0], p0[1]), pk2(p0[2], p0[3]), pk2(p0[4], p0[5]), pk2(p0[6], p0[7])};
            else if (ks == 1) pw = (u32x4){pk2(p0[8], p0[9]), pk2(p0[10], p0[11]), pk2(p0[12], p0[13]), pk2(p0[14], p0[15])};
            else if (ks == 2) pw = (u32x4){pk2(p1[0], p1[1]), pk2(p1[2], p1[3]), pk2(p1[4], p1[5]), pk2(p1[6], p1[7])};
            else pw = (u32x4){pk2(p1[8], p1[9]), pk2(p1[10], p1[11]), pk2(p1[12], p1[13]), pk2(p1[14], p1[15])};
            const bf16x8 pa = __builtin_bit_cast(bf16x8, pw);
#pragma unroll
            for (int db = 0; db < 2; ++db) {
                const bf16x8 vb = *(const LAS bf16x8*)(Vts + (32 * db + r32) * (VP * 2) + (16 * ks + 8 * hi) * 2);
                o[db] = MFMA32(pa, vb, o[db]);
            }
        }
    }
}

__device__ __forceinline__ void mla_unit(const bf16_t* Q, const bf16_t* KN, const bf16_t* KR, const bf16_t* VT, const float* CS, bf16_t* Y, int bl, int h, int qb, LAS unsigned char* lds, int wv_) {
    OPAQUE_TID(tid);
    constexpr int KP = 104, KBUF = 64 * KP * 2, VBUF = 64 * VP * 2, OFF_V = 4 * KBUF, OFF_SC = OFF_V + 4 * VBUF;
    const int lane = tid & 63, w = __builtin_amdgcn_readfirstlane(tid >> 6), r32 = lane & 31, hi = lane >> 5;
    const size_t rb = (size_t)bl * SEQ;
    LAS float* sc = (LAS float*)(lds + OFF_SC) + w * 32;
    const float QS = 0.10206207261596577f * LOG2E;
    bf16x8 qf[6];
    { const size_t qrow = rb + (size_t)qb * 256 + 32 * w + r32;
      const bf16_t* qp = Q + qrow * 768 + h * 96;
#pragma unroll
      for (int d0 = 0; d0 < 4; ++d0) { const u32x4 raw = *(const GAS u32x4*)(qp + 16 * d0 + 8 * hi);
          u32x4 t; t.x = pk2(bflo(raw.x) * QS, bfhi(raw.x) * QS); t.y = pk2(bflo(raw.y) * QS, bfhi(raw.y) * QS); t.z = pk2(bflo(raw.z) * QS, bfhi(raw.z) * QS); t.w = pk2(bflo(raw.w) * QS, bfhi(raw.w) * QS);
          qf[d0] = __builtin_bit_cast(bf16x8, t); }
      const u32x4 r1 = *(const GAS u32x4*)(qp + 64 + 8 * hi), r2 = *(const GAS u32x4*)(qp + 80 + 8 * hi);
      const f32x4 c0 = *(const GAS f32x4*)(CS + qrow * 32 + 8 * hi), c1 = *(const GAS f32x4*)(CS + qrow * 32 + 8 * hi + 4);
      const f32x4 s0 = *(const GAS f32x4*)(CS + qrow * 32 + 16 + 8 * hi), s1 = *(const GAS f32x4*)(CS + qrow * 32 + 16 + 8 * hi + 4);
      const float x1[8] = {bflo(r1.x), bfhi(r1.x), bflo(r1.y), bfhi(r1.y), bflo(r1.z), bfhi(r1.z), bflo(r1.w), bfhi(r1.w)};
      const float x2[8] = {bflo(r2.x), bfhi(r2.x), bflo(r2.y), bfhi(r2.y), bflo(r2.z), bfhi(r2.z), bflo(r2.w), bfhi(r2.w)};
      const float cc[8] = {c0.x, c0.y, c0.z, c0.w, c1.x, c1.y, c1.z, c1.w}, ss[8] = {s0.x, s0.y, s0.z, s0.w, s1.x, s1.y, s1.z, s1.w};
      float o1[8], o2[8];
#pragma unroll
      for (int i = 0; i < 8; ++i) { o1[i] = (x1[i] * cc[i] - x2[i] * ss[i]) * QS; o2[i] = (x2[i] * cc[i] + x1[i] * ss[i]) * QS; }
      u32x4 t1 = (u32x4){pk2(o1[0], o1[1]), pk2(o1[2], o1[3]), pk2(o1[4], o1[5]), pk2(o1[6], o1[7])}, t2 = (u32x4){pk2(o2[0], o2[1]), pk2(o2[2], o2[3]), pk2(o2[4], o2[5]), pk2(o2[6], o2[7])};
      qf[4] = __builtin_bit_cast(bf16x8, t1); qf[5] = __builtin_bit_cast(bf16x8, t2); }
    const int T = 4 * qb + 4;
    const int tlast = 4 * qb + (w >> 1);
    const int krow = tid >> 3, kch = tid & 7;
    const int rrow = (tid & 255) >> 2, rch = tid & 3;
    const bf16_t* knp = KN + (rb + krow) * 512 + h * 64 + 8 * kch;
    const bf16_t* krp = KR + (rb + rrow) * 4096 + 8 * rch;
    const bf16_t* vtp = VT + (size_t)(h * 64 + krow) * MH + rb + 8 * kch;
    const int vpos = 16 * (kch >> 1) + ((kch & 1) ? 4 : 0);
    u32x4 gk0, gr0 = (u32x4){0u, 0u, 0u, 0u}, gv0, gk1, gr1 = (u32x4){0u, 0u, 0u, 0u}, gv1;
#define MLA_LOAD1(S, t) do { gk##S = *(const GAS u32x4*)(knp + (size_t)(t) * 64 * 512); if (tid < 256) gr##S = *(const GAS u32x4*)(krp + (size_t)(t) * 64 * 4096); gv##S = *(const GAS u32x4*)(vtp + (size_t)(t) * 64); } while (0)
#define MLA_STORE1(S, slot) do { *(LAS u32x4*)(lds + (slot) * KBUF + krow * (KP * 2) + kch * 16) = gk##S; if (tid < 256) *(LAS u32x4*)(lds + (slot) * KBUF + rrow * (KP * 2) + 128 + rch * 16) = gr##S; \
        LAS unsigned char* vd_ = lds + OFF_V + (slot) * VBUF + krow * (VP * 2) + vpos * 2; *(LAS u32x2*)vd_ = (u32x2){gv##S.x, gv##S.y}; *(LAS u32x2*)(vd_ + 16) = (u32x2){gv##S.z, gv##S.w}; } while (0)
    f32x16 o[2], negm, a0, a1, b0, b1;
#pragma unroll
    for (int r = 0; r < 16; ++r) { o[0][r] = 0.f; o[1][r] = 0.f; negm[r] = 0.f; }
    float m_run = 0.f, l_run = 0.f;
    bool first = true;
    MLA_LOAD1(0, 0); MLA_LOAD1(1, 1); MLA_STORE1(0, 0); MLA_STORE1(1, 1);
    __syncthreads();
#pragma unroll 1
    for (int tp = 0, st = 0; tp < T; tp += 2, st ^= 1) {
        if (tp + 2 < T) { MLA_LOAD1(0, tp + 2); MLA_LOAD1(1, tp + 3); }
        const LAS unsigned char* Ka = lds + (2 * st) * KBUF; const LAS unsigned char* Va = lds + OFF_V + (2 * st) * VBUF;
        if (tp + 1 <= tlast) {
            qk_pair6<KP>(Ka, Ka + KBUF, qf, negm, a0, a1, b0, b1, r32, hi);
            softmax_pv2(a0, a1, b0, b1, o, m_run, l_run, negm, first, Va, Va + VBUF, sc, r32, hi); first = false;
        } else if (tp <= tlast) {
            qk_tile<6, KP>(Ka, qf, negm, a0, a1, r32, hi);
            softmax_pv(a0, a1, o, m_run, l_run, negm, first, Va, sc, r32, hi); first = false;
        }
        if (tp + 2 < T) { MLA_STORE1(0, 2 * (st ^ 1)); MLA_STORE1(1, 2 * (st ^ 1) + 1); }
        __syncthreads();
    }
#undef MLA_LOAD1
#undef MLA_STORE1
    attn_finish(o, l_run, Y, rb + (size_t)qb * 256 + 32 * w, 1536, 1024 + h * 64, sc, r32, hi);
    __syncthreads();
}

__device__ __forceinline__ void bandattn_unit(const bf16_t* P, const float* relb  , bf16_t* Y, int bl, int h, int grp, LAS unsigned char* lds, int wv_) {
    OPAQUE_TID(tid);
    constexpr int KP = 72, KBUF = 64 * KP * 2, VBUF = 64 * VP * 2, OFF_V = 2 * KBUF, OFF_SC = OFF_V + 3 * VBUF, OFF_TB = OFF_SC + 8 * 128;
    const int lane = tid & 63, w = __builtin_amdgcn_readfirstlane(tid >> 6), r32 = lane & 31, hi = lane >> 5;
    const size_t rb = (size_t)bl * SEQ;
    LAS float* sc = (LAS float*)(lds + OFF_SC) + w * 32;
    LAS float* tb = (LAS float*)(lds + OFF_TB);
    if (tid < 257) tb[tid] = ((const GAS float*)relb)[tid] * LOG2E;
    const float QS = 0.125f * LOG2E;
    bf16x8 qf[4];
    { const size_t qrow = rb + (size_t)grp * 256 + 32 * w + r32;
      const bf16_t* qp = P + qrow * 4096 + h * 64;
#pragma unroll
      for (int d0 = 0; d0 < 4; ++d0) { const u32x4 raw = *(const GAS u32x4*)(qp + 16 * d0 + 8 * hi);
          u32x4 t; t.x = pk2(bflo(raw.x) * QS, bfhi(raw.x) * QS); t.y = pk2(bflo(raw.y) * QS, bfhi(raw.y) * QS); t.z = pk2(bflo(raw.z) * QS, bfhi(raw.z) * QS); t.w = pk2(bflo(raw.w) * QS, bfhi(raw.w) * QS);
          qf[d0] = __builtin_bit_cast(bf16x8, t); } }
    const int c = 4 * grp + (w >> 1);
    const int wg = w & 1;
    const int kc0 = (4 * grp - 8) > 0 ? (4 * grp - 8) : 0, kc1 = 4 * grp + 3;
    const int krow = tid >> 3, kch = tid & 7;
    const int vkv = tid & 63, vch = tid >> 6;
    const int vpos = (vkv & ~12) | ((vkv & 4) << 1) | ((vkv & 8) >> 1);
    const bf16_t* kp = P + (rb + krow) * 4096 + 512 + h * 64 + 8 * kch;
    const bf16_t* vp = P + (rb + vkv) * 4096 + 1024 + h * 64 + 8 * vch;
    u32x4 gk0, gv0, gk1, gv1;
#define BA_LOAD(S, kc) do { gk##S = *(const GAS u32x4*)(kp + (size_t)(kc) * 64 * 4096); gv##S = *(const GAS u32x4*)(vp + (size_t)(kc) * 64 * 4096); } while (0)
#define BA_STORE(S, kb, vb) do { *(LAS u32x4*)(lds + (kb) * KBUF + krow * (KP * 2) + kch * 16) = gk##S; \
        LAS bf16_t* vd = (LAS bf16_t*)(lds + OFF_V + (vb) * VBUF) + (8 * vch) * VP + vpos; \
        vd[0 * VP] = (bf16_t)(gv##S.x & 0xffffu); vd[1 * VP] = (bf16_t)(gv##S.x >> 16); vd[2 * VP] = (bf16_t)(gv##S.y & 0xffffu); vd[3 * VP] = (bf16_t)(gv##S.y >> 16); \
        vd[4 * VP] = (bf16_t)(gv##S.z & 0xffffu); vd[5 * VP] = (bf16_t)(gv##S.z >> 16); vd[6 * VP] = (bf16_t)(gv##S.w & 0xffffu); vd[7 * VP] = (bf16_t)(gv##S.w >> 16); } while (0)
    f32x16 o[2], negm, p0, p1;
#pragma unroll
    for (int r = 0; r < 16; ++r) { o[0][r] = 0.f; o[1][r] = 0.f; negm[r] = 0.f; p0[r] = 0.f; p1[r] = 0.f; }
    float m_run = 0.f, l_run = 0.f;
    bool first = true;
    BA_LOAD(0, kc0); BA_LOAD(1, kc0 + 1); BA_STORE(0, 0, 0);
    __syncthreads();
    const int qpos = 64 * c + 32 * (w & 1) + r32;
#define BA_QK(kc, kb) do { qk_tile<4, KP>(lds + (kb) * KBUF, qf, negm, p0, p1, r32, hi); \
        if (c - (kc) >= 3) { const float bb = tb[256]; _Pragma("unroll") for (int r = 0; r < 16; ++r) { p0[r] += bb; p1[r] += bb; } } \
        else { _Pragma("unroll") for (int r = 0; r < 16; ++r) { const int d0 = qpos - (64 * (kc) + crow(r, hi)); \
            const int i0 = d0 < -128 ? -128 : (d0 > 128 ? 128 : d0), i1 = (d0 - 32) < -128 ? -128 : ((d0 - 32) > 128 ? 128 : (d0 - 32)); \
            p0[r] += tb[i0 + 128]; p1[r] += tb[i1 + 128]; } } } while (0)
    int vcur = 0, vprev = 2, vnext = 1;
#define BA_STEP(kc, it, SL, SS) do { \
        if ((kc) + 2 <= kc1) BA_LOAD(SL, (kc) + 2); \
        if (wg == 1 && (it) >= 1 && (kc) - 1 >= c - 8 && (kc) - 1 <= c) { softmax_pv(p0, p1, o, m_run, l_run, negm, first, lds + OFF_V + vprev * VBUF, sc, r32, hi); first = false; } \
        if ((kc) >= c - 8 && (kc) <= c) BA_QK(kc, (it) & 1); \
        if (wg == 0 && (kc) >= c - 8 && (kc) <= c) { softmax_pv(p0, p1, o, m_run, l_run, negm, first, lds + OFF_V + vcur * VBUF, sc, r32, hi); first = false; } \
        if ((kc) + 1 <= kc1) BA_STORE(SS, ((it) + 1) & 1, vnext); \
        __syncthreads(); \
        { const int tmp = vprev; vprev = vcur; vcur = vnext; vnext = tmp; } } while (0)
#pragma unroll 1
    for (int kc = kc0, it = 0; kc <= kc1; kc += 2, it += 2) { BA_STEP(kc, it, 0, 1); BA_STEP(kc + 1, it + 1, 1, 0); }
    if (wg == 1 && kc1 <= c) softmax_pv(p0, p1, o, m_run, l_run, negm, first, lds + OFF_V + vprev * VBUF, sc, r32, hi);
#undef BA_LOAD
#undef BA_STORE
#undef BA_QK
#undef BA_STEP
    attn_finish(o, l_run, Y, rb + (size_t)grp * 256 + 32 * w, 1536, h * 64, sc, r32, hi);
    __syncthreads();
}

__device__ __forceinline__ void hgrn_x_unit(bf16_t* P, const float* lbl, float* DLg, int layer, int bl, int h, int cp, LAS unsigned char* ldsb, int wv_, const u32x4 (&rqa)[2], const u32x4 (&rfa)[2], const u32x4 (&ria)[2]) {
    OPAQUE_TID(tid);
    constexpr int RP = 144;
    constexpr int O_LF = 0, O_SEG = 16384, O_QT = 18432, O_KT = 27648, O_KH = 36864, O_VT = 46080, XCH = 55296;
    const int lane = tid & 63, w = __builtin_amdgcn_readfirstlane(tid >> 6), r32 = lane & 31, hi = lane >> 5;
    const int j = tid >> 3, c8 = tid & 7;
    const size_t rb0 = (size_t)bl * SEQ + (size_t)cp * 128;
    float kka[2][8];
#pragma unroll
    for (int ch = 0; ch < 2; ++ch) { LAS unsigned char* lds = ldsb + ch * XCH; const size_t rb = rb0 + ch * 64; const int c = 2 * cp + ch; (void)c; (void)rb;
      LAS float* LF = (LAS float*)(lds + O_LF); LAS float* SEG = (LAS float*)(lds + O_SEG); (void)SEG; (void)LF;
      bf16_t* base = P + (rb + j) * 4096 + h * 64 + 8 * c8; (void)base;
      const u32x4 rq = rqa[ch], rf = rfa[ch], ri = ria[ch]; (void)rq; (void)rf; (void)ri;
      float (&kk)[8] = kka[ch];
    { const float z[8] = {bflo(rf.x), bfhi(rf.x), bflo(rf.y), bfhi(rf.y), bflo(rf.z), bfhi(rf.z), bflo(rf.w), bfhi(rf.w)};
      float lf[8];
#pragma unroll
      for (int i = 0; i < 8; ++i) { const int d = h * 64 + 8 * c8 + i; const GAS float* lblg = (const GAS float*)lbl; const float lb = (layer == 0) ? 0.f : sigm(lblg[512 + d] - lblg[d]);
          const float sg = sigm(z[i]); const float f = lb + (1.0f - lb) * sg; lf[i] = fmaxf(__builtin_amdgcn_logf(f), -80.0f); kk[i] = (1.0f - lb) * (1.0f - sg); }
      *(LAS f32x4*)(LF + j * 64 + 8 * c8) = (f32x4){lf[0], lf[1], lf[2], lf[3]}; *(LAS f32x4*)(LF + j * 64 + 8 * c8 + 4) = (f32x4){lf[4], lf[5], lf[6], lf[7]}; }
    }
    __syncthreads();
#pragma unroll
    for (int ch = 0; ch < 2; ++ch) { LAS unsigned char* lds = ldsb + ch * XCH; const size_t rb = rb0 + ch * 64; const int c = 2 * cp + ch; (void)c; (void)rb;
      LAS float* LF = (LAS float*)(lds + O_LF); LAS float* SEG = (LAS float*)(lds + O_SEG); (void)SEG; (void)LF;
      bf16_t* base = P + (rb + j) * 4096 + h * 64 + 8 * c8; (void)base;
      const u32x4 rq = rqa[ch], rf = rfa[ch], ri = ria[ch]; (void)rq; (void)rf; (void)ri;
      float (&kk)[8] = kka[ch];
    { const int d = tid & 63, sg = tid >> 6; float v[8];
#pragma unroll
      for (int k = 0; k < 8; ++k) v[k] = LF[(8 * sg + k) * 64 + d];
#pragma unroll
      for (int k = 1; k < 8; ++k) v[k] += v[k - 1];
#pragma unroll
      for (int k = 0; k < 8; ++k) LF[(8 * sg + k) * 64 + d] = v[k];
      SEG[sg * 64 + d] = v[7]; }
    }
    __syncthreads();
#pragma unroll
    for (int ch = 0; ch < 2; ++ch) { LAS unsigned char* lds = ldsb + ch * XCH; const size_t rb = rb0 + ch * 64; const int c = 2 * cp + ch; (void)c; (void)rb;
      LAS float* LF = (LAS float*)(lds + O_LF); LAS float* SEG = (LAS float*)(lds + O_SEG); (void)SEG; (void)LF;
      bf16_t* base = P + (rb + j) * 4096 + h * 64 + 8 * c8; (void)base;
      const u32x4 rq = rqa[ch], rf = rfa[ch], ri = ria[ch]; (void)rq; (void)rf; (void)ri;
      float (&kk)[8] = kka[ch];
    { const int sg = j >> 3;
      float off[8], tot[8], mid[8];
#pragma unroll
      for (int i = 0; i < 8; ++i) { off[i] = 0.f; tot[i] = 0.f; mid[i] = 0.f; }
#pragma unroll
      for (int s2 = 0; s2 < 8; ++s2) { const f32x4 a = *(const LAS f32x4*)(SEG + s2 * 64 + 8 * c8), b = *(const LAS f32x4*)(SEG + s2 * 64 + 8 * c8 + 4);
          const float v8[8] = {a.x, a.y, a.z, a.w, b.x, b.y, b.z, b.w};
#pragma unroll
          for (int i = 0; i < 8; ++i) { if (s2 < sg) off[i] += v8[i]; tot[i] += v8[i]; if (s2 == 3) mid[i] = tot[i]; } }
      const f32x4 ca = *(const LAS f32x4*)(LF + j * 64 + 8 * c8), cb = *(const LAS f32x4*)(LF + j * 64 + 8 * c8 + 4);
      const float cl[8] = {ca.x, ca.y, ca.z, ca.w, cb.x, cb.y, cb.z, cb.w};
      const float qr[8] = {bflo(rq.x), bfhi(rq.x), bflo(rq.y), bfhi(rq.y), bflo(rq.z), bfhi(rq.z), bflo(rq.w), bfhi(rq.w)};
      float qt[8], kt[8], qh[8], kh[8];
#pragma unroll
      for (int i = 0; i < 8; ++i) { const float cum = cl[i] + off[i]; const float qs = qr[i] * sigm(qr[i]);
          qt[i] = qs * ex2(cum - mid[i]); kt[i] = kk[i] * ex2(mid[i] - cum); qh[i] = qs * ex2(cum); kh[i] = kk[i] * ex2(tot[i] - cum); }
      *(LAS u32x4*)(lds + O_QT + j * RP + c8 * 16) = (u32x4){pk2(qt[0], qt[1]), pk2(qt[2], qt[3]), pk2(qt[4], qt[5]), pk2(qt[6], qt[7])};
      *(LAS u32x4*)(lds + O_KT + j * RP + c8 * 16) = (u32x4){pk2(kt[0], kt[1]), pk2(kt[2], kt[3]), pk2(kt[4], kt[5]), pk2(kt[6], kt[7])};
      *(GAS u32x4*)(base + 1536) = (u32x4){pk2(qh[0], qh[1]), pk2(qh[2], qh[3]), pk2(qh[4], qh[5]), pk2(qh[6], qh[7])};
      LAS bf16_t* khp = (LAS bf16_t*)(lds + O_KH) + (8 * c8) * 72 + j;
      LAS bf16_t* vtp = (LAS bf16_t*)(lds + O_VT) + (8 * c8) * 72 + j;
      const unsigned vw[4] = {ri.x, ri.y, ri.z, ri.w};
#pragma unroll
      for (int i = 0; i < 8; ++i) { khp[i * 72] = f2bf(kh[i]); vtp[i * 72] = (bf16_t)((i & 1) ? (vw[i >> 1] >> 16) : (vw[i >> 1] & 0xffffu)); }
      if (j == 0) { float* dlp = DLg + ((size_t)((bl * 8 + h) * 128 + c)) * 64 + 8 * c8;
          *(GAS f32x4*)dlp = (f32x4){ex2(tot[0]), ex2(tot[1]), ex2(tot[2]), ex2(tot[3])}; *(GAS f32x4*)(dlp + 4) = (f32x4){ex2(tot[4]), ex2(tot[5]), ex2(tot[6]), ex2(tot[7])}; } }
    }
    __syncthreads();
#pragma unroll
    for (int ch = 0; ch < 2; ++ch) { LAS unsigned char* lds = ldsb + ch * XCH; const size_t rb = rb0 + ch * 64; const int c = 2 * cp + ch; (void)c; (void)rb;
      LAS float* LF = (LAS float*)(lds + O_LF); LAS float* SEG = (LAS float*)(lds + O_SEG); (void)SEG; (void)LF;
      bf16_t* base = P + (rb + j) * 4096 + h * 64 + 8 * c8; (void)base;
      const u32x4 rq = rqa[ch], rf = rfa[ch], ri = ria[ch]; (void)rq; (void)rf; (void)ri;
      float (&kk)[8] = kka[ch];
    if (w < 4) {
        const int I = w >> 1, DV = w & 1;
        f32x16 o;
#pragma unroll
        for (int r = 0; r < 16; ++r) o[r] = 0.f;
        for (int J = 0; J <= I; ++J) {
            f32x16 p;
#pragma unroll
            for (int r = 0; r < 16; ++r) p[r] = 0.f;
#pragma unroll
            for (int ks = 0; ks < 4; ++ks) { const bf16x8 a = *(const LAS bf16x8*)(lds + O_KT + (32 * J + r32) * RP + (16 * ks + 8 * hi) * 2);
                const bf16x8 b = *(const LAS bf16x8*)(lds + O_QT + (32 * I + r32) * RP + (16 * ks + 8 * hi) * 2); p = MFMA32(a, b, p); }
            if (J == I) {
#pragma unroll
                for (int r = 0; r < 16; ++r) if (crow(r, hi) > r32) p[r] = 0.f;
            }
#pragma unroll
            for (int k2 = 0; k2 < 2; ++k2) {
                u32x4 pw;
                if (k2 == 0) pw = (u32x4){pk2(p[0], p[1]), pk2(p[2], p[3]), pk2(p[4], p[5]), pk2(p[6], p[7])};
                else pw = (u32x4){pk2(p[8], p[9]), pk2(p[10], p[11]), pk2(p[12], p[13]), pk2(p[14], p[15])};
                const LAS unsigned char* vp = lds + O_VT + (32 * DV + r32) * RP + (32 * J + 16 * k2 + 4 * hi) * 2;
                const u32x2 lo = *(const LAS u32x2*)vp, h2 = *(const LAS u32x2*)(vp + 16);
                const u32x4 vw4 = (u32x4){lo.x, lo.y, h2.x, h2.y};
                o = MFMA32(__builtin_bit_cast(bf16x8, pw), __builtin_bit_cast(bf16x8, vw4), o);
            }
        }
        GAS bf16_t* op = (GAS bf16_t*)(P + (rb + 32 * I) * 4096 + 2048 + h * 64 + 32 * DV + r32);
#pragma unroll
        for (int r = 0; r < 16; ++r) op[(size_t)crow(r, hi) * 4096] = f2bf(o[r]);
    } else {
        const int ww = w - 4, Dt = ww >> 1, DV = ww & 1;
        f32x16 zt;
#pragma unroll
        for (int r = 0; r < 16; ++r) zt[r] = 0.f;
#pragma unroll
        for (int ks = 0; ks < 4; ++ks) { const bf16x8 a = *(const LAS bf16x8*)(lds + O_VT + (32 * DV + r32) * RP + (16 * ks + 8 * hi) * 2);
            const bf16x8 b = *(const LAS bf16x8*)(lds + O_KH + (32 * Dt + r32) * RP + (16 * ks + 8 * hi) * 2); zt = MFMA32(a, b, zt); }
        GAS bf16_t* zp = (GAS bf16_t*)(P + (rb + 32 * DV) * 4096 + 2560 + h * 64 + 32 * Dt + r32);
#pragma unroll
        for (int r = 0; r < 16; ++r) zp[(size_t)crow(r, hi) * 4096] = f2bf(zt[r]);
    }
    }
    __syncthreads();
}
__device__ __forceinline__ void hgrn_scan(bf16_t* P, const float* DLg, int slice, int wv_) {
    OPAQUE_TID(tid);
    const int chain = slice >> 3, bl = chain >> 3, h = chain & 7, dv = 8 * (slice & 7) + (tid >> 6), d = tid & 63;
    GAS bf16_t* p = (GAS bf16_t*)(P + ((size_t)bl * SEQ + dv) * 4096 + 2560 + h * 64 + d);
    const GAS float* dl = (const GAS float*)(DLg + (size_t)chain * 128 * 64 + d);
    float s = 0.f;
#pragma unroll 1
    for (int c0 = 0; c0 < 128; c0 += 16) {
        bf16_t z[16]; float e[16];
#pragma unroll
        for (int k = 0; k < 16; ++k) { z[k] = p[(size_t)(c0 + k) * 64 * 4096]; e[k] = dl[(c0 + k) * 64]; }
#pragma unroll
        for (int k = 0; k < 16; ++k) { s = e[k] * s + __uint_as_float((unsigned)z[k] << 16); p[(size_t)(c0 + k) * 64 * 4096] = f2bf(s); }
    }
}
__device__ __forceinline__ void hgrn_z_unit(const bf16_t* P, const float* ng, bf16_t* Y, int bl, int h, int cp, LAS unsigned char* lds, int wv_) {
    OPAQUE_TID(tid);
    const int lane = tid & 63, w = __builtin_amdgcn_readfirstlane(tid >> 6), r32 = lane & 31, hi = lane >> 5;
    const size_t rb = (size_t)bl * SEQ;
    LAS float* OB = (LAS float*)lds;
    { const int cw = 2 * cp + (w >> 2), I = (w >> 1) & 1, DV = w & 1;
      f32x16 o;
#pragma unroll
      for (int r = 0; r < 16; ++r) o[r] = 0.f;
      if (cw > 0) {
          const bf16_t* ap = P + (rb + (size_t)cw * 64 + 32 * I + r32) * 4096 + 1536 + h * 64 + 8 * hi;
          const bf16_t* bp = P + (rb + (size_t)(cw - 1) * 64 + 32 * DV + r32) * 4096 + 2560 + h * 64 + 8 * hi;
#pragma unroll
          for (int ks = 0; ks < 4; ++ks) { const bf16x8 a = *(const GAS bf16x8*)(ap + 16 * ks), b = *(const GAS bf16x8*)(bp + 16 * ks); o = MFMA32(a, b, o); }
      }
#pragma unroll
      for (int r = 0; r < 16; ++r) OB[((w >> 2) * 64 + 32 * I + crow(r, hi)) * 68 + 32 * DV + r32] = o[r]; }
    __syncthreads();
    const int c8 = tid & 7;
    float ngv[8];
#pragma unroll
    for (int i = 0; i < 8; ++i) ngv[i] = ((const GAS float*)ng)[8 * c8 + i];
#pragma unroll
    for (int it = 0; it < 2; ++it) {
        const int row = it * 64 + (tid >> 3);
        const bf16_t* pr = P + (rb + (size_t)cp * 128 + row) * 4096 + h * 64 + 8 * c8;
        const u32x4 oi = *(const GAS u32x4*)(pr + 2048), rg = *(const GAS u32x4*)(pr + 3072);
        const f32x4 a = *(const LAS f32x4*)(OB + row * 68 + 8 * c8), b = *(const LAS f32x4*)(OB + row * 68 + 8 * c8 + 4);
        const float ov[8] = {a.x + bflo(oi.x), a.y + bfhi(oi.x), a.z + bflo(oi.y), a.w + bfhi(oi.y), b.x + bflo(oi.z), b.y + bfhi(oi.z), b.z + bflo(oi.w), b.w + bfhi(oi.w)};
        float ss = 0.f;
#pragma unroll
        for (int i = 0; i < 8; ++i) ss += ov[i] * ov[i];
        ss += shx(ss, 1, lane); ss += shx(ss, 2, lane); ss += shx(ss, 4, lane);
        const float r = 1.0f / sqrtf(ss * (1.0f / 64.0f) + EPS);
        const float gr[8] = {bflo(rg.x), bfhi(rg.x), bflo(rg.y), bfhi(rg.y), bflo(rg.z), bfhi(rg.z), bflo(rg.w), bfhi(rg.w)};
        float ou[8];
#pragma unroll
        for (int i = 0; i < 8; ++i) ou[i] = ov[i] * r * ngv[i] * (gr[i] * sigm(gr[i]));
        *(GAS u32x4*)(Y + (rb + (size_t)cp * 128 + row) * 1536 + 512 + h * 64 + 8 * c8) = (u32x4){pk2(ou[0], ou[1]), pk2(ou[2], ou[3]), pk2(ou[4], ou[5]), pk2(ou[6], ou[7])};
    }
    __syncthreads();
}

__device__ __forceinline__ void tr_item(const float* W, int ldw, int k0, int nsrc0, bf16_t* WT, int ldt, int nrow0, LAS float* scr, int lane, bool zero, const float* gk = nullptr) {
    if (!zero) {
        float wvv[32];
#pragma unroll
        for (int i = 0; i < 32; ++i) { const int kk = 2 * i + (lane >> 5); wvv[i] = ((const GAS float*)W)[(size_t)(k0 + kk) * ldw + nsrc0 + (lane & 31)]; }
        if (gk) {
#pragma unroll
            for (int i = 0; i < 32; ++i) wvv[i] *= ((const GAS float*)gk)[k0 + 2 * i + (lane >> 5)];
        }
#pragma unroll
        for (int i = 0; i < 32; ++i) scr[(2 * i + (lane >> 5)) * 33 + (lane & 31)] = wvv[i];
    }
    LDS_WAIT();
    const int c = lane & 7;
#pragma unroll
    for (int jj = 0; jj < 4; ++jj) { const int n = (lane >> 3) + 8 * jj; const LAS float* s = scr + (8 * c) * 33 + n;
        u32x4 o = (u32x4){0u, 0u, 0u, 0u};
        if (!zero) { o.x = pk2(s[0 * 33], s[1 * 33]); o.y = pk2(s[2 * 33], s[3 * 33]); o.z = pk2(s[4 * 33], s[5 * 33]); o.w = pk2(s[6 * 33], s[7 * 33]); }
        *(GAS u32x4*)(WT + (size_t)(nrow0 + n) * ldt + k0 + 8 * c) = o; }
    LDS_WAIT();
}

#define XB_TMO      128
#define XB_XCNT(j)  (256  + 64 * (j))
#define XB_XSUB(j)  (1280 + 64 * (j))
#define XB_XGEN(j)  (2304 + 64 * (j))
#define XB_TOP      3328
#define XB_TOPGEN   3392
#define XCD_BAR_WORDS 3456
#define XB_SPIN_CAP (1u << 18)
__device__ __forceinline__ unsigned xb_ld(unsigned* p)              { return __hip_atomic_load(p, __ATOMIC_RELAXED, __HIP_MEMORY_SCOPE_AGENT); }
__device__ __forceinline__ unsigned xb_add(unsigned* p, unsigned v) { return __hip_atomic_fetch_add(p, v, __ATOMIC_RELAXED, __HIP_MEMORY_SCOPE_AGENT); }
__device__ __forceinline__ unsigned xb_xcc_id() { return (unsigned)__builtin_amdgcn_s_getreg((3 << 11) | 20) & 0xFu; }
#define XB_SPIN(cond, bar) do { unsigned _sp = 0; while (cond) { __builtin_amdgcn_s_sleep(1); \
    if ((++_sp & 255u) == 0u) { if (xb_ld(&(bar)[XB_TMO])) break; if (_sp > XB_SPIN_CAP) { atomicAdd(&(bar)[XB_TMO], 1u); break; } } } } while (0)
struct XcdBarrier { unsigned* bar; unsigned x; volatile LAS unsigned* st; };
__device__ __forceinline__ void xcd_barrier_complete(unsigned* bar, unsigned x, unsigned& nloc, unsigned& nx) {
    const unsigned G = gridDim.x * gridDim.y * gridDim.z;
    unsigned sum, cnt, mine, sp = 0u;
    for (;;) {
        sum = 0u; cnt = 0u; mine = 0u;
#pragma unroll
        for (unsigned j = 0; j < 16; ++j) { const unsigned c = xb_ld(&bar[XB_XCNT(j)]); sum += c; cnt += (c > 0u) ? 1u : 0u; mine = (j == x) ? c : mine; }
        if (sum == G) break;
        __builtin_amdgcn_s_sleep(1);
        if ((++sp & 255u) == 0u) { if (xb_ld(&bar[XB_TMO])) break; if (sp > XB_SPIN_CAP) { atomicAdd(&bar[XB_TMO], 1u); break; } }
    }
    nloc = mine > 0u ? mine : 1u; nx = cnt > 0u ? cnt : 1u;
}
__device__ __forceinline__ void xcd_barrier(const XcdBarrier& b, int wv_) {
    asm volatile("s_waitcnt vmcnt(0)" ::: "memory");
    __syncthreads();
    OPAQUE_TID(xtid);
    if (xtid == 0) {
        unsigned* bar = b.bar;
        __builtin_amdgcn_s_waitcnt(0);
        unsigned nloc = b.st[0], nx = b.st[1];
        if (nloc == 0u) { xcd_barrier_complete(bar, b.x, nloc, nx); b.st[0] = nloc; b.st[1] = nx; }
        const unsigned old = xb_add(&bar[XB_XSUB(b.x)], 1u);
        const unsigned gen = old / nloc;
        if (old + 1u == (gen + 1u) * nloc) {
            __builtin_amdgcn_fence(__ATOMIC_RELEASE, "agent");
            asm volatile("s_waitcnt vmcnt(0)" ::: "memory");
            const unsigned og = xb_add(&bar[XB_TOP], 1u);
            const unsigned tg = og / nx;
            if (og + 1u == (tg + 1u) * nx) xb_add(&bar[XB_TOPGEN], 1u);
            else XB_SPIN(xb_ld(&bar[XB_TOPGEN]) == tg, bar);
            __builtin_amdgcn_fence(__ATOMIC_ACQUIRE, "agent");
            xb_add(&bar[XB_XGEN(b.x)], 1u);
            asm volatile("s_waitcnt vmcnt(0)" ::: "memory");
        } else {
            XB_SPIN(xb_ld(&bar[XB_XGEN(b.x)]) == gen, bar);
            __builtin_amdgcn_fence(__ATOMIC_ACQUIRE, "agent");
            asm volatile("s_waitcnt vmcnt(0)" ::: "memory");
        }
    }
    __syncthreads();
}

#ifndef PROBE_TS
#define PROBE_TS 0
#endif
#if PROBE_TS
#define STAMP(ty) do { OPAQUE_TID(ts_tid_); if (blockIdx.x == 0 && ts_tid_ == 0) { LAS unsigned long long* tsl = (LAS unsigned long long*)(lds + 131088); const unsigned long long now_ = __builtin_amdgcn_s_memrealtime(); \
        if ((PROBE_TS >> (ty)) & 1) tsl[1] += now_ - tsl[0]; tsl[0] = now_; } } while (0)
#else
#define STAMP(ty) do {} while (0)
#endif
struct Args { const float* in[17]; float* out; unsigned char* ws; };

__global__ void __launch_bounds__(512, 2) fwd_kernel(Args a) {
    extern __shared__ __attribute__((aligned(16))) unsigned char lds_raw[];
    cg::grid_group grid = cg::this_grid();
    LAS unsigned char* lds = (LAS unsigned char*)lds_raw;
    const int G = gridDim.x, NGW = G * 8;
    const int wv_ = __builtin_amdgcn_readfirstlane((int)threadIdx.x >> 6);
#if PROBE_TS
    { OPAQUE_TID(t0_); if (blockIdx.x == 0 && t0_ == 0) { LAS unsigned long long* tsl = (LAS unsigned long long*)(lds + 131088); tsl[0] = __builtin_amdgcn_s_memrealtime(); tsl[1] = 0ull; } }
#endif
    typedef const __attribute__((address_space(4))) Args* KArgs;
#define KARGS(name) KArgs name = (KArgs)__builtin_amdgcn_kernarg_segment_ptr(); asm volatile("" : "+s"(name))
    XcdBarrier xb;
    { KARGS(kb); OPAQUE_TID(t0b); volatile LAS unsigned* st = (volatile LAS unsigned*)(lds + 131136);
      if (t0b == 0) { st[0] = 0u; st[1] = 0u; }
      __syncthreads();
      xb.bar = (unsigned*)(GAS unsigned*)(as_global(kb->ws) + WS_CTL) + 8192; xb.x = xb_xcc_id(); xb.st = st;
      if (t0b == 0) (void)xb_add(&xb.bar[XB_XCNT(xb.x)], 1u); }
#define GSYNC() xcd_barrier(xb, wv_)
    {
        KARGS(ka);
        unsigned char* ws = as_global(ka->ws);
        OPAQUE_TID(tid); const int lane = tid & 63, wave = __builtin_amdgcn_readfirstlane(tid >> 6), gw = blockIdx.x * 8 + wave;
        LAS float* scr = (LAS float*)(lds + wave * 16384);
        constexpr int I_IN = 16 * 224, I_BR = 768, I_OUT = 512, I_F1 = 2048, I_F2 = 2048, I_L = I_IN + I_BR + I_OUT + I_F1 + I_F2;
        for (int it = gw; it < 2 * I_L; it += NGW) {
            const int l = it / I_L; int r = it % I_L;
            unsigned char* wl = ws + WS_W + (size_t)l * W_LAYER_REAL;
            if (r < I_IN) { const int kb = r / 224, nb = r % 224, n0 = 32 * nb; const bool zero = (n0 >= 4000 && n0 < 4096); const int ns = n0 < 4000 ? n0 : n0 - 96;
                tr_item(as_global(ka->in[3]) + (size_t)l * 1024 * 7072, 7072, 64 * kb, zero ? 0 : ns, (bf16_t*)(wl + WO_IN), 1024, n0, scr, lane, zero, as_global(ka->in[2]) + l * 1024); continue; }
            r -= I_IN;
            if (r < I_BR) { const int z = r / 256, rr = r % 256, kb = rr / 32, nb = rr % 32;
                tr_item(as_global(ka->in[11]) + ((size_t)l * 3 + z) * 512 * 1024, 1024, 64 * kb, 32 * nb, (bf16_t*)(wl + WO_BR) + (size_t)z * 1024 * 512, 512, 32 * nb, scr, lane, false); continue; }
            r -= I_BR;
            if (r < I_OUT) { const int kb = r / 32, nb = r % 32; tr_item(as_global(ka->in[12]) + (size_t)l * 1024 * 1024, 1024, 64 * kb, 32 * nb, (bf16_t*)(wl + WO_OUT), 1024, 32 * nb, scr, lane, false); continue; }
            r -= I_OUT;
            if (r < I_F1) { const int kb = r / 128, nb = r % 128; tr_item(as_global(ka->in[14]) + (size_t)l * 1024 * 4096, 4096, 64 * kb, 32 * nb, (bf16_t*)(wl + WO_F1), 1024, 32 * nb, scr, lane, false, as_global(ka->in[13]) + l * 1024); continue; }
            r -= I_F1;
            { const int kb = r / 32, nb = r % 32; tr_item(as_global(ka->in[15]) + (size_t)l * 4096 * 1024, 1024, 64 * kb, 32 * nb, (bf16_t*)(wl + WO_F2), 4096, 32 * nb, scr, lane, false); }
        }
        rows_bf16_ssq(as_global(ka->in[0]), (bf16_t*)(ws + WS_XN), (float*)(ws + WS_SS), MTOT, NGW, wv_);
        for (int i = blockIdx.x * 512 + tid; i < 4 * MTOT; i += G * 512) ((GAS float*)(ws + WS_SS))[MTOT + i] = 0.f;
        const int gt = blockIdx.x * 512 + tid, GT_ = G * 512;
        for (int idx = gt; idx < 2 * 86016; idx += GT_) {
            const int l = idx / 86016; int r = idx % 86016;
            unsigned char* wl = ws + WS_W + (size_t)l * W_LAYER_REAL;
            const GAS float* wuq = (const GAS float*)(ka->in[9] + (size_t)l * 256 * 768); const GAS float* wukv = (const GAS float*)(ka->in[10] + (size_t)l * 128 * 1024);
            float v[8]; bf16_t* dst;
            if (r < 61440) { const int n = r % 1280, kc = r / 1280; dst = (bf16_t*)(wl + WO_QK) + (size_t)n * 384 + 8 * kc;
#pragma unroll
                for (int i = 0; i < 8; ++i) { const int k = 8 * kc + i;
                    v[i] = (n < 768) ? (k < 256 ? wuq[(size_t)k * 768 + n] : 0.f) : (k >= 256 ? wukv[(size_t)(k - 256) * 1024 + ((n - 768) >> 6) * 128 + ((n - 768) & 63)] : 0.f); }
            } else { r -= 61440; const int n = r % 512, kc = r / 512; dst = (bf16_t*)(wl + WO_V) + (size_t)n * 384 + 8 * kc;
#pragma unroll
                for (int i = 0; i < 8; ++i) { const int k = 8 * kc + i; v[i] = (k >= 256) ? wukv[(size_t)(k - 256) * 1024 + (n >> 6) * 128 + 64 + (n & 63)] : 0.f; }
            }
            *(GAS u32x4*)dst = (u32x4){pk2(v[0], v[1]), pk2(v[2], v[3]), pk2(v[4], v[5]), pk2(v[6], v[7])};
        }
    }
    grid.sync(); STAMP(10);

#pragma unroll 1
    for (int l = 0; l < 2; ++l) {
#define WPTR(base, off) ((const bf16_t*)((base) + WS_W + (size_t)l * W_LAYER_REAL + (off)))
#pragma unroll 1
        for (int hf = 0; hf < 2; ++hf) {
            const size_t R0 = (size_t)hf * MH;
            KARGS(ka);
            unsigned char* wsq_ = ka->ws; asm volatile("" : "+s"(wsq_)); unsigned char* wsq = as_global(wsq_);
#define ctl ((unsigned*)(wsq + WS_CTL))
#define XN ((bf16_t*)(wsq + WS_XN))
#define SSQ(i) ((float*)(wsq + WS_SS) + (size_t)(i) * MTOT)
#define CS ((float*)(wsq + WS_CS))
#define P ((bf16_t*)(wsq + WS_P))
#define GT ((bf16_t*)(wsq + WS_G))
#define Q ((bf16_t*)(wsq + WS_Q))
#define KN ((bf16_t*)(wsq + WS_KN))
#define VT ((bf16_t*)(wsq + WS_VT))
#define Y ((bf16_t*)(wsq + WS_Y))
#define MG ((bf16_t*)(wsq + WS_MG))
            { pg8::Gemm g{XN + R0 * DM, WPTR(wsq, WO_IN), MH, NIN, DM, DM, DM, 0, 0}; pg8::StaticOrder S; S.init(MH, NIN, G, (int)blockIdx.x);
              pg8::EpiSplit<0, 1> E{P, 4096, 16, GT, 3072, SSQ(2 * l) + R0};
              pg8::gemm_phase(lds, g, S, E, wv_); }
            GSYNC(); STAMP(1);
            mla_prep(P, (const int*)as_global(ka->in[1]) + R0, as_global(ka->in[7]) + l * 256, as_global(ka->in[8]) + l * 128, CS, NGW, wv_);
            { OPAQUE_TID(xt);
#define XLOAD(u_, q_, f_, i_) do { _Pragma("unroll") for (int ch_ = 0; ch_ < 2; ++ch_) { const bf16_t* xb_ = P + ((size_t)((u_) >> 9) * SEQ + (size_t)((u_) & 63) * 128 + ch_ * 64 + (xt >> 3)) * 4096 + (((u_) >> 6) & 7) * 64 + 8 * (xt & 7); \
                q_[ch_] = *(const GAS u32x4*)(xb_ + 1536); f_[ch_] = *(const GAS u32x4*)(xb_ + 2048); i_[ch_] = *(const GAS u32x4*)(xb_ + 2560); } } while (0)
              u32x4 nq[2], nf[2], ni[2];
#pragma unroll
              for (int ch_ = 0; ch_ < 2; ++ch_) { nq[ch_] = (u32x4){0u, 0u, 0u, 0u}; nf[ch_] = nq[ch_]; ni[ch_] = nq[ch_]; }
              if ((int)blockIdx.x < 1024) XLOAD((int)blockIdx.x, nq, nf, ni);
              for (int u = blockIdx.x; u < 1024; u += G) {
                  const u32x4 cq[2] = {nq[0], nq[1]}, cf[2] = {nf[0], nf[1]}, ci[2] = {ni[0], ni[1]};
                  if (u + G < 1024) XLOAD(u + G, nq, nf, ni);
                  hgrn_x_unit(P, as_global(ka->in[5]), (float*)(wsq + WS_DL), l, u >> 9, (u >> 6) & 7, u & 63, lds, wv_, cq, cf, ci);
              }
#undef XLOAD
            }
            GSYNC(); STAMP(2);
            { pg8::Gemm g{P + 3584, WPTR(wsq, WO_QK), MH, 1280, 384, 4096, 384, 0, 0}; pg8::StaticOrder S; S.init(MH, 1280, G, (int)blockIdx.x);
              pg8::EpiSplit<0, 0> E{Q, 768, 3, KN, 512, nullptr};
              pg8::gemm_phase(lds, g, S, E, wv_); }
            { pg8::Gemm g{WPTR(wsq, WO_V), P + 3584, 512, MH, 384, 384, 4096, 0, 0}; pg8::StaticOrder S; S.init(512, MH, G, (int)blockIdx.x);
              pg8::EpiSplit<0, 0> E{VT, MH, 1 << 30, VT, MH, nullptr};
              pg8::gemm_phase(lds, g, S, E, wv_); }
            for (int sl = G - 1 - (int)blockIdx.x; sl < 128; sl += G) hgrn_scan(P, (const float*)(wsq + WS_DL), sl, wv_);
            GSYNC(); STAMP(3);
#ifndef PROBE_RUN
#define PROBE_RUN 0
#endif
#define PH4_BODY(RUN, CTR) { \
                OPAQUE_TID(tid); \
                LAS int* slot = (LAS int*)(lds + 131072); \
                for (int qi = 0; qi < 8; ++qi) { \
                    const int q = ((int)blockIdx.x + qi) & 7;            \
                    unsigned* ctr = (CTR) + 64 * q; \
                    for (;;) { \
                        if (tid == 0) slot[0] = (int)__hip_atomic_fetch_add((GAS unsigned*)ctr, 1u, __ATOMIC_RELAXED, __HIP_MEMORY_SCOPE_AGENT); \
                        __syncthreads(); \
                        const int item = __builtin_amdgcn_readfirstlane(slot[0]); \
                        __syncthreads(); \
                        if (item >= 256) break; \
                        const int bh = 2 * q + (item & 1), kq = (item & 63) >> 1; \
                        if (item < 64) { if ((RUN) & 2) mla_unit(Q, KN, P + 3968, VT, CS, Y, bh >> 3, bh & 7, 31 - kq, lds, wv_); } \
                        else if (item < 128) { if ((RUN) & 4) bandattn_unit(P, as_global(ka->in[4]) + ((size_t)l * 8 + (bh & 7)) * 257, Y, bh >> 3, bh & 7, kq, lds, wv_); } \
                        else { if ((RUN) & 1) hgrn_z_unit(P, as_global(ka->in[6]) + l * 64, Y, bh >> 3, bh & 7, (item - 128) >> 1, lds, wv_); } \
                    } \
                } \
                GSYNC(); STAMP(4); }
            PH4_BODY(7, ctl + 1024 * (l * 2 + hf))
#if PROBE_RUN
            PH4_BODY(PROBE_RUN, ctl + 1024 * (l * 2 + hf) + 512)
#endif
            { pg8::Gemm g{Y, WPTR(wsq, WO_BR), MH, 1024, 512, 1536, 512, (size_t)512 * 2, (size_t)1024 * 512 * 2}; pg8::BranchOrder S{G, (int)blockIdx.x};
              pg8::EpiBranch E{GT, MG};
              pg8::gemm_phase(lds, g, S, E, wv_); }
            GSYNC(); STAMP(5);
            { pg8::Gemm g{MG, WPTR(wsq, WO_OUT), MH, DM, DM, DM, DM, 0, 0}; pg8::StaticOrder S; S.init(MH, DM, G, (int)blockIdx.x);
              pg8::EpiResid E{((l == 0) ? as_global(ka->in[0]) : as_global(ka->out)) + R0 * DM, as_global(ka->out) + R0 * DM, XN + R0 * DM, SSQ(2 * l + 1) + R0};
              pg8::gemm_phase(lds, g, S, E, wv_); }
            if (hf == 1) GSYNC();
            STAMP(6);
        }
#undef ctl
#undef XN
#undef SSQ
#undef CS
#undef P
#undef GT
#undef Q
#undef KN
#undef VT
#undef Y
#undef MG
        KARGS(kf); { KArgs ka = kf;
        unsigned char* wsf_ = ka->ws; asm volatile("" : "+s"(wsf_)); unsigned char* wsf = as_global(wsf_);
        bf16_t* XN = (bf16_t*)(wsf + WS_XN); bf16_t* HB = (bf16_t*)(wsf + WS_H);
        { pg8::Gemm g{XN, WPTR(wsf, WO_F1), MTOT, FF, DM, DM, DM, 0, 0}; pg8::StaticOrder S; S.init(MTOT, FF, G, (int)blockIdx.x);
          pg8::EpiSplit<2, 2> E{HB, FF, 1 << 30, HB, FF, (const float*)(wsf + WS_SS) + (size_t)(2 * l + 1) * MTOT};
          pg8::gemm_phase(lds, g, S, E, wv_); }
        GSYNC(); STAMP(8);
        { pg8::Gemm g{HB, WPTR(wsf, WO_F2), MTOT, DM, FF, FF, FF, 0, 0}; pg8::StaticOrder S; S.init(MTOT, DM, G, (int)blockIdx.x);
          pg8::EpiResid E{as_global(ka->out), as_global(ka->out), XN, (float*)(wsf + WS_SS) + (size_t)(2 * l + 2) * MTOT};
          pg8::gemm_phase(lds, g, S, E, wv_); }
        GSYNC(); STAMP(9); }
    }
#ifdef PROBE_SYNCS
#pragma unroll 1
    for (int i_ = 0; i_ < PROBE_SYNCS; ++i_) GSYNC();
#endif
    KARGS(kz);
    final_norm(as_global(kz->out), as_global(kz->in[16]), (const float*)(as_global(kz->ws) + WS_SS) + (size_t)4 * MTOT, G, wv_);
#if PROBE_TS
    { OPAQUE_TID(t1_); if (blockIdx.x == 0 && t1_ == 0) { LAS unsigned long long* tsl = (LAS unsigned long long*)(lds + 131088); unsigned long long now_ = __builtin_amdgcn_s_memrealtime(); if ((PROBE_TS >> 11) & 1) tsl[1] += now_ - tsl[0];
        const unsigned long long until = now_ + tsl[1]; while (__builtin_amdgcn_s_memrealtime() < until) __builtin_amdgcn_s_sleep(8); } }
#endif
}

extern "C" void kernel_launch(void* const* d_in, const int* in_sizes, int n_in, void* d_out, int out_size, void* d_ws, size_t ws_size, hipStream_t stream) {
    static int grid = 0;
    if (grid == 0) {
        int dev = 0, cus = 0, per_cu = 0;
        (void)hipGetDevice(&dev);
        (void)hipDeviceGetAttribute(&cus, hipDeviceAttributeMultiprocessorCount, dev);
        (void)hipFuncSetAttribute((const void*)fwd_kernel, hipFuncAttributeMaxDynamicSharedMemorySize, LDS_BYTES);
        (void)hipOccupancyMaxActiveBlocksPerMultiprocessor(&per_cu, (const void*)fwd_kernel, 512, LDS_BYTES);
        (void)per_cu;
        grid = cus;
        if (ws_size < (size_t)504 * MiB) fprintf(stderr, "kernel_launch: workspace too small (%zu)\n", ws_size);
    }
    (void)hipMemsetAsync((char*)d_ws + WS_CTL, 0, 65536, stream);
    Args a{};
    for (int i = 0; i < 17; ++i) a.in[i] = (const float*)d_in[i];
    a.out = (float*)d_out; a.ws = (unsigned char*)d_ws;
    void* args[] = {&a};
    hipError_t e = hipLaunchCooperativeKernel((void*)fwd_kernel, dim3(grid), dim3(512), args, LDS_BYTES, stream);
    if (e != hipSuccess) fprintf(stderr, "cooperative launch failed: %s (grid %d)\n", hipGetErrorString(e), grid);
}
```
